# Optimizing an MI355X kernel written in HIP

```python
import jax
import jax.numpy as jnp
from jax import lax
import numpy as np

D_MODEL = 1024
BATCH = 4
SEQ = 8192
DEPTH = 1

GRID_W = 64
CTX_LEN = 256
D_MIX = D_MODEL
D_MLSTM = D_MIX // 2
D_CONV = D_MIX - D_MLSTM
M_HEADS = 4
V_DIM = D_MLSTM // M_HEADS
QK_DIM = V_DIM // 2
D_QK = M_HEADS * QK_DIM
N_GATES = 4 * M_HEADS
CHUNK = 128
CONV_WIDTH = 31
N_EXPERTS = 64
TOP_K = 8
D_EXPERT = D_MODEL // 4
D_SHARED = D_EXPERT
ROUTE_SCALE = 2.5
EXPERT_BLOCK = 128
EPS = 1e-6
IN_SPLITS = (D_QK, 2 * D_QK, 2 * D_QK + D_MLSTM, 2 * D_QK + 2 * D_MLSTM,
             2 * D_QK + 2 * D_MLSTM + N_GATES, 2 * D_QK + 2 * D_MLSTM + N_GATES + D_CONV)
D_IN = 2 * D_QK + 2 * D_MLSTM + N_GATES + 2 * D_CONV

kernel_name = "hybrid_mlstm_conformer_moe_dit_layer"


def _rms_norm(x, g):
    xf = x.astype(jnp.float32)
    y = xf * lax.rsqrt(jnp.mean(xf * xf, axis=-1, keepdims=True) + EPS)
    return (y * g.astype(jnp.float32)).astype(x.dtype)


def _layer_norm(x, g, b):
    xf = x.astype(jnp.float32)
    mu = jnp.mean(xf, axis=-1, keepdims=True)
    xc = xf - mu
    y = xc * lax.rsqrt(jnp.mean(xc * xc, axis=-1, keepdims=True) + EPS)
    return (y * g.astype(jnp.float32) + b.astype(jnp.float32)).astype(x.dtype)


def _modulate(h, shift, scale):
    return h * (1.0 + scale) + shift


def _heads(t, n):
    B, T, _ = t.shape
    return t.reshape(B, T, n, -1).transpose(0, 2, 1, 3).astype(jnp.float32)


def _mlstm_chunk_states(k, v, log_i, log_f, state0):
    B, H, T, dk = k.shape
    dv = v.shape[-1]
    nc = T // CHUNK
    kc = k.reshape(B, H, nc, CHUNK, dk)
    vc = v.reshape(B, H, nc, CHUNK, dv)
    li = log_i.reshape(B, H, nc, CHUNK)
    b = jnp.cumsum(log_f.reshape(B, H, nc, CHUNK), axis=-1)
    b_tot = b[..., -1]
    g = b_tot[..., None] - b + li
    m_loc = jnp.max(g, axis=-1)
    w = jnp.exp(g - m_loc[..., None])
    C_loc = jnp.einsum('bhcs,bhcsv,bhcsk->bhcvk', w, vc, kc)
    n_loc = jnp.einsum('bhcs,bhcsk->bhck', w, kc)

    def step(state, xs):
        C, n, m = state
        bt, ml, Cl, nl = xs
        m_new = jnp.maximum(bt + m, ml)
        a = jnp.exp(bt + m - m_new)
        e = jnp.exp(ml - m_new)
        C_new = a[..., None, None] * C + e[..., None, None] * Cl
        n_new = a[..., None] * n + e[..., None] * nl
        return (C_new, n_new, m_new), (C, n, m)

    xs = (jnp.moveaxis(b_tot, 2, 0), jnp.moveaxis(m_loc, 2, 0),
          jnp.moveaxis(C_loc, 2, 0), jnp.moveaxis(n_loc, 2, 0))
    final, prev = lax.scan(step, state0, xs)
    prev = (jnp.moveaxis(prev[0], 0, 2), jnp.moveaxis(prev[1], 0, 2), jnp.moveaxis(prev[2], 0, 2))
    return prev, final


def _mlstm_chunk_outputs(q, k, v, log_i, log_f, prev):
    C_prev, n_prev, m_prev = prev
    B, H, T, dk = q.shape
    dv = v.shape[-1]
    nc = T // CHUNK
    qc = q.reshape(B, H, nc, CHUNK, dk)
    kc = k.reshape(B, H, nc, CHUNK, dk)
    vc = v.reshape(B, H, nc, CHUNK, dv)
    li = log_i.reshape(B, H, nc, CHUNK)
    b = jnp.cumsum(log_f.reshape(B, H, nc, CHUNK), axis=-1)
    lower = jnp.tril(jnp.ones((CHUNK, CHUNK), dtype=bool))
    log_d = jnp.where(lower, b[..., :, None] - b[..., None, :] + li[..., None, :], -jnp.inf)
    a = b + m_prev[..., None]
    m_t = jnp.maximum(a, jnp.max(log_d, axis=-1))
    s = jnp.einsum('bhctk,bhcsk->bhcts', qc, kc) * jnp.exp(log_d - m_t[..., None])
    e_int = jnp.exp(a - m_t)
    num = (jnp.einsum('bhcts,bhcsv->bhctv', s, vc)
           + e_int[..., None] * jnp.einsum('bhcvk,bhctk->bhctv', C_prev, qc))
    den = jnp.sum(s, axis=-1) + e_int * jnp.einsum('bhck,bhctk->bhct', n_prev, qc)
    h = num / jnp.maximum(jnp.abs(den), jnp.exp(-m_t))[..., None]
    return h.reshape(B, H, T, dv)


def _mlstm_direction(q, k, v, log_i, log_f, state0, reverse, want_out):
    if reverse:
        q, k, v = jnp.flip(q, 2), jnp.flip(k, 2), jnp.flip(v, 2)
        log_i, log_f = jnp.flip(log_i, 2), jnp.flip(log_f, 2)
    prev, final = _mlstm_chunk_states(k, v, log_i, log_f, state0)
    h = None
    if want_out:
        h = _mlstm_chunk_outputs(q, k, v, log_i, log_f, prev)
        if reverse:
            h = jnp.flip(h, 2)
    return h, final


def _mlstm_bidir(q, k, v, gates, states0, want_out):
    h_f, s_f = _mlstm_direction(q, k, v, gates[:, 0], jax.nn.log_sigmoid(gates[:, 1]),
                                states0[0], False, want_out)
    h_b, s_b = _mlstm_direction(q, k, v, gates[:, 2], jax.nn.log_sigmoid(gates[:, 3]),
                                states0[1], True, want_out)
    h = h_f + h_b if want_out else None
    return h, (s_f, s_b)


def _project(h, w_in, b_in, b_gate):
    B, T, _ = h.shape
    z = h @ w_in + b_in
    q, k, v, o, gt, ga, gb = jnp.split(z, IN_SPLITS, axis=-1)
    q = _heads(q, M_HEADS)
    k = _heads(k, M_HEADS) * (QK_DIM ** -0.5)
    v = _heads(v, M_HEADS)
    gates = (gt.reshape(B, T, 4, M_HEADS).transpose(0, 2, 3, 1).astype(jnp.float32)
             + b_gate.astype(jnp.float32)[None, :, :, None])
    u = ga * jax.nn.sigmoid(gb)
    return (q, k, v, gates), o, u


def _mlstm_group_out(h, o, norm_g):
    B, H, T, dv = h.shape
    hn = h * lax.rsqrt(jnp.mean(h * h, axis=-1, keepdims=True) + EPS) * norm_g.astype(jnp.float32)[:, None, :]
    return hn.transpose(0, 2, 1, 3).reshape(B, T, H * dv).astype(o.dtype) * jax.nn.sigmoid(o)


def _conv_group_out(u, conv_w, conv_b, ln_g, ln_b, rows):
    B, T, C = u.shape
    lhs = u.reshape(B * rows, T // rows, C)
    y = lax.conv_general_dilated(lhs, conv_w.astype(u.dtype)[:, None, :], (1,), 'SAME',
                                 dimension_numbers=('NWC', 'WIO', 'NWC'), feature_group_count=C)
    y = y.reshape(B, T, C) + conv_b
    return jax.nn.silu(_layer_norm(y, ln_g, ln_b))


def _token_mixer(hx, hc, w_in, b_in, b_gate, norm_g, conv_w, conv_b, ln_g, ln_b, w_out, b_out, ctx_out):
    B = hx.shape[0]
    rows = hx.shape[1] // GRID_W
    mx_in, ox, ux = _project(hx, w_in, b_in, b_gate)
    mc_in, oc, uc = _project(hc, w_in, b_in, b_gate)
    zero = (jnp.zeros((B, M_HEADS, V_DIM, QK_DIM), jnp.float32),
            jnp.zeros((B, M_HEADS, QK_DIM), jnp.float32),
            jnp.zeros((B, M_HEADS), jnp.float32))
    hc_m, ctx_states = _mlstm_bidir(*mc_in, (zero, zero), ctx_out)
    hx_m, _ = _mlstm_bidir(*mx_in, ctx_states, True)
    yx = jnp.concatenate([_mlstm_group_out(hx_m, ox, norm_g),
                          _conv_group_out(ux, conv_w, conv_b, ln_g, ln_b, rows)], axis=-1) @ w_out + b_out
    yc = None
    if ctx_out:
        yc = jnp.concatenate([_mlstm_group_out(hc_m, oc, norm_g),
                              _conv_group_out(uc, conv_w, conv_b, ln_g, ln_b, 1)], axis=-1) @ w_out + b_out
    return yx, yc


def _moe_ffn(h, w_router, b_router, we_gate, we_up, we_down, ws_gate, ws_up, ws_down):
    B, T, D = h.shape
    hf = h.reshape(-1, D)
    nt = hf.shape[0]
    s = jax.nn.sigmoid((hf @ w_router).astype(jnp.float32))
    _, idx = lax.top_k(s + b_router.astype(jnp.float32), TOP_K)
    s_sel = jnp.take_along_axis(s, idx, axis=-1)
    wts = s_sel / jnp.sum(s_sel, axis=-1, keepdims=True) * ROUTE_SCALE
    n_assign = nt * TOP_K
    e_flat = idx.reshape(-1)
    tok_flat = jnp.repeat(jnp.arange(nt, dtype=jnp.int32), TOP_K)
    order = jnp.argsort(e_flat)
    e_s, tok_s, w_s = e_flat[order], tok_flat[order], wts.reshape(-1)[order]
    counts = jnp.bincount(e_flat, length=N_EXPERTS)
    starts = jnp.cumsum(counts) - counts
    padded = (counts + EXPERT_BLOCK - 1) // EXPERT_BLOCK * EXPERT_BLOCK
    pend = jnp.cumsum(padded)
    pstarts = pend - padded
    dest = pstarts[e_s] + (jnp.arange(n_assign, dtype=jnp.int32) - starts[e_s])
    n_rows = -(-(n_assign + N_EXPERTS * (EXPERT_BLOCK - 1)) // EXPERT_BLOCK) * EXPERT_BLOCK
    n_blocks = n_rows // EXPERT_BLOCK
    row_tok = jnp.full((n_rows,), nt, jnp.int32).at[dest].set(tok_s)
    row_w = jnp.zeros((n_rows,), jnp.float32).at[dest].set(w_s)
    block_e = jnp.minimum(jnp.searchsorted(pend, jnp.arange(n_blocks) * EXPERT_BLOCK, side='right'),
                          N_EXPERTS - 1)
    hpad = jnp.concatenate([hf, jnp.zeros((1, D), hf.dtype)], axis=0)

    def body(acc, xs):
        rows, rw, e = xs
        xb = hpad[rows]
        y = (jax.nn.silu(xb @ we_gate[e]) * (xb @ we_up[e])) @ we_down[e]
        return acc.at[rows].add(y * rw[:, None].astype(y.dtype)), None

    acc, _ = lax.scan(body, jnp.zeros((nt + 1, D), hf.dtype),
                      (row_tok.reshape(n_blocks, EXPERT_BLOCK), row_w.reshape(n_blocks, EXPERT_BLOCK), block_e))
    shared = (jax.nn.silu(hf @ ws_gate) * (hf @ ws_up)) @ ws_down
    return (acc[:nt] + shared).reshape(B, T, D)


def setup_inputs(seed: int = 0) -> dict:
    key = jax.random.key(seed)
    ks = jax.random.split(key, 32)

    def nrm(k, shape, scale):
        return jax.random.normal(k, shape, jnp.float32) * scale

    D = D_MODEL
    b_gate = jnp.stack([nrm(ks[12], (DEPTH, M_HEADS), 0.1),
                        3.0 + 3.0 * jax.random.uniform(ks[13], (DEPTH, M_HEADS), jnp.float32),
                        nrm(ks[14], (DEPTH, M_HEADS), 0.1),
                        3.0 + 3.0 * jax.random.uniform(ks[15], (DEPTH, M_HEADS), jnp.float32)], axis=1)
    return {
        "x": nrm(ks[0], (BATCH, SEQ, D), 1.0),
        "c": nrm(ks[1], (BATCH, D), 1.0),
        "ctx": nrm(ks[2], (BATCH, CTX_LEN, D), 1.0),
        "c_ctx": nrm(ks[3], (D,), 1.0),
        "w_ada": nrm(ks[4], (DEPTH, D, 6 * D), 0.5 * D ** -0.5),
        "b_ada": nrm(ks[5], (DEPTH, 6 * D), 0.02),
        "g_pre_mix": 1.0 + nrm(ks[6], (DEPTH, D), 0.1),
        "g_post_mix": 1.0 + nrm(ks[7], (DEPTH, D), 0.1),
        "g_pre_ffn": 1.0 + nrm(ks[8], (DEPTH, D), 0.1),
        "g_post_ffn": 1.0 + nrm(ks[9], (DEPTH, D), 0.1),
        "w_in": nrm(ks[10], (DEPTH, D, D_IN), D ** -0.5),
        "b_in": nrm(ks[11], (DEPTH, D_IN), 0.02),
        "b_gate": b_gate,
        "mlstm_norm_g": 1.0 + nrm(ks[16], (DEPTH, M_HEADS, V_DIM), 0.1),
        "conv_w": nrm(ks[17], (DEPTH, CONV_WIDTH, D_CONV), CONV_WIDTH ** -0.5),
        "conv_b": nrm(ks[18], (DEPTH, D_CONV), 0.02),
        "conv_ln_g": 1.0 + nrm(ks[19], (DEPTH, D_CONV), 0.1),
        "conv_ln_b": nrm(ks[20], (DEPTH, D_CONV), 0.02),
        "w_out": nrm(ks[21], (DEPTH, D_MIX, D), D_MIX ** -0.5),
        "b_out": nrm(ks[22], (DEPTH, D), 0.02),
        "w_router": nrm(ks[23], (DEPTH, D, N_EXPERTS), D ** -0.5),
        "b_router": nrm(ks[24], (DEPTH, N_EXPERTS), 0.01),
        "we_gate": nrm(ks[25], (DEPTH, N_EXPERTS, D, D_EXPERT), D ** -0.5),
        "we_up": nrm(ks[26], (DEPTH, N_EXPERTS, D, D_EXPERT), D ** -0.5),
        "we_down": nrm(ks[27], (DEPTH, N_EXPERTS, D_EXPERT, D), D_EXPERT ** -0.5),
        "ws_gate": nrm(ks[28], (DEPTH, D, D_SHARED), D ** -0.5),
        "ws_up": nrm(ks[29], (DEPTH, D, D_SHARED), D ** -0.5),
        "ws_down": nrm(ks[30], (DEPTH, D_SHARED, D), D_SHARED ** -0.5),
    }


def reference(x, c, ctx, c_ctx, w_ada, b_ada, g_pre_mix, g_post_mix, g_pre_ffn, g_post_ffn,
              w_in, b_in, b_gate, mlstm_norm_g, conv_w, conv_b, conv_ln_g, conv_ln_b, w_out, b_out,
              w_router, b_router, we_gate, we_up, we_down, ws_gate, ws_up, ws_down):
    for l in range(DEPTH):
        ctx_out = l < DEPTH - 1
        mx = [t[:, None, :] for t in jnp.split(jax.nn.silu(c) @ w_ada[l] + b_ada[l], 6, axis=-1)]
        mc = jnp.split(jax.nn.silu(c_ctx) @ w_ada[l] + b_ada[l], 6, axis=-1)
        hx = _modulate(_rms_norm(x, g_pre_mix[l]), mx[0], mx[1])
        hc = _modulate(_rms_norm(ctx, g_pre_mix[l]), mc[0], mc[1])
        yx, yc = _token_mixer(hx, hc, w_in[l], b_in[l], b_gate[l], mlstm_norm_g[l], conv_w[l], conv_b[l],
                              conv_ln_g[l], conv_ln_b[l], w_out[l], b_out[l], ctx_out)
        x = x + mx[2] * _rms_norm(yx, g_post_mix[l])
        hx = _modulate(_rms_norm(x, g_pre_ffn[l]), mx[3], mx[4])
        x = x + mx[5] * _rms_norm(_moe_ffn(hx, w_router[l], b_router[l], we_gate[l], we_up[l], we_down[l],
                                           ws_gate[l], ws_up[l], ws_down[l]), g_post_ffn[l])
        if ctx_out:
            ctx = ctx + mc[2] * _rms_norm(yc, g_post_mix[l])
            hc = _modulate(_rms_norm(ctx, g_pre_ffn[l]), mc[3], mc[4])
            ctx = ctx + mc[5] * _rms_norm(_moe_ffn(hc, w_router[l], b_router[l], we_gate[l], we_up[l], we_down[l],
                                                 ws_gate[l], ws_up[l], ws_down[l]), g_post_ffn[l])
    return x
```

```cpp
#include <hip/hip_runtime.h>
#include <hip/hip_cooperative_groups.h>
#include <cstdio>
#include <cstdint>

#ifndef DUP_MASK
#define DUP_MASK 0
#endif
#ifndef N_LAUNCH_MODE
#define N_LAUNCH_MODE 0
#endif

namespace cg = cooperative_groups;

typedef unsigned short bf16_t;
typedef short bf16x8 __attribute__((ext_vector_type(8)));
typedef float f32x4 __attribute__((ext_vector_type(4)));
typedef unsigned u32x2 __attribute__((ext_vector_type(2)));
typedef float f32x2_t __attribute__((ext_vector_type(2)));
typedef unsigned u32x4 __attribute__((ext_vector_type(4)));
#define LAS __attribute__((address_space(3)))

constexpr int D = 1024, NB = 4, T = 8192, NT = NB * T, CTXL = 256, CT = NB * CTXL, NR = NT + CT;
constexpr int DIN = 2576, NH = 4, DV = 128, DK = 64, NE = 64, TOPK = 8, DE = 256;
constexpr int NCH = 66;
constexpr float EPS = 1e-6f;
constexpr int NTHREADS = 512;

constexpr size_t al256(size_t x) { return (x + 255) & ~(size_t)255; }
constexpr int HT = NT / 2;
constexpr int LCAP = NT;
constexpr size_t WS_WT_D = 0;
constexpr size_t WS_MODP = WS_WT_D + (size_t)65 * 1024 * 256 * 2;
constexpr size_t WS_LTOK = WS_MODP + (size_t)8 * 5 * 6144 * 4;
constexpr size_t WS_SLOTE = WS_LTOK + (size_t)64 * LCAP * 4;
constexpr size_t WS_SLOTP = WS_SLOTE + (size_t)NT * 8 * 4;
constexpr size_t WS_SLOTW = WS_SLOTP + (size_t)NT * 8 * 4;
constexpr size_t WS_CURSOR = WS_SLOTW + (size_t)NT * 8 * 4;
constexpr size_t WS_WRH = WS_CURSOR + 1024;
constexpr size_t WS_WRL = WS_WRH + 131072;
constexpr size_t WS_BAR = WS_WRL + 131072;
constexpr size_t WS_GP = WS_BAR + 16384;
constexpr size_t WS_Z1 = al256(WS_GP + (size_t)NR * 16 * 4);
constexpr size_t WS_WT_IN = WS_Z1;
constexpr size_t WS_WT_IN8 = WS_WT_IN + (size_t)1024 * 1024 * 2;
constexpr size_t WS_WT_OUT = WS_WT_IN + (size_t)2560 * 1024 * 2;
constexpr size_t WS_WT_GU = WS_WT_OUT + (size_t)1024 * 1024 * 2;
constexpr size_t WS_HX = WS_WT_GU + (size_t)65 * 512 * 1024 * 2;
constexpr size_t WS_RA = WS_HX + (size_t)NR * 1024 * 2;
constexpr size_t WS_Q = WS_RA;
constexpr size_t WS_K = WS_Q + (size_t)NR * 256 * 2;
constexpr size_t WS_V = WS_K + (size_t)NR * 256 * 2;
constexpr size_t WS_SO = WS_V + (size_t)NR * 512 * 2;
constexpr size_t WS_U = WS_SO + (size_t)NR * 512 * 2;
constexpr size_t WS_RA_END = WS_U + (size_t)NR * 512 * 2;
constexpr size_t WS_YX = WS_RA;
constexpr size_t WS_RB = WS_RA_END;
constexpr size_t WS_CLOC = WS_RB;
constexpr size_t WS_HX8 = WS_CLOC + (size_t)32 * NCH * 8192 * 2;
constexpr size_t WS_NLOC = WS_CLOC + (size_t)32 * NCH * 8192 * 4;
constexpr size_t WS_SCAL = WS_NLOC + (size_t)32 * NCH * 64 * 4;
constexpr size_t WS_CPREV = al256(WS_SCAL + (size_t)32 * NCH * 2 * 4);
constexpr size_t WS_NPREV = WS_CPREV + (size_t)32 * 64 * 8192 * 2;
constexpr size_t WS_MPREV = WS_NPREV + (size_t)32 * 64 * 64 * 4;
constexpr size_t WS_MIX = al256(WS_MPREV + (size_t)32 * 64 * 4);
constexpr size_t WS_RB_END = WS_MIX + (size_t)NT * 1024 * 2;
constexpr int MAXTILES = 64 + NT * 8 / 256 + NT / 256;
constexpr size_t WS_YE = WS_Z1;
constexpr size_t WS_ACT = WS_YE + (size_t)MAXTILES * 256 * 1024;
constexpr size_t WS_ACT_END = WS_ACT + (size_t)MAXTILES * 256 * 256;
constexpr size_t WS_X1B = al256(WS_ACT_END);
constexpr size_t WS_X1B_END = WS_X1B + (size_t)NT * 1024 * 2;
constexpr size_t WS_END = WS_X1B_END > WS_RB_END ? WS_X1B_END : WS_RB_END;
static_assert(WS_ACT >= WS_RA_END, "act must not overlap hx2 / gate-up weights / yx");
static_assert((size_t)NT * 1024 * 4 <= WS_RA_END - WS_RA, "yx alias overflow");
static_assert(WS_END <= (size_t)512 * 1024 * 1024, "workspace too large");

struct P {
    const float *x, *c, *ctx, *c_ctx, *w_ada, *b_ada, *g_pre_mix, *g_post_mix, *g_pre_ffn, *g_post_ffn;
    const float *w_in, *b_in, *b_gate, *norm_g, *conv_w, *conv_b, *ln_g, *ln_b, *w_out, *b_out;
    const float *w_router, *b_router, *we_gate, *we_up, *we_down, *ws_gate, *ws_up, *ws_down;
    float* out;
    unsigned char* ws;
};

__device__ __forceinline__ int tidx() { int t = threadIdx.x; asm volatile("" : "+v"(t)); return t; }
__device__ __forceinline__ unsigned hw_pk_bf16(float lo, float hi) { unsigned r; asm("s_nop 0\n\tv_cvt_pk_bf16_f32 %0, %1, %2" : "=v"(r) : "v"(lo), "v"(hi)); return r; }
__device__ __forceinline__ bf16_t f2bf(float f) { return (bf16_t)(hw_pk_bf16(f, f) & 0xffffu); }
__device__ __forceinline__ float bf2f(bf16_t b) { return __uint_as_float(((unsigned)b) << 16); }
__device__ __forceinline__ unsigned pk2(float lo, float hi) { return hw_pk_bf16(lo, hi); }
__device__ __forceinline__ unsigned pk2_sw(float lo, float hi) { unsigned a = __float_as_uint(lo), b = __float_as_uint(hi); a += 0x7FFFu + ((a >> 16) & 1u); b += 0x7FFFu + ((b >> 16) & 1u); return (a >> 16) | (b & 0xffff0000u); }
__device__ __forceinline__ unsigned pk4_fp8(const f32x4 v) {
    const float a = __builtin_amdgcn_fmed3f(v[0], -448.f, 448.f), b = __builtin_amdgcn_fmed3f(v[1], -448.f, 448.f);
    const float c = __builtin_amdgcn_fmed3f(v[2], -448.f, 448.f), d = __builtin_amdgcn_fmed3f(v[3], -448.f, 448.f);
    int w = __builtin_amdgcn_cvt_pk_fp8_f32(a, b, 0, false);
    w = __builtin_amdgcn_cvt_pk_fp8_f32(c, d, w, true);
    return (unsigned)w;
}
template <int CTRL, int RMASK> __device__ __forceinline__ float dpp_get(float oldv, float v) {
    return __int_as_float(__builtin_amdgcn_update_dpp(__float_as_int(oldv), __float_as_int(v), CTRL, RMASK, 0xf, false));
}
__device__ __forceinline__ float wave_sum(float v) {
    v += dpp_get<0xB1, 0xf>(0.f, v);
    v += dpp_get<0x4E, 0xf>(0.f, v);
    v += dpp_get<0x141, 0xf>(0.f, v);
    v += dpp_get<0x140, 0xf>(0.f, v);
    v += dpp_get<0x142, 0xa>(0.f, v);
    v += dpp_get<0x143, 0xc>(0.f, v);
    return __int_as_float(__builtin_amdgcn_readlane(__float_as_int(v), 63));
}
__device__ __forceinline__ float wave_max(float v) {
    v = fmaxf(v, dpp_get<0xB1, 0xf>(v, v));
    v = fmaxf(v, dpp_get<0x4E, 0xf>(v, v));
    v = fmaxf(v, dpp_get<0x141, 0xf>(v, v));
    v = fmaxf(v, dpp_get<0x140, 0xf>(v, v));
    v = fmaxf(v, dpp_get<0x142, 0xa>(v, v));
    v = fmaxf(v, dpp_get<0x143, 0xc>(v, v));
    return __int_as_float(__builtin_amdgcn_readlane(__float_as_int(v), 63));
}
__device__ __forceinline__ float sigmoidf_(float x) { return 1.0f / (1.0f + __expf(-x)); }
__device__ __forceinline__ float siluf_(float x) { return x / (1.0f + __expf(-x)); }
__device__ __forceinline__ float logsigmoidf_(float x) { return fminf(x, 0.0f) - log1pf(__expf(-fabsf(x))); }
__device__ __forceinline__ float modval(const float* modp, int r, int idx) { return modp[(size_t)r * 6144 + idx]; }
__device__ __forceinline__ void glds16(const void* g, char* l) {
    __builtin_amdgcn_global_load_lds((const __attribute__((address_space(1))) unsigned*)g, (LAS unsigned*)l, 16, 0, 0);
}

template <bool FWD> __device__ __forceinline__ float masked_sum128(const float* a, int t) {
    float s = 0.f;
#pragma unroll 8
    for (int j4 = 0; j4 < 32; ++j4) {
        const f32x4 v = *(const f32x4*)(a + 4 * j4); const int j = 4 * j4;
        if (FWD) s += ((j <= t ? v[0] : 0.f) + (j + 1 <= t ? v[1] : 0.f)) + ((j + 2 <= t ? v[2] : 0.f) + (j + 3 <= t ? v[3] : 0.f));
        else     s += ((j >= t ? v[0] : 0.f) + (j + 1 >= t ? v[1] : 0.f)) + ((j + 2 >= t ? v[2] : 0.f) + (j + 3 >= t ? v[3] : 0.f));
    }
    return s;
}
template <bool FWD> __device__ __forceinline__ float masked_max128(const float* a, int t) {
    float s = -INFINITY;
#pragma unroll 8
    for (int j4 = 0; j4 < 32; ++j4) {
        const f32x4 v = *(const f32x4*)(a + 4 * j4); const int j = 4 * j4;
        if (FWD) s = fmaxf(fmaxf(s, fmaxf(j <= t ? v[0] : -INFINITY, j + 1 <= t ? v[1] : -INFINITY)), fmaxf(j + 2 <= t ? v[2] : -INFINITY, j + 3 <= t ? v[3] : -INFINITY));
        else     s = fmaxf(fmaxf(s, fmaxf(j >= t ? v[0] : -INFINITY, j + 1 >= t ? v[1] : -INFINITY)), fmaxf(j + 2 >= t ? v[2] : -INFINITY, j + 3 >= t ? v[3] : -INFINITY));
    }
    return s;
}
__device__ __forceinline__ float reduce16(const float (&g)[16], int lane) {
    float h8[8], h4[4], h2[2];
    const bool b5 = lane & 32, b4 = lane & 16, b3 = lane & 8, b2 = lane & 4;
#pragma unroll
    for (int i = 0; i < 8; ++i) { const float keep = b5 ? g[i + 8] : g[i], send = b5 ? g[i] : g[i + 8]; h8[i] = keep + __shfl_xor(send, 32); }
#pragma unroll
    for (int i = 0; i < 4; ++i) { const float keep = b4 ? h8[i + 4] : h8[i], send = b4 ? h8[i] : h8[i + 4]; h4[i] = keep + __shfl_xor(send, 16); }
#pragma unroll
    for (int i = 0; i < 2; ++i) { const float keep = b3 ? h4[i + 2] : h4[i], send = b3 ? h4[i] : h4[i + 2]; h2[i] = keep + __shfl_xor(send, 8); }
    float r = (b2 ? h2[1] : h2[0]) + __shfl_xor(b2 ? h2[0] : h2[1], 4);
    r += __shfl_xor(r, 2); r += __shfl_xor(r, 1);
    return r;
}

template <int CTRL, int RMASK> __device__ __forceinline__ float dpp_get_bc(float oldv, float v) {
    return __int_as_float(__builtin_amdgcn_update_dpp(__float_as_int(oldv), __float_as_int(v), CTRL, RMASK, 0xf, false));
}
__device__ __forceinline__ float wscan_up_add(float v, int lane) {
    (void)lane;
    v += dpp_get_bc<0x111, 0xf>(0.f, v);
    v += dpp_get_bc<0x112, 0xf>(0.f, v);
    v += dpp_get_bc<0x114, 0xf>(0.f, v);
    v += dpp_get_bc<0x118, 0xf>(0.f, v);
    v += dpp_get_bc<0x142, 0xa>(0.f, v);
    v += dpp_get_bc<0x143, 0xc>(0.f, v);
    return v;
}
__device__ __forceinline__ float wscan_up_max(float v, int lane) {
    (void)lane;
    v = fmaxf(v, dpp_get_bc<0x111, 0xf>(v, v));
    v = fmaxf(v, dpp_get_bc<0x112, 0xf>(v, v));
    v = fmaxf(v, dpp_get_bc<0x114, 0xf>(v, v));
    v = fmaxf(v, dpp_get_bc<0x118, 0xf>(v, v));
    v = fmaxf(v, dpp_get_bc<0x142, 0xa>(v, v));
    v = fmaxf(v, dpp_get_bc<0x143, 0xc>(v, v));
    return v;
}
__device__ __forceinline__ float wscan_down_add(float v, int lane) {
    v = __shfl(v, 63 - lane); v = wscan_up_add(v, lane); return __shfl(v, 63 - lane);
}
__device__ __forceinline__ float wscan_down_max(float v, int lane) {
    v = __shfl(v, 63 - lane); v = wscan_up_max(v, lane); return __shfl(v, 63 - lane);
}
__device__ __forceinline__ int seq_row0(int s, int cid) { return cid < 2 ? NT + s * CTXL + cid * 128 : s * T + (cid - 2) * 128; }

namespace g8 {
constexpr int BM = 256, BK = 64, HALF = 128, HTB = HALF * BK * 2, STAGE_BYTES = 8 * HTB;
__device__ __forceinline__ int lds_byte(int r, int c) { const int st = (r >> 4) * 2 + (c >> 5), rr = r & 15, cc = c & 31, ob = rr * 64 + cc * 2; return st * 1024 + (ob ^ (((ob >> 9) & 1) << 5)); }
__device__ __forceinline__ void stage_rc(int b, int& R, int& C) { const int st = b / 1024, sb = b % 1024, swz = sb ^ (((sb >> 9) & 1) << 5); R = (st >> 1) * 16 + swz / 64; C = (st & 1) * 32 + (swz % 64) / 2; }
__device__ __forceinline__ int perm32(int rho) { const int n = rho >> 4, i = rho & 15; return 8 * (i >> 2) + 4 * n + (i & 3); }
__device__ __forceinline__ unsigned cvt_pk_bf16(float lo, float hi) { unsigned r; asm volatile("s_nop 0\n\tv_cvt_pk_bf16_f32 %0, %1, %2" : "=v"(r) : "v"(lo), "v"(hi)); return r; }

struct Unit { const char* A; const char* B; int x0, x1, x2, x3; };

typedef int v8i_t __attribute__((ext_vector_type(8)));
template <bool PERM, bool GATHER, bool FP8, int SCB, class Sched, class Epi>
__device__ __forceinline__ void gemm(LAS unsigned char* lds, const int KB, const Sched& S, const Epi& E) {
    const int tid = tidx(), wid = __builtin_amdgcn_readfirstlane(tid >> 6), lane = tid & 63, wr = wid >> 2, wc = wid & 3, fr = lane & 15, fq = lane >> 4;
    const int nt = KB / 128;
    int R[2]; unsigned c2[2], voffB[2], vb[2];
#pragma unroll
    for (int i = 0; i < 2; ++i) { int C; stage_rc(tid * 16 + i * 8192, R[i], C); const int Rb = PERM ? ((R[i] & ~31) + perm32(R[i] & 31)) : R[i]; voffB[i] = (unsigned)(Rb * KB + C * 2); vb[i] = (unsigned)(R[i] * KB + C * 2); c2[i] = (unsigned)C * 2u; }
    const size_t kstep = (size_t)(BK * 2);
    const size_t hstep = (size_t)HALF * KB;
    const unsigned ldsw = (unsigned)wid * 1024u;
    const int ca0 = FP8 ? (fq >> 1) * 32 + (fq & 1) * 16 : fq * 8, ca1 = FP8 ? ca0 + 8 : 32 + fq * 8;
    const int pa0 = lds_byte(wr * 64 + fr, ca0), pa1 = lds_byte(wr * 64 + fr, ca1), pb0 = lds_byte(wc * 32 + fr, ca0), pb1 = lds_byte(wc * 32 + fr, ca1);
#define G8_SA(b, h) (((b) * 2 + (h)) * HTB)
#define G8_SB(b, h) ((4 + (b) * 2 + (h)) * HTB)
#define G8_STAGE(bufoff, gbase, voff) do { _Pragma("unroll") for (int _i = 0; _i < 2; ++_i) \
        __builtin_amdgcn_global_load_lds((const __attribute__((address_space(1))) unsigned*)((const char*)(gbase) + (voff)[_i]), (LAS unsigned*)(lds + (bufoff) + ldsw + _i * 8192), 16, 0, 0); } while (0)
#define G8_LDA(dst, b, h) do { _Pragma("unroll") for (int m = 0; m < 4; ++m) _Pragma("unroll") for (int k = 0; k < 2; ++k) dst[m][k] = *(const LAS bf16x8*)(lds + G8_SA(b, h) + (k ? pa1 : pa0) + m * 2048); } while (0)
#define G8_LDB(dst, b, h) do { _Pragma("unroll") for (int n = 0; n < 2; ++n) _Pragma("unroll") for (int k = 0; k < 2; ++k) dst[n][k] = *(const LAS bf16x8*)(lds + G8_SB(b, h) + (k ? pb1 : pb0) + n * 2048); } while (0)
#define G8_CAT(x) __builtin_shufflevector(__builtin_bit_cast(u32x4, (x)[0]), __builtin_bit_cast(u32x4, (x)[1]), 0, 1, 2, 3, 4, 5, 6, 7)
#define G8_MMA(ai, bj, At, Bt) do { __builtin_amdgcn_s_setprio(1); _Pragma("unroll") for (int m = 0; m < 4; ++m) _Pragma("unroll") for (int n = 0; n < 2; ++n) { \
        if (FP8) acc[ai][bj][m][n] = __builtin_amdgcn_mfma_scale_f32_16x16x128_f8f6f4(__builtin_bit_cast(v8i_t, G8_CAT(Bt[n])), __builtin_bit_cast(v8i_t, G8_CAT(At[m])), acc[ai][bj][m][n], 0, 0, 0, 0x7F7F7F7F, 0, SCB * 0x01010101); \
        else { _Pragma("unroll") for (int k = 0; k < 2; ++k) acc[ai][bj][m][n] = __builtin_amdgcn_mfma_f32_16x16x32_bf16(Bt[n][k], At[m][k], acc[ai][bj][m][n], 0, 0, 0); } } \
        __builtin_amdgcn_s_setprio(0); } while (0)
#define G8_WAIT_V(n) asm volatile("s_waitcnt vmcnt(" #n ")" ::: "memory")
#define G8_WAIT_L(n) asm volatile("s_waitcnt lgkmcnt(" #n ")" ::: "memory")
#define G8_BAR __builtin_amdgcn_s_barrier()
#define G8_SCHED __builtin_amdgcn_sched_barrier(0)
    Unit cur, nxt; int ui = 0;
    if (!S.next(0, cur)) return;
    f32x4 acc[2][2][4][2];
#define G8_ZERO_ACC() do { _Pragma("unroll") for (int a = 0; a < 2; ++a) _Pragma("unroll") for (int b = 0; b < 2; ++b) _Pragma("unroll") for (int m = 0; m < 4; ++m) _Pragma("unroll") for (int n = 0; n < 2; ++n) { \
        f32x2_t z0_, z1_; asm volatile("v_mov_b64 %0, 0" : "=v"(z0_)); asm volatile("v_mov_b64 %0, 0" : "=v"(z1_)); acc[a][b][m][n] = __builtin_shufflevector(z0_, z1_, 0, 1, 2, 3); } } while (0)
    G8_ZERO_ACC();
    bf16x8 At[4][2], B0[2][2], B1[2][2];
    unsigned va[2][2];
    if (GATHER) S.aoffs(cur, R, c2, va);
    else { va[0][0] = vb[0]; va[0][1] = vb[1]; va[1][0] = vb[0]; va[1][1] = vb[1]; }
    const size_t ah = GATHER ? (size_t)0 : hstep;
    const char* cA = cur.A; const char* cB = cur.B;
    G8_STAGE(G8_SB(0, 0), cB, voffB); G8_STAGE(G8_SA(0, 0), cA, va[0]); G8_STAGE(G8_SB(0, 1), cB + hstep, voffB); G8_STAGE(G8_SA(0, 1), cA + ah, va[1]);
    if (wr == 1) G8_BAR;
    G8_WAIT_V(4); G8_BAR;
    G8_STAGE(G8_SB(1, 0), cB + kstep, voffB); G8_STAGE(G8_SA(1, 0), cA + kstep, va[0]); G8_STAGE(G8_SB(1, 1), cB + hstep + kstep, voffB); G8_STAGE(G8_SA(1, 1), cA + kstep + ah, va[1]);
    G8_WAIT_V(8); G8_BAR;
    for (;;) {
        const bool has_next = S.next(ui + 1, nxt);
        const char* nA = has_next ? nxt.A : cA; const char* nB = has_next ? nxt.B : cB;
#pragma unroll 1
        for (int t = 0; t < nt; t += 2) {
            const bool last = (t == nt - 2);
            G8_LDB(B0, 0, 0); G8_SCHED; G8_LDA(At, 0, 0);
            G8_WAIT_L(8); G8_BAR; G8_WAIT_L(0); G8_MMA(0, 0, At, B0); G8_BAR; G8_SCHED;
            if (GATHER) { if (last && has_next) S.aoffs(nxt, R, c2, va); }
            const char* a2 = last ? nA : cA + (size_t)(t + 2) * kstep; const char* b2 = last ? nB : cB + (size_t)(t + 2) * kstep;
            const char* a3 = a2 + kstep; const char* b3 = b2 + kstep;
            G8_SCHED;
            G8_LDB(B1, 0, 1); G8_STAGE(G8_SB(0, 0), b2, voffB);
            G8_BAR; G8_WAIT_L(0); G8_MMA(0, 1, At, B1); G8_BAR;
            G8_LDA(At, 0, 1); G8_STAGE(G8_SA(0, 0), a2, va[0]);
            G8_BAR; G8_WAIT_L(0); G8_MMA(1, 0, At, B0); G8_BAR; G8_SCHED;
            G8_STAGE(G8_SB(0, 1), b2 + hstep, voffB);
            G8_WAIT_V(6); G8_BAR; G8_MMA(1, 1, At, B1); G8_BAR;
            G8_LDB(B0, 1, 0); G8_SCHED; G8_LDA(At, 1, 0); G8_STAGE(G8_SA(0, 1), a2 + ah, va[1]);
            G8_WAIT_L(8); G8_BAR; G8_WAIT_L(0); G8_MMA(0, 0, At, B0); G8_BAR; G8_SCHED;
            G8_LDB(B1, 1, 1); G8_STAGE(G8_SB(1, 0), b3, voffB);
            G8_BAR; G8_WAIT_L(0); G8_MMA(0, 1, At, B1); G8_BAR;
            G8_LDA(At, 1, 1); G8_STAGE(G8_SA(1, 0), a3, va[0]);
            G8_BAR; G8_WAIT_L(0); G8_MMA(1, 0, At, B0); G8_BAR; G8_SCHED;
            G8_STAGE(G8_SB(1, 1), b3 + hstep, voffB);
            G8_WAIT_V(6); G8_BAR; G8_MMA(1, 1, At, B1); G8_BAR;
            G8_STAGE(G8_SA(1, 1), a3 + ah, va[1]);
        }
        E(acc, cur, wr, wc, fr, fq);
        if (!has_next) break;
        G8_ZERO_ACC();
        cur = nxt; cA = nA; cB = nB; ++ui;
    }
    G8_WAIT_V(0);
    if (wr == 0) G8_BAR;
    G8_BAR;
#undef G8_ZERO_ACC
#undef G8_SA
#undef G8_SB
#undef G8_STAGE
#undef G8_LDA
#undef G8_LDB
#undef G8_MMA
#undef G8_CAT
#undef G8_WAIT_V
#undef G8_WAIT_L
#undef G8_BAR
#undef G8_SCHED
}

__device__ __forceinline__ bool static_unit(int i, int nM, int nN, int& pm, int& pn) {
    const int nwg = nM * nN, G = gridDim.x;
    const long L = (long)i * G + blockIdx.x; if (L >= nwg) return false;
    int wgid = (int)L; { const int q = nwg / 8, r = nwg % 8, xcd = wgid % 8, off = wgid / 8; wgid = (xcd < r ? xcd * (q + 1) : r * (q + 1) + (xcd - r) * q) + off; }
    const int nig = 8 * nN, gid = wgid / nig, fm = gid * 8, gsz = (nM - fm) < 8 ? (nM - fm) : 8;
    pm = fm + ((wgid % nig) % gsz); pn = (wgid % nig) / gsz; return true;
}
}

constexpr int CVT_T0 = 640, CVT_T1 = CVT_T0 + 256, CVT_T2 = CVT_T1 + 65 * 128, CVT_T3 = CVT_T2 + 65 * 64;
constexpr int ADA_ITEMS = 96;
constexpr float HX2_SCALE = 4.0f, WGU_SCALE = 64.0f;   static_assert(HX2_SCALE * WGU_SCALE == 256.0f, "the gate/up GEMM's MFMA block scale is 2^-8");
constexpr float YE_SCALE = 16.0f;
constexpr float HX8_SCALE = 4.0f, WIN8_SCALE = 64.0f;   static_assert(HX8_SCALE * WIN8_SCALE == 256.0f, "the fp8 in-projection's MFMA block scale is 2^-8");
constexpr float MIX_SCALE = 16.0f, WOUT_SCALE = 64.0f;   static_assert(MIX_SCALE * WOUT_SCALE == 1024.0f, "the out-projection's MFMA block scale is 2^-10");
constexpr float ACT_SCALE = 1.0f, WD_SCALE = YE_SCALE / ACT_SCALE;

__device__ __forceinline__ void ada_item(const P& p, int it, char* smem) {
    const int tid = tidx(), lane = tid & 63, kg = tid >> 6, cq = lane & 15, rg = lane >> 4;
    float* sc = (float*)smem;
    float* red = (float*)(smem + 20480);
    __syncthreads();
    {
        float t[10];
#pragma unroll
        for (int j = 0; j < 10; ++j) { const int i = tid + j * NTHREADS, r = i >> 10, k = i & 1023; t[j] = r < 4 ? p.c[r * 1024 + k] : p.c_ctx[k]; }
#pragma unroll
        for (int j = 0; j < 10; ++j) sc[tid + j * NTHREADS] = siluf_(t[j]);
    }
    __syncthreads();
    f32x4 a[5];
#pragma unroll
    for (int r = 0; r < 5; ++r) a[r] = (f32x4){0.f, 0.f, 0.f, 0.f};
    const float* w = p.w_ada + (size_t)(kg * 128 + rg) * 6144 + it * 64 + 4 * cq;
    const float* s0 = sc + kg * 128 + rg;
#pragma unroll 8
    for (int i = 0; i < 32; ++i) {
        const f32x4 wv = *(const f32x4*)(w + (size_t)(4 * i) * 6144);
#pragma unroll
        for (int r = 0; r < 5; ++r) a[r] += s0[r * 1024 + 4 * i] * wv;
    }
#pragma unroll
    for (int r = 0; r < 5; ++r)
#pragma unroll
        for (int c = 0; c < 4; ++c) { float v = a[r][c]; v += __shfl_xor(v, 16); v += __shfl_xor(v, 32); a[r][c] = v; }
    if (rg == 0) {
#pragma unroll
        for (int r = 0; r < 5; ++r) *(f32x4*)(red + kg * 320 + r * 64 + 4 * cq) = a[r];
    }
    __syncthreads();
    if (tid < 320) {
        const int r = tid >> 6, cc = it * 64 + (tid & 63);
        float v = p.b_ada[cc];
#pragma unroll
        for (int g = 0; g < 8; ++g) v += red[g * 320 + tid];
        ((float*)(p.ws + WS_MODP))[(size_t)r * 6144 + cc] = v;
    }
}

struct CvtTile { int job, e, k0, n0; };
__device__ __forceinline__ CvtTile cvt_decode(int t) {
    CvtTile c; c.e = 0; int kt, nt;
    if (t < CVT_T0) { kt = t / 40; nt = t % 40; c.job = nt >= 16 ? 4 : 0; }
    else if (t < CVT_T1) { c.job = 1; t -= CVT_T0; kt = t / 16; nt = t % 16; }
    else if (t < CVT_T2) { c.job = 2; t -= CVT_T1; c.e = t / 128; t %= 128; kt = t / 8; nt = t % 8; }
    else { c.job = 3; t -= CVT_T2; c.e = t / 64; t %= 64; kt = t / 16; nt = t % 16; }
    c.k0 = kt * 64; c.n0 = nt * 64; return c;
}
__device__ __forceinline__ const float* cvt_src(const P& p, const CvtTile& c, int k, int n) {
    if (c.job == 0 || c.job == 4) {
        if (n < 1536) return p.w_in + (size_t)k * DIN + n;
        const int m = n - 1536, g = m >> 8, wi = m & 255; return p.w_in + (size_t)k * DIN + (wi < 128 ? 1552 + g * 128 + wi : 2064 + g * 128 + wi - 128);
    } else if (c.job == 1) return p.w_out + (size_t)k * 1024 + n;
    else if (c.job == 2) {
        const int g = n >> 8, wi = n & 255;
        const float* gb = c.e < 64 ? p.we_gate + (size_t)c.e * 1024 * 256 : p.ws_gate;
        const float* ub = c.e < 64 ? p.we_up + (size_t)c.e * 1024 * 256 : p.ws_up;
        return wi < 128 ? gb + (size_t)k * 256 + g * 128 + wi : ub + (size_t)k * 256 + g * 128 + wi - 128;
    }
    const float* db = c.e < 64 ? p.we_down + (size_t)c.e * 256 * 1024 : p.ws_down; return db + (size_t)k * 1024 + n;
}
__device__ __forceinline__ bf16_t* cvt_dst(const P& p, const CvtTile& c, int n, int k) {
    if (c.job == 0) return (bf16_t*)(p.ws + WS_WT_IN) + (size_t)n * 1024 + k;
    if (c.job == 1) return (bf16_t*)(p.ws + WS_WT_OUT) + (size_t)n * 1024 + k;
    if (c.job == 2) return (bf16_t*)(p.ws + WS_WT_GU) + (size_t)c.e * 512 * 1024 + (size_t)n * 1024 + k;
    return (bf16_t*)(p.ws + WS_WT_D) + (size_t)c.e * 1024 * 256 + (size_t)n * 256 + k;
}
__device__ __forceinline__ void cvt_load(const P& p, int t4, f32x4 (&v)[8]) {
    const int tid = tidx();
    if (t4 * 4 >= CVT_T0 || (t4 * 4) % 40 >= 16) {
        const int q2 = tid >> 8, kq = (tid >> 4) & 15, n4 = (tid & 15) * 4;
#pragma unroll
        for (int rnd = 0; rnd < 2; ++rnd) {
            const CvtTile c = cvt_decode(t4 * 4 + q2 + 2 * rnd);
#pragma unroll
            for (int r = 0; r < 4; ++r) v[rnd * 4 + r] = *(const f32x4*)cvt_src(p, c, c.k0 + 4 * kq + r, c.n0 + n4);
        }
    } else {
        const int kp = tid >> 4, n4 = (tid & 15) * 4;
#pragma unroll
        for (int q = 0; q < 4; ++q) {
            const CvtTile c = cvt_decode(t4 * 4 + q);
            v[2 * q] = *(const f32x4*)cvt_src(p, c, c.k0 + 2 * kp, c.n0 + n4);
            v[2 * q + 1] = *(const f32x4*)cvt_src(p, c, c.k0 + 2 * kp + 1, c.n0 + n4);
        }
    }
}
__device__ __forceinline__ void cvt_store(const P& p, int t4, const f32x4 (&v)[8], char* smem) {
    const int tid = tidx();
    unsigned* tile = (unsigned*)smem;
    if (t4 * 4 >= CVT_T0 || (t4 * 4) % 40 >= 16) {
        const int q2 = tid >> 8, kq = (tid >> 4) & 15, n4 = (tid & 15) * 4;
        CvtTile c[2];
#pragma unroll
        for (int rnd = 0; rnd < 2; ++rnd) {
            c[rnd] = cvt_decode(t4 * 4 + q2 + 2 * rnd);
#pragma unroll
            for (int cc = 0; cc < 4; ++cc)
                tile[(q2 + 2 * rnd) * 1088 + (n4 + cc) * 17 + kq] = pk4_fp8((f32x4){v[rnd * 4][cc], v[rnd * 4 + 1][cc], v[rnd * 4 + 2][cc], v[rnd * 4 + 3][cc]} * (c[rnd].job == 2 ? WGU_SCALE : (c[rnd].job == 3 ? WD_SCALE : (c[rnd].job == 4 ? WIN8_SCALE : WOUT_SCALE))));
        }
        __syncthreads();
        const int nn = (tid >> 2) & 63, part = tid & 3;
#pragma unroll
        for (int rnd = 0; rnd < 2; ++rnd) {
            const unsigned* src = tile + (q2 + 2 * rnd) * 1088 + nn * 17 + part * 4;
            u32x4 w; w.x = src[0]; w.y = src[1]; w.z = src[2]; w.w = src[3];
            unsigned char* dst = c[rnd].job == 2 ? (unsigned char*)(p.ws + WS_WT_GU) + (size_t)c[rnd].e * 512 * 1024 + (size_t)(c[rnd].n0 + nn) * 1024 + c[rnd].k0 + part * 16
                               : c[rnd].job == 3 ? (unsigned char*)(p.ws + WS_WT_D) + (size_t)c[rnd].e * 1024 * 256 + (size_t)(c[rnd].n0 + nn) * 256 + c[rnd].k0 + part * 16
                               : c[rnd].job == 4 ? (unsigned char*)(p.ws + WS_WT_IN8) + (size_t)(c[rnd].n0 + nn - 1024) * 1024 + c[rnd].k0 + part * 16
                                                 : (unsigned char*)(p.ws + WS_WT_OUT) + (size_t)(c[rnd].n0 + nn) * 1024 + c[rnd].k0 + part * 16;
            *(u32x4*)dst = w;
        }
    } else {
        const int kp = tid >> 4, n4 = (tid & 15) * 4;
#pragma unroll
        for (int q = 0; q < 4; ++q)
#pragma unroll
            for (int cc = 0; cc < 4; ++cc) tile[q * 2112 + (n4 + cc) * 33 + kp] = pk2(v[2 * q][cc], v[2 * q + 1][cc]);
        __syncthreads();
        const int nn = tid >> 3, kw = (tid & 7) * 4;
#pragma unroll
        for (int q = 0; q < 4; ++q) {
            const CvtTile c = cvt_decode(t4 * 4 + q);
            u32x4 w; w.x = tile[q * 2112 + nn * 33 + kw]; w.y = tile[q * 2112 + nn * 33 + kw + 1]; w.z = tile[q * 2112 + nn * 33 + kw + 2]; w.w = tile[q * 2112 + nn * 33 + kw + 3];
            *(u32x4*)cvt_dst(p, c, c.n0 + nn, c.k0 + 2 * kw) = w;
        }
    }
}

__device__ __forceinline__ void wr_split_item(const P& p, int it) {
    const int idx = it * NTHREADS + tidx(), lane = idx & 63, n = (idx >> 6) & 3, ks = (idx >> 8) & 3, w = idx >> 10, fr = lane & 15, fq = lane >> 4;
    float v[8], lo[8]; unsigned hi[4];
#pragma unroll
    for (int j = 0; j < 8; ++j) v[j] = p.w_router[(size_t)(128 * w + 32 * ks + 8 * fq + j) * 64 + 16 * n + fr];
#pragma unroll
    for (int j = 0; j < 4; ++j) { hi[j] = pk2(v[2 * j], v[2 * j + 1]); lo[2 * j] = v[2 * j] - __uint_as_float(hi[j] << 16); lo[2 * j + 1] = v[2 * j + 1] - __uint_as_float(hi[j] & 0xffff0000u); }
    *(u32x4*)(p.ws + WS_WRH + (size_t)idx * 16) = (u32x4){hi[0], hi[1], hi[2], hi[3]};
    *(u32x4*)(p.ws + WS_WRL + (size_t)idx * 16) = (u32x4){pk2(lo[0], lo[1]), pk2(lo[2], lo[3]), pk2(lo[4], lo[5]), pk2(lo[6], lo[7])};
}

constexpr int XB_ADAFLAG = 3520;
__device__ __forceinline__ void ada_signal(const P& p) {
    asm volatile("s_waitcnt vmcnt(0)" ::: "memory");
    __syncthreads();
    if (tidx() == 0) { __builtin_amdgcn_fence(__ATOMIC_RELEASE, "agent"); __hip_atomic_fetch_add((unsigned*)(p.ws + WS_BAR) + XB_ADAFLAG, 1u, __ATOMIC_RELAXED, __HIP_MEMORY_SCOPE_AGENT); }
}
__device__ __forceinline__ void ada_wait(const P& p) {
    if (tidx() == 0) {
        unsigned* f = (unsigned*)(p.ws + WS_BAR) + XB_ADAFLAG; unsigned* tmo = (unsigned*)(p.ws + WS_BAR) + 128; unsigned sp = 0;
        while (__hip_atomic_load(f, __ATOMIC_RELAXED, __HIP_MEMORY_SCOPE_AGENT) < (unsigned)ADA_ITEMS) {
            __builtin_amdgcn_s_sleep(2);
            if ((++sp & 255u) == 0u) { if (__hip_atomic_load(tmo, __ATOMIC_RELAXED, __HIP_MEMORY_SCOPE_AGENT)) break; if (sp > (1u << 18)) { atomicAdd(tmo, 1u); break; } }
        }
        __builtin_amdgcn_fence(__ATOMIC_ACQUIRE, "agent");
    }
    __syncthreads();
}
__device__ __forceinline__ void phase0(const P& p, char* smem) {
    if (blockIdx.x == 0 && tidx() < 128) ((int*)(p.ws + WS_CURSOR))[tidx()] = 0;
    const int G = (int)gridDim.x, bid = (int)blockIdx.x;
    for (int it = G - 1 - bid; it < 16; it += G) wr_split_item(p, it);
    for (int it = bid; it < ADA_ITEMS; it += G) { ada_item(p, it, smem); ada_signal(p); }
    const int S = CVT_T3 / 4, nA = G > ADA_ITEMS ? ADA_ITEMS : 0;
    int R = (S - 2 * (G - nA) + G - 1) / G; if (R < 0) R = 0;
    const int base2 = R * G, G2 = G - nA, b2 = bid - nA;
#define P0_STEP(k_) ((k_) < R ? (k_) * G + bid : (b2 >= 0 ? base2 + b2 + ((k_) - R) * G2 : S))
    f32x4 v[8];
    int k = 0, st = P0_STEP(0);
    if (st < S) cvt_load(p, st, v);
    while (st < S) {
        f32x4 c[8];
#pragma unroll
        for (int i = 0; i < 8; ++i) c[i] = v[i];
        const int nx = P0_STEP(k + 1);
        __syncthreads();
        if (nx < S) cvt_load(p, nx, v);
        cvt_store(p, st, c, smem);
        st = nx; ++k;
    }
#undef P0_STEP
}

__device__ __forceinline__ void phase1(const P& p, char* smem) {
    const int tid = tidx(), wid = tid >> 6, lane = tid & 63;
    float* modl = (float*)smem;
    float* wgT = (float*)(smem + 40960);
    const float* modp = (const float*)(p.ws + WS_MODP);
    f32x4 nv[2][4];
#define P1_LOAD(r0_) do { _Pragma("unroll") for (int q = 0; q < 2; ++q) { const int row_ = (r0_) + q; const float* xr_ = row_ < NT ? p.x + (size_t)row_ * 1024 : p.ctx + (size_t)(row_ - NT) * 1024; \
        _Pragma("unroll") for (int j = 0; j < 4; ++j) nv[q][j] = *(const f32x4*)(xr_ + 4 * lane + 256 * j); } } while (0)
    if ((blockIdx.x * 8 + wid) * 2 < NR) P1_LOAD((blockIdx.x * 8 + wid) * 2);
    ada_wait(p);
    {
        float t0[20], t1[32];
#pragma unroll
        for (int j = 0; j < 20; ++j) { const int i = tid + j * NTHREADS; t0[j] = modval(modp, i >> 11, i & 2047); }
#pragma unroll
        for (int j = 0; j < 32; ++j) { const int i = tid + j * NTHREADS; t1[j] = p.w_in[(size_t)(i >> 4) * DIN + 1536 + (i & 15)]; }
#pragma unroll
        for (int j = 0; j < 20; ++j) modl[tid + j * NTHREADS] = t0[j];
#pragma unroll
        for (int j = 0; j < 32; ++j) { const int i = tid + j * NTHREADS; wgT[(i & 15) * 1024 + (i >> 4)] = t1[j]; }
    }
    float* gl = (float*)(smem + 40960 + 65536);
    { const float a0 = p.g_pre_mix[tid], a1 = p.g_pre_mix[tid + NTHREADS]; gl[tid] = a0; gl[tid + NTHREADS] = a1; }
    const int gi = ((lane >> 5) & 1) * 8 + ((lane >> 4) & 1) * 4 + ((lane >> 3) & 1) * 2 + ((lane >> 2) & 1);
    const float bb = p.b_in[1536 + gi] + p.b_gate[gi];
    __syncthreads();
    bf16_t* hx = (bf16_t*)(p.ws + WS_HX);
    float* gp = (float*)(p.ws + WS_GP);
    for (int row0 = (blockIdx.x * 8 + wid) * 2; row0 < NR; row0 += gridDim.x * 16) {
        f32x4 v[2][4]; float ss[2]; int rr[2];
#pragma unroll
        for (int q = 0; q < 2; ++q) {
            rr[q] = (row0 + q) < NT ? (row0 + q) / T : 4; ss[q] = 0.f;
#pragma unroll
            for (int j = 0; j < 4; ++j) { v[q][j] = nv[q][j]; ss[q] += v[q][j][0] * v[q][j][0] + v[q][j][1] * v[q][j][1] + v[q][j][2] * v[q][j][2] + v[q][j][3] * v[q][j][3]; }
        }
        { const int nx = row0 + gridDim.x * 16; if (nx < NR) P1_LOAD(nx); }
        ss[0] = wave_sum(ss[0]); ss[1] = wave_sum(ss[1]);
#pragma unroll
        for (int q = 0; q < 2; ++q) {
            const int row = row0 + q;
            const float inv = rsqrtf(ss[q] * (1.0f / 1024.0f) + EPS);
            const float* sh = modl + rr[q] * 2048; const float* scl = sh + 1024;
#pragma unroll
            for (int j = 0; j < 4; ++j) {
                const int idx = 4 * lane + 256 * j;
                const f32x4 g = *(const f32x4*)(gl + idx), s1 = *(const f32x4*)(sh + idx), s2 = *(const f32x4*)(scl + idx);
#pragma unroll
                for (int c = 0; c < 4; ++c) v[q][j][c] = v[q][j][c] * inv * g[c] * (1.0f + s2[c]) + s1[c];
                u32x2 o; o.x = pk2(v[q][j][0], v[q][j][1]); o.y = pk2(v[q][j][2], v[q][j][3]);
                *(u32x2*)(hx + (size_t)row * 1024 + idx) = o;
                if (row < NT) *(unsigned*)(p.ws + WS_HX8 + (size_t)row * 1024 + idx) = pk4_fp8(v[q][j] * HX8_SCALE);
            }
        }
        float ga[2][16];
#pragma unroll
        for (int jg = 0; jg < 16; ++jg) {
            f32x4 s0 = (f32x4){0.f, 0.f, 0.f, 0.f}, s1 = s0;
#pragma unroll
            for (int j = 0; j < 4; ++j) {
                const f32x4 w = *(const f32x4*)(wgT + jg * 1024 + 4 * lane + 256 * j);
                s0 = __builtin_elementwise_fma(v[0][j], w, s0); s1 = __builtin_elementwise_fma(v[1][j], w, s1);
            }
            ga[0][jg] = (s0[0] + s0[1]) + (s0[2] + s0[3]); ga[1][jg] = (s1[0] + s1[1]) + (s1[2] + s1[3]);
            if ((jg & 3) == 3) __builtin_amdgcn_sched_barrier(0);
        }
        const float r0 = reduce16(ga[0], lane), r1 = reduce16(ga[1], lane);
        if ((lane & 3) == 0) {
            gp[(size_t)row0 * 16 + gi] = r0 + bb; gp[(size_t)(row0 + 1) * 16 + gi] = r1 + bb;
        }
    }
#undef P1_LOAD
}

__device__ __forceinline__ void phase3(const P& p, char* smem) {
    const int tid = tidx(), wid = tid >> 6, lane = tid & 63, fr = lane & 15, fq = lane >> 4;
    char* KT = smem;
    char* KTWf = smem + 17408;
    char* KTWb = smem + 2 * 17408;
    char* VT = smem + 3 * 17408;
    float* sc = (float*)(smem + 3 * 17408 + 34816);
    float *li_f = sc, *lf_f = sc + 128, *li_b = sc + 256, *lf_b = sc + 384, *bfa = sc + 512, *rba = sc + 640, *wf = sc + 768, *wb = sc + 896, *red = sc + 1024;
    const bf16_t* Kb = (const bf16_t*)(p.ws + WS_K); const bf16_t* V = (const bf16_t*)(p.ws + WS_V);
    const float* gp = (const float*)(p.ws + WS_GP);
    bf16_t* Cloc = (bf16_t*)(p.ws + WS_CLOC); float* Nloc = (float*)(p.ws + WS_NLOC); float* Scal = (float*)(p.ws + WS_SCAL);
    const int nitems = NB * NH * NCH;
    u32x4 rk[2], rv[4]; float rg[4];
#define P3_LOAD(it_) do { const int s_ = (it_) / (NH * NCH), h_ = ((it_) / NCH) % NH, r0_ = seq_row0(s_, (it_) % NCH); const int pr_ = tid >> 2; \
        const bf16_t* ks_ = Kb + (size_t)(r0_ + pr_) * 256 + h_ * 64 + (tid & 3) * 16; rk[0] = *(const u32x4*)ks_; rk[1] = *(const u32x4*)(ks_ + 8); \
        const bf16_t* vs_ = V + (size_t)(r0_ + pr_) * 512 + h_ * 128 + (tid & 3) * 32; _Pragma("unroll") for (int q = 0; q < 4; ++q) rv[q] = *(const u32x4*)(vs_ + 8 * q); \
        if (tid < 128) { const f32x4* g_ = (const f32x4*)(gp + (size_t)(r0_ + tid) * 16); const f32x4 g0 = g_[0], g1 = g_[1], g2 = g_[2], g3 = g_[3]; rg[0] = g0[h_]; rg[1] = g1[h_]; rg[2] = g2[h_]; rg[3] = g3[h_]; } } while (0)
    if ((int)blockIdx.x < nitems) P3_LOAD(blockIdx.x);
    for (int it = blockIdx.x; it < nitems; it += gridDim.x) {
        const int s = it / (NH * NCH), h = (it / NCH) % NH, cid = it % NCH;
        __syncthreads();
        {
            const int pr = tid >> 2, kc = (tid & 3) * 16, vc = (tid & 3) * 32;
            const unsigned w[8] = {rk[0].x, rk[0].y, rk[0].z, rk[0].w, rk[1].x, rk[1].y, rk[1].z, rk[1].w};
#pragma unroll
            for (int i = 0; i < 8; ++i) { *(bf16_t*)(KT + (kc + 2 * i) * 272 + pr * 2) = (bf16_t)(w[i] & 0xffff); *(bf16_t*)(KT + (kc + 2 * i + 1) * 272 + pr * 2) = (bf16_t)(w[i] >> 16); }
#pragma unroll
            for (int q = 0; q < 4; ++q) {
                const unsigned wv[4] = {rv[q].x, rv[q].y, rv[q].z, rv[q].w};
#pragma unroll
                for (int i = 0; i < 4; ++i) { *(bf16_t*)(VT + (vc + 8 * q + 2 * i) * 272 + pr * 2) = (bf16_t)(wv[i] & 0xffff); *(bf16_t*)(VT + (vc + 8 * q + 2 * i + 1) * 272 + pr * 2) = (bf16_t)(wv[i] >> 16); }
            }
            if (tid < 128) { li_f[tid] = rg[0]; lf_f[tid] = logsigmoidf_(rg[1]); li_b[tid] = rg[2]; lf_b[tid] = logsigmoidf_(rg[3]); }
        }
        { const int nx = it + gridDim.x; if (nx < nitems) P3_LOAD(nx); }
        __syncthreads();
        if (wid == 0) {
            const float x0 = lf_f[2 * lane], x1 = lf_f[2 * lane + 1];
            const float sc_ = wscan_up_add(x0 + x1, lane);
            const float btot = __shfl(sc_, 63);
            const float g0 = btot - (sc_ - x1) + li_f[2 * lane], g1 = btot - sc_ + li_f[2 * lane + 1];
            const float mx = wave_max(fmaxf(g0, g1));
            *(f32x2_t*)(wf + 2 * lane) = (f32x2_t){__expf(g0 - mx), __expf(g1 - mx)};
            if (lane == 0) { red[0] = mx; bfa[127] = btot; }
        } else if (wid == 1) {
            const float x0 = lf_b[2 * lane], x1 = lf_b[2 * lane + 1];
            const float sc_ = wscan_down_add(x0 + x1, lane);
            const float btot = __shfl(sc_, 0);
            const float g0 = btot - sc_ + li_b[2 * lane], g1 = btot - (sc_ - x0) + li_b[2 * lane + 1];
            const float mx = wave_max(fmaxf(g0, g1));
            *(f32x2_t*)(wb + 2 * lane) = (f32x2_t){__expf(g0 - mx), __expf(g1 - mx)};
            if (lane == 0) { red[1] = mx; rba[0] = btot; }
        }
        __syncthreads();
#pragma unroll
        for (int rep = 0; rep < 2; ++rep) {
            const int i = tid + rep * NTHREADS, k = i >> 4, p8 = i & 15;
            const u32x4 kv = *(const u32x4*)(KT + k * 272 + p8 * 16);
            const f32x4 f0 = *(const f32x4*)(wf + 8 * p8), f1 = *(const f32x4*)(wf + 8 * p8 + 4), b0 = *(const f32x4*)(wb + 8 * p8), b1 = *(const f32x4*)(wb + 8 * p8 + 4);
            const float e[8] = {__uint_as_float(kv.x << 16), __uint_as_float(kv.x & 0xffff0000u), __uint_as_float(kv.y << 16), __uint_as_float(kv.y & 0xffff0000u),
                                __uint_as_float(kv.z << 16), __uint_as_float(kv.z & 0xffff0000u), __uint_as_float(kv.w << 16), __uint_as_float(kv.w & 0xffff0000u)};
            u32x4 of, ob;
            of.x = g8::cvt_pk_bf16(e[0] * f0[0], e[1] * f0[1]); of.y = g8::cvt_pk_bf16(e[2] * f0[2], e[3] * f0[3]); of.z = g8::cvt_pk_bf16(e[4] * f1[0], e[5] * f1[1]); of.w = g8::cvt_pk_bf16(e[6] * f1[2], e[7] * f1[3]);
            ob.x = g8::cvt_pk_bf16(e[0] * b0[0], e[1] * b0[1]); ob.y = g8::cvt_pk_bf16(e[2] * b0[2], e[3] * b0[3]); ob.z = g8::cvt_pk_bf16(e[4] * b1[0], e[5] * b1[1]); ob.w = g8::cvt_pk_bf16(e[6] * b1[2], e[7] * b1[3]);
            *(u32x4*)(KTWf + k * 272 + p8 * 16) = of; *(u32x4*)(KTWb + k * 272 + p8 * 16) = ob;
        }
        const int chain_f = (s * NH + h) * 2, chain_b = chain_f + 1;
        if (tid < 128) {
            const int dir = tid >> 6, k = tid & 63; const float* w = dir ? wb : wf;
            float a = 0.f;
#pragma unroll 4
            for (int p8 = 0; p8 < 16; ++p8) {
                const u32x4 kv = *(const u32x4*)(KT + k * 272 + p8 * 16);
                const f32x4 w0 = *(const f32x4*)(w + 8 * p8), w1 = *(const f32x4*)(w + 8 * p8 + 4);
                a += w0[0] * __uint_as_float(kv.x << 16) + w0[1] * __uint_as_float(kv.x & 0xffff0000u) + w0[2] * __uint_as_float(kv.y << 16) + w0[3] * __uint_as_float(kv.y & 0xffff0000u)
                   + w1[0] * __uint_as_float(kv.z << 16) + w1[1] * __uint_as_float(kv.z & 0xffff0000u) + w1[2] * __uint_as_float(kv.w << 16) + w1[3] * __uint_as_float(kv.w & 0xffff0000u);
            }
            Nloc[((size_t)(chain_f + dir) * NCH + cid) * 64 + k] = a;
        }
        if (tid == 0) {
            Scal[((size_t)chain_f * NCH + cid) * 2 + 0] = red[0]; Scal[((size_t)chain_f * NCH + cid) * 2 + 1] = bfa[127];
            Scal[((size_t)chain_b * NCH + cid) * 2 + 0] = red[1]; Scal[((size_t)chain_b * NCH + cid) * 2 + 1] = rba[0];
        }
        __syncthreads();
#pragma unroll
        for (int dir = 0; dir < 2; ++dir) {
            const char* KW = dir ? KTWb : KTWf;
            f32x4 acc[4];
#pragma unroll
            for (int n = 0; n < 4; ++n) acc[n] = (f32x4){0.f, 0.f, 0.f, 0.f};
#pragma unroll
            for (int ks = 0; ks < 4; ++ks) {
                const bf16x8 a = *(const bf16x8*)(VT + (16 * wid + fr) * 272 + (32 * ks + 8 * fq) * 2);
#pragma unroll
                for (int n = 0; n < 4; ++n) { const bf16x8 b = *(const bf16x8*)(KW + (16 * n + fr) * 272 + (32 * ks + 8 * fq) * 2); acc[n] = __builtin_amdgcn_mfma_f32_16x16x32_bf16(b, a, acc[n], 0, 0, 0); }
            }
            bf16_t* dst = Cloc + ((size_t)(chain_f + dir) * NCH + cid) * 8192 + (16 * wid + fr) * 64;
#pragma unroll
            for (int n = 0; n < 4; ++n) { u32x2 o; o.x = pk2_sw(acc[n][0], acc[n][1]); o.y = pk2_sw(acc[n][2], acc[n][3]); *(u32x2*)(dst + 16 * n + 4 * fq) = o; }
        }
    }
#undef P3_LOAD
}

__device__ __forceinline__ void phase4(const P& p, char* smem) {
    const int tid = tidx();
    const bf16_t* Cloc = (const bf16_t*)(p.ws + WS_CLOC); const float* Nloc = (const float*)(p.ws + WS_NLOC); const float* Scal = (const float*)(p.ws + WS_SCAL);
    bf16_t* Cprev = (bf16_t*)(p.ws + WS_CPREV); float* Nprev = (float*)(p.ws + WS_NPREV); float* Mprev = (float*)(p.ws + WS_MPREV);
    float* sl = (float*)smem;
    for (int it = blockIdx.x; it < 32 * 8; it += gridDim.x) {
        const int chain = it >> 3, slice = it & 7, dir = chain & 1;
        __syncthreads();
        for (int i = tid; i < NCH * 2; i += NTHREADS) sl[i] = Scal[(size_t)chain * NCH * 2 + i];
        __syncthreads();
        const int e0 = slice * 1024 + tid * 2;
        float c0 = 0.f, c1 = 0.f, nn = 0.f, m = 0.f;
        const bool do_n = (slice == 0 && tid < 64);
        float l0[2][11], l1[2][11], ln[2][11];
#define SCAN_LOAD(buf, st0_) do { _Pragma("unroll") for (int i = 0; i < 11; ++i) { \
            const int st = (st0_) + i, cid = dir == 0 ? st : (st < 2 ? 1 - st : NCH + 1 - st); \
            const unsigned v = *(const unsigned*)(Cloc + ((size_t)chain * NCH + cid) * 8192 + e0); l0[buf][i] = __uint_as_float(v << 16); l1[buf][i] = __uint_as_float(v & 0xffff0000u); \
            ln[buf][i] = do_n ? Nloc[((size_t)chain * NCH + cid) * 64 + tid] : 0.f; } } while (0)
#define SCAN_STEP(buf, st0_) do { _Pragma("unroll") for (int i = 0; i < 11; ++i) { \
            const int st = (st0_) + i, cid = dir == 0 ? st : (st < 2 ? 1 - st : NCH + 1 - st); \
            if (cid >= 2) { const size_t o = (size_t)chain * 64 + (cid - 2); *(unsigned*)(Cprev + o * 8192 + e0) = pk2(c0, c1); if (do_n) Nprev[o * 64 + tid] = nn; if (slice == 0 && tid == 0) Mprev[o] = m; } \
            const float ml = sl[cid * 2 + 0], bt = sl[cid * 2 + 1]; \
            const float mnew = fmaxf(bt + m, ml), a = __expf(bt + m - mnew), e = __expf(ml - mnew); \
            c0 = a * c0 + e * l0[buf][i]; c1 = a * c1 + e * l1[buf][i]; nn = a * nn + e * ln[buf][i]; m = mnew; } } while (0)
        SCAN_LOAD(0, 0);
#pragma unroll 1
        for (int st0 = 0; st0 < NCH; st0 += 22) {
            SCAN_LOAD(1, st0 + 11);
            SCAN_STEP(0, st0);
            if (st0 + 22 < NCH) SCAN_LOAD(0, st0 + 22);
            SCAN_STEP(1, st0 + 11);
        }
#undef SCAN_LOAD
#undef SCAN_STEP
    }
}

struct MlstmRegs { u32x4 q[2], k[2], cf[2], cb[2], v[4]; float g[4]; float np, mpf, mpb; };
__device__ __forceinline__ void mlstm_load(const P& p, int it, MlstmRegs& R) {
    const int tid = tidx();
    const int b = it >> 8, h = (it >> 6) & 3, c = it & 63, row0 = b * T + c * 128;
    const bf16_t* Q = (const bf16_t*)(p.ws + WS_Q); const bf16_t* Kb = (const bf16_t*)(p.ws + WS_K); const bf16_t* V = (const bf16_t*)(p.ws + WS_V);
    const float* gp = (const float*)(p.ws + WS_GP);
    const bf16_t* Cprev = (const bf16_t*)(p.ws + WS_CPREV); const float* Nprev = (const float*)(p.ws + WS_NPREV); const float* Mprev = (const float*)(p.ws + WS_MPREV);
    const int chain_f = (b * NH + h) * 2;
    const size_t of = (size_t)chain_f * 64 + c, ob = (size_t)(chain_f + 1) * 64 + c;
    const int pr = tid >> 2, kc = (tid & 3) * 16, vc = (tid & 3) * 32;
    const bf16_t* qs = Q + (size_t)(row0 + pr) * 256 + h * 64 + kc; const bf16_t* ks = Kb + (size_t)(row0 + pr) * 256 + h * 64 + kc;
    const bf16_t* cfs = Cprev + of * 8192 + pr * 64 + kc; const bf16_t* cbs = Cprev + ob * 8192 + pr * 64 + kc;
    const bf16_t* vs = V + (size_t)(row0 + pr) * 512 + h * 128 + vc;
    R.q[0] = *(const u32x4*)qs; R.q[1] = *(const u32x4*)(qs + 8); R.k[0] = *(const u32x4*)ks; R.k[1] = *(const u32x4*)(ks + 8);
    R.cf[0] = *(const u32x4*)cfs; R.cf[1] = *(const u32x4*)(cfs + 8); R.cb[0] = *(const u32x4*)cbs; R.cb[1] = *(const u32x4*)(cbs + 8);
#pragma unroll
    for (int q = 0; q < 4; ++q) R.v[q] = *(const u32x4*)(vs + 8 * q);
    if (tid < 128) { const f32x4* g = (const f32x4*)(gp + (size_t)(row0 + tid) * 16); const f32x4 g0 = g[0], g1 = g[1], g2 = g[2], g3 = g[3]; R.g[0] = g0[h]; R.g[1] = g1[h]; R.g[2] = g2[h]; R.g[3] = g3[h]; }
    else if (tid < 192) R.np = Nprev[of * 64 + tid - 128];
    else if (tid < 256) R.np = Nprev[ob * 64 + tid - 192];
    R.mpf = Mprev[of]; R.mpb = Mprev[ob];
}
__device__ __forceinline__ void mlstm_item(const P& p, int it, char* smem, const MlstmRegs& R) {
    const int tid = tidx(), wid = tid >> 6, lane = tid & 63, fr = lane & 15, fq = lane >> 4;
    const int b = it >> 8, h = (it >> 6) & 3, c = it & 63;
    const int row0 = b * T + c * 128;
    char* Qs = smem;
    char* Ks = smem + 18432;
    char* Cf = smem + 2 * 18432;
    char* Cb = smem + 3 * 18432;
    char* VT = smem + 4 * 18432;
    char* Ps = VT + 34816;
    float* sc = (float*)(Ps + 34816);
    float *li_f = sc, *lf_f = sc + 128, *li_b = sc + 256, *lf_b = sc + 384, *beta_f = sc + 768, *beta_b = sc + 896,
          *alpha_f = sc + 1024, *alpha_b = sc + 1152, *eint_f = sc + 1280, *eint_b = sc + 1408, *emm_f = sc + 1536, *emm_b = sc + 1664, *nq_f = sc + 1792, *nq_b = sc + 1920,
          *cfa = sc + 2048, *cba = sc + 2176, *npf = sc + 2304, *npb = sc + 2368;
    const bf16_t* SO = (const bf16_t*)(p.ws + WS_SO);
    unsigned char* mix = (unsigned char*)(p.ws + WS_MIX);
    {
        const int pr = tid >> 2, kc = (tid & 3) * 16, vc = (tid & 3) * 32;
        *(u32x4*)(Qs + pr * 144 + kc * 2) = R.q[0]; *(u32x4*)(Qs + pr * 144 + kc * 2 + 16) = R.q[1];
        *(u32x4*)(Ks + pr * 144 + kc * 2) = R.k[0]; *(u32x4*)(Ks + pr * 144 + kc * 2 + 16) = R.k[1];
        *(u32x4*)(Cf + pr * 144 + kc * 2) = R.cf[0]; *(u32x4*)(Cf + pr * 144 + kc * 2 + 16) = R.cf[1];
        *(u32x4*)(Cb + pr * 144 + kc * 2) = R.cb[0]; *(u32x4*)(Cb + pr * 144 + kc * 2 + 16) = R.cb[1];
#pragma unroll
        for (int q = 0; q < 4; ++q) {
            const unsigned w[4] = {R.v[q].x, R.v[q].y, R.v[q].z, R.v[q].w};
#pragma unroll
            for (int i = 0; i < 4; ++i) { *(bf16_t*)(VT + (vc + 8 * q + 2 * i) * 272 + pr * 2) = (bf16_t)(w[i] & 0xffff); *(bf16_t*)(VT + (vc + 8 * q + 2 * i + 1) * 272 + pr * 2) = (bf16_t)(w[i] >> 16); }
        }
        if (tid < 128) { li_f[tid] = R.g[0]; lf_f[tid] = logsigmoidf_(R.g[1]); li_b[tid] = R.g[2]; lf_b[tid] = logsigmoidf_(R.g[3]); }
        else if (tid < 192) npf[tid - 128] = R.np;
        else if (tid < 256) npb[tid - 192] = R.np;
    }
    const float mpf = R.mpf, mpb = R.mpb;
    __syncthreads();
    if (wid == 0) {
        const float x0 = lf_f[2 * lane], x1 = lf_f[2 * lane + 1];
        const float sc_ = wscan_up_add(x0 + x1, lane);
        const float b0 = sc_ - x1, b1 = sc_;
        const float be0 = li_f[2 * lane] - b0, be1 = li_f[2 * lane + 1] - b1;
        const float msc = wscan_up_max(fmaxf(be0, be1), lane);
        float ex = __shfl_up(msc, 1); if (lane == 0) ex = -INFINITY;
        const float pm0 = fmaxf(ex, be0), pm1 = msc;
        const float a0 = b0 + mpf, a1 = b1 + mpf, m0 = fmaxf(a0, b0 + pm0), m1 = fmaxf(a1, b1 + pm1);
        *(f32x2_t*)(beta_f + 2 * lane) = (f32x2_t){be0, be1};
        *(f32x2_t*)(alpha_f + 2 * lane) = (f32x2_t){b0 - m0, b1 - m1};
        *(f32x2_t*)(eint_f + 2 * lane) = (f32x2_t){__expf(a0 - m0), __expf(a1 - m1)};
        *(f32x2_t*)(emm_f + 2 * lane) = (f32x2_t){__expf(-m0), __expf(-m1)};
    } else if (wid == 1) {
        const float x0 = lf_b[2 * lane], x1 = lf_b[2 * lane + 1];
        const float sc_ = wscan_down_add(x0 + x1, lane);
        const float b0 = sc_, b1 = sc_ - x0;
        const float be0 = li_b[2 * lane] - b0, be1 = li_b[2 * lane + 1] - b1;
        const float msc = wscan_down_max(fmaxf(be0, be1), lane);
        float ex = __shfl_down(msc, 1); if (lane == 63) ex = -INFINITY;
        const float pm1 = fmaxf(ex, be1), pm0 = msc;
        const float a0 = b0 + mpb, a1 = b1 + mpb, m0 = fmaxf(a0, b0 + pm0), m1 = fmaxf(a1, b1 + pm1);
        *(f32x2_t*)(beta_b + 2 * lane) = (f32x2_t){be0, be1};
        *(f32x2_t*)(alpha_b + 2 * lane) = (f32x2_t){b0 - m0, b1 - m1};
        *(f32x2_t*)(eint_b + 2 * lane) = (f32x2_t){__expf(a0 - m0), __expf(a1 - m1)};
        *(f32x2_t*)(emm_b + 2 * lane) = (f32x2_t){__expf(-m0), __expf(-m1)};
    } else if (wid < 4) {
        const int t = tid - 128; float a = 0.f, bsum = 0.f;
#pragma unroll
        for (int k8 = 0; k8 < 8; ++k8) {
            const u32x4 qv = *(const u32x4*)(Qs + t * 144 + k8 * 16);
            const float q[8] = {__uint_as_float(qv.x << 16), __uint_as_float(qv.x & 0xffff0000u), __uint_as_float(qv.y << 16), __uint_as_float(qv.y & 0xffff0000u),
                                __uint_as_float(qv.z << 16), __uint_as_float(qv.z & 0xffff0000u), __uint_as_float(qv.w << 16), __uint_as_float(qv.w & 0xffff0000u)};
#pragma unroll
            for (int c = 0; c < 8; ++c) { a += npf[8 * k8 + c] * q[c]; bsum += npb[8 * k8 + c] * q[c]; }
        }
        nq_f[t] = a; nq_b[t] = bsum;
    }
    __syncthreads();
    {
        f32x4 acc[8];
#pragma unroll
        for (int n = 0; n < 8; ++n) acc[n] = (f32x4){0.f, 0.f, 0.f, 0.f};
#pragma unroll
        for (int ks = 0; ks < 2; ++ks) {
            const bf16x8 a = *(const bf16x8*)(Qs + (16 * wid + fr) * 144 + (32 * ks + 8 * fq) * 2);
#pragma unroll
            for (int n = 0; n < 8; ++n) { const bf16x8 bb = *(const bf16x8*)(Ks + (16 * n + fr) * 144 + (32 * ks + 8 * fq) * 2); acc[n] = __builtin_amdgcn_mfma_f32_16x16x32_bf16(bb, a, acc[n], 0, 0, 0); }
        }
        const int t = 16 * wid + fr;
        const float af = alpha_f[t], ab = alpha_b[t];
        float rsf = 0.f, rsb = 0.f;
        f32x4 sf[8], sb[8];
#pragma unroll
        for (int n = 0; n < 8; ++n) {
            const f32x4 bf4 = *(const f32x4*)(beta_f + 16 * n + 4 * fq), bb4 = *(const f32x4*)(beta_b + 16 * n + 4 * fq);
#pragma unroll
            for (int j = 0; j < 4; ++j) {
                const int s = 16 * n + 4 * fq + j; const float qk = acc[n][j];
                const float vf = s <= t ? qk * __expf(af + bf4[j]) : 0.f;
                const float vb = s >= t ? qk * __expf(ab + bb4[j]) : 0.f;
                sf[n][j] = vf; sb[n][j] = vb; rsf += vf; rsb += vb;
            }
        }
        rsf += __shfl_xor(rsf, 16); rsf += __shfl_xor(rsf, 32); rsb += __shfl_xor(rsb, 16); rsb += __shfl_xor(rsb, 32);
        const float denf = rsf + eint_f[t] * nq_f[t], denb = rsb + eint_b[t] * nq_b[t];
        const float rf = 1.0f / fmaxf(fabsf(denf), emm_f[t]), rb = 1.0f / fmaxf(fabsf(denb), emm_b[t]);
        if (fq == 0) { cfa[t] = eint_f[t] * rf; cba[t] = eint_b[t] * rb; }
#pragma unroll
        for (int n = 0; n < 8; ++n) {
            const f32x4 pv = rf * sf[n] + rb * sb[n];
            u32x2 o; o.x = g8::cvt_pk_bf16(pv[0], pv[1]); o.y = g8::cvt_pk_bf16(pv[2], pv[3]);
            *(u32x2*)(Ps + t * 272 + (16 * n + 4 * fq) * 2) = o;
        }
    }
    __syncthreads();
    {
        f32x4 aP[8], aT[8];
        const int t = 16 * wid + fr;
        const float cf = cfa[t], cb = cba[t];
        u32x2 sov[8];
#pragma unroll
        for (int n = 0; n < 8; ++n) sov[n] = *(const u32x2*)(SO + ((size_t)row0 + t) * 512 + h * 128 + 16 * n + 4 * fq);
#pragma unroll
        for (int n = 0; n < 8; ++n) aT[n] = (f32x4){0.f, 0.f, 0.f, 0.f};
#pragma unroll
        for (int ks = 0; ks < 2; ++ks) {
            const bf16x8 a = *(const bf16x8*)(Qs + (16 * wid + fr) * 144 + (32 * ks + 8 * fq) * 2);
#pragma unroll
            for (int n = 0; n < 8; ++n) { const bf16x8 b1 = *(const bf16x8*)(Cf + (16 * n + fr) * 144 + (32 * ks + 8 * fq) * 2); aT[n] = __builtin_amdgcn_mfma_f32_16x16x32_bf16(b1, a, aT[n], 0, 0, 0); }
        }
#pragma unroll
        for (int n = 0; n < 8; ++n) { aP[n] = cf * aT[n]; aT[n] = (f32x4){0.f, 0.f, 0.f, 0.f}; }
#pragma unroll
        for (int ks = 0; ks < 2; ++ks) {
            const bf16x8 a = *(const bf16x8*)(Qs + (16 * wid + fr) * 144 + (32 * ks + 8 * fq) * 2);
#pragma unroll
            for (int n = 0; n < 8; ++n) { const bf16x8 b2 = *(const bf16x8*)(Cb + (16 * n + fr) * 144 + (32 * ks + 8 * fq) * 2); aT[n] = __builtin_amdgcn_mfma_f32_16x16x32_bf16(b2, a, aT[n], 0, 0, 0); }
        }
#pragma unroll
        for (int n = 0; n < 8; ++n) aP[n] = aP[n] + cb * aT[n];
#pragma unroll 1
        for (int ks = 0; ks < 4; ++ks) {
            const bf16x8 a = *(const bf16x8*)(Ps + (16 * wid + fr) * 272 + (32 * ks + 8 * fq) * 2);
#pragma unroll
            for (int n = 0; n < 8; ++n) { const bf16x8 bb = *(const bf16x8*)(VT + (16 * n + fr) * 272 + (32 * ks + 8 * fq) * 2); aP[n] = __builtin_amdgcn_mfma_f32_16x16x32_bf16(bb, a, aP[n], 0, 0, 0); }
        }
        float ss = 0.f;
#pragma unroll
        for (int n = 0; n < 8; ++n) ss += aP[n][0] * aP[n][0] + aP[n][1] * aP[n][1] + aP[n][2] * aP[n][2] + aP[n][3] * aP[n][3];
        ss += __shfl_xor(ss, 16); ss += __shfl_xor(ss, 32);
        const float inv = rsqrtf(ss * (1.0f / 128.0f) + EPS);
        const size_t row = (size_t)row0 + t;
#pragma unroll
        for (int n = 0; n < 8; ++n) {
            const int v = 16 * n + 4 * fq;
            const f32x4 g = *(const f32x4*)((const float*)(smem + 153600) + h * 128 + v);
            const u32x2 so = sov[n];
            const float s0 = __uint_as_float(so.x << 16), s1 = __uint_as_float(so.x & 0xffff0000u), s2 = __uint_as_float(so.y << 16), s3 = __uint_as_float(so.y & 0xffff0000u);
            *(unsigned*)(mix + row * 1024 + h * 128 + v) = pk4_fp8((f32x4){aP[n][0] * inv * g[0] * s0, aP[n][1] * inv * g[1] * s1, aP[n][2] * inv * g[2] * s2, aP[n][3] * inv * g[3] * s3} * MIX_SCALE);
        }
    }
}

__device__ __forceinline__ void conv_load(const P& p, int it, u32x4 (&U8)[8]) {
    const bf16_t* U = (const bf16_t*)(p.ws + WS_U) + (size_t)it * 64 * 512;
    const int tid = tidx();
#pragma unroll
    for (int i = 0; i < 8; ++i) U8[i] = *(const u32x4*)(U + (size_t)(tid + 512 * i) * 8);
}
__device__ __forceinline__ void conv_stage(char* smem, const u32x4 (&U8)[8]) {
    const int tid = tidx();
    char* ul = smem + 1024 + 15 * 1024;
#pragma unroll
    for (int i = 0; i < 8; ++i) *(u32x4*)(ul + (size_t)(tid + 512 * i) * 16) = U8[i];
}
__device__ __forceinline__ void conv_item(const P& p, int it, char* smem, const f32x2_t (&w2)[16], const float cb, const float lg, const float lb) {
    const int tid = tidx(), lane = tid & 63;
    const int row0 = it * 64;
    unsigned char* mix = (unsigned char*)(p.ws + WS_MIX);
    float* stat = (float*)smem;
    const bf16_t* up = (const bf16_t*)(smem + 1024);
    bf16_t* yl = (bf16_t*)(smem + 1024 + 94 * 1024);
    const int ch = tid;
#pragma unroll
    for (int i = 0; i < 15; ++i) { ((bf16_t*)(smem + 1024))[i * 512 + ch] = 0; ((bf16_t*)(smem + 1024 + 79 * 1024))[i * 512 + ch] = 0; }
    __syncthreads();
#pragma unroll 1
    for (int g = 0; g < 4; ++g) {
        f32x2_t ua[23], ub[23];
#pragma unroll
        for (int k = 0; k < 23; ++k) {
            const float e0 = bf2f(up[(16 * g + 2 * k) * 512 + ch]), e1 = bf2f(up[(16 * g + 2 * k + 1) * 512 + ch]);
            ua[k][0] = e0; ua[k][1] = e1; ub[k][0] = e1; if (k > 0) ub[k - 1][1] = e0;
        }
        ub[22][1] = 0.f;
#pragma unroll
        for (int e = 0; e < 8; ++e) {
            f32x2_t a0 = (f32x2_t){cb, 0.f}, a1 = a0;
#pragma unroll
            for (int k = 0; k < 16; ++k) { a0 = __builtin_elementwise_fma(w2[k], ua[e + k], a0); a1 = __builtin_elementwise_fma(w2[k], ub[e + k], a1); }
            yl[(16 * g + 2 * e) * 512 + ch] = f2bf(a0[0] + a0[1]);
            yl[(16 * g + 2 * e + 1) * 512 + ch] = f2bf(a1[0] + a1[1]);
        }
    }
    __syncthreads();
    {
        const int pp = tid >> 3, sub = tid & 7;
        float s1 = 0.f, s2 = 0.f;
#pragma unroll
        for (int i = 0; i < 8; ++i) {
            const u32x4 v = *(const u32x4*)(yl + pp * 512 + sub * 64 + 8 * ((i + lane) & 7));
            const unsigned wv[4] = {v.x, v.y, v.z, v.w};
#pragma unroll
            for (int c = 0; c < 4; ++c) { const float lo = __uint_as_float(wv[c] << 16), hi = __uint_as_float(wv[c] & 0xffff0000u); s1 += lo + hi; s2 += lo * lo + hi * hi; }
        }
        s1 += __shfl_xor(s1, 1); s2 += __shfl_xor(s2, 1); s1 += __shfl_xor(s1, 2); s2 += __shfl_xor(s2, 2); s1 += __shfl_xor(s1, 4); s2 += __shfl_xor(s2, 4);
        if (sub == 0) { const float mu = s1 * (1.0f / 512.0f), var = fmaxf(s2 * (1.0f / 512.0f) - mu * mu, 0.f); stat[pp * 2] = mu; stat[pp * 2 + 1] = rsqrtf(var + EPS); }
    }
    __syncthreads();
#pragma unroll 8
    for (int pp = 0; pp < 64; ++pp) {
        const float z = (bf2f(yl[pp * 512 + ch]) - stat[pp * 2]) * stat[pp * 2 + 1] * lg + lb;
        yl[pp * 512 + ch] = f2bf(siluf_(z));
    }
    __syncthreads();
#pragma unroll
    for (int i = 0; i < 4; ++i) {
        const int q = tid + 512 * i, pp = q >> 5, c16 = (q & 31) * 16;
        const u32x4 a = *(const u32x4*)(yl + pp * 512 + c16), b = *(const u32x4*)(yl + pp * 512 + c16 + 8);
        const unsigned w[8] = {a.x, a.y, a.z, a.w, b.x, b.y, b.z, b.w};
        u32x4 o;
        o.x = pk4_fp8((f32x4){__uint_as_float(w[0] << 16), __uint_as_float(w[0] & 0xffff0000u), __uint_as_float(w[1] << 16), __uint_as_float(w[1] & 0xffff0000u)} * MIX_SCALE);
        o.y = pk4_fp8((f32x4){__uint_as_float(w[2] << 16), __uint_as_float(w[2] & 0xffff0000u), __uint_as_float(w[3] << 16), __uint_as_float(w[3] & 0xffff0000u)} * MIX_SCALE);
        o.z = pk4_fp8((f32x4){__uint_as_float(w[4] << 16), __uint_as_float(w[4] & 0xffff0000u), __uint_as_float(w[5] << 16), __uint_as_float(w[5] & 0xffff0000u)} * MIX_SCALE);
        o.w = pk4_fp8((f32x4){__uint_as_float(w[6] << 16), __uint_as_float(w[6] & 0xffff0000u), __uint_as_float(w[7] << 16), __uint_as_float(w[7] & 0xffff0000u)} * MIX_SCALE);
        *(u32x4*)(mix + (size_t)(row0 + pp) * 1024 + 512 + c16) = o;
    }
}

__device__ __forceinline__ void phase5(const P& p, char* smem) {
    {
        MlstmRegs R;
        int it = blockIdx.x;
        if (it < 1024) mlstm_load(p, it, R);
        { float* ng = (float*)(smem + 153600); const int t = tidx(); if (t < NH * 128) ng[t] = p.norm_g[t]; }
        for (; it < 1024; it += gridDim.x) {
            __syncthreads();
            const MlstmRegs C = R;
            const int nx = it + gridDim.x;
            if (nx < 1024) mlstm_load(p, nx, R);
            mlstm_item(p, it, smem, C);
        }
    }
    {
        u32x4 U8[8];
        int it = blockIdx.x;
        const int ch = tidx();
        f32x2_t w2[16];
#pragma unroll
        for (int k = 0; k < 16; ++k) { w2[k][0] = p.conv_w[(2 * k) * 512 + ch]; w2[k][1] = (2 * k + 1 < 31) ? p.conv_w[(2 * k + 1) * 512 + ch] : 0.f; }
        const float cb = p.conv_b[ch], lg = p.ln_g[ch], lb = p.ln_b[ch];
        if (it < 512) conv_load(p, it, U8);
        for (; it < 512; it += gridDim.x) {
            __syncthreads();
            conv_stage(smem, U8);
            const int nx = it + gridDim.x;
            if (nx < 512) conv_load(p, nx, U8);
            conv_item(p, it, smem, w2, cb, lg, lb);
        }
    }
}

__device__ __forceinline__ void phase7(const P& p, char* smem) {
    const int tid = tidx(), wid = tid >> 6, lane = tid & 63, fr = lane & 15, fq = lane >> 4;
    float* H = (float*)smem;
    float* LP = (float*)(smem + 65792);
    float* modl = (float*)(smem + 65792 + 32768);
    int* selE = (int*)(smem + 65792 + 32768 + 12288);
    float* selW = (float*)(smem + 65792 + 32768 + 12288 + 4096);
    int* rank = (int*)(smem + 65792 + 32768 + 12288 + 8192);
    int* ebase = (int*)(smem + 65792 + 32768 + 12288 + 12288);
    int* segcnt = ebase + 64;
    int* lcnt = segcnt;
    float* vls = (float*)(segcnt + 512);
    float* gvec = (float*)(smem + 131072);
    const float* modp = (const float*)(p.ws + WS_MODP);
    const bf16_t* yx = (const bf16_t*)(p.ws + WS_YX);
    unsigned char* hx2 = (unsigned char*)(p.ws + WS_HX);
    int* cursor = (int*)(p.ws + WS_CURSOR);
    int* ltok = (int*)(p.ws + WS_LTOK);
    int* slotE = (int*)(p.ws + WS_SLOTE); int* slotP = (int*)(p.ws + WS_SLOTP); float* slotW = (float*)(p.ws + WS_SLOTW);
    bf16x8 bh[4][4];
#pragma unroll
    for (int ks = 0; ks < 4; ++ks)
#pragma unroll
        for (int n = 0; n < 4; ++n) bh[ks][n] = *(const bf16x8*)(p.ws + WS_WRH + (size_t)((((wid * 4 + ks) * 4 + n) * 64 + lane) * 16));
    const float brt = p.b_router[lane];
    u32x4 nyw[2]; f32x4 nxa[2], nxb[2];
#define P7_LOAD(row_) do { const bf16_t* yr_ = yx + (size_t)(row_) * 1024; const float* xr_ = p.x + (size_t)(row_) * 1024; _Pragma("unroll") for (int jj = 0; jj < 2; ++jj) { \
        const int idx_ = 8 * lane + 512 * jj; nyw[jj] = *(const u32x4*)(yr_ + idx_); nxa[jj] = *(const f32x4*)(xr_ + idx_); nxb[jj] = *(const f32x4*)(xr_ + idx_ + 4); } } while (0)
    if ((int)blockIdx.x < NT / 128) P7_LOAD((size_t)blockIdx.x * 128 + 2 * wid);
    { const float a0 = p.g_post_mix[tid], a1 = p.g_post_mix[tid + NTHREADS], a2 = p.g_pre_ffn[tid], a3 = p.g_pre_ffn[tid + NTHREADS]; gvec[tid] = a0; gvec[tid + NTHREADS] = a1; gvec[1024 + tid] = a2; gvec[1024 + tid + NTHREADS] = a3; }
    for (int blk = blockIdx.x; blk < NT / 128; blk += gridDim.x) {
        const int b = (blk * 128) / T;
        __syncthreads();
        if (tidx() < 64) lcnt[tidx()] = 0;
        {
            const int t0 = tidx(); float t[6];
#pragma unroll
            for (int j = 0; j < 6; ++j) { const int i = t0 + j * NTHREADS, which = i >> 10, idx = i & 1023; t[j] = modval(modp, b, (which == 0 ? 2048 : (which == 1 ? 3072 : 4096)) + idx); }
#pragma unroll
            for (int j = 0; j < 6; ++j) modl[t0 + j * NTHREADS] = t[j];
        }
        __syncthreads();
        for (int g = 0; g < 8; ++g) {
#pragma unroll 1
            for (int i = 0; i < 2; ++i) {
                const int lr = 2 * wid + i; const size_t row = (size_t)blk * 128 + g * 16 + lr;
                bf16_t* x1row = (bf16_t*)(p.ws + WS_X1B) + row * 1024;
                float y[16], xv[16]; float ss = 0.f;
#pragma unroll
                for (int jj = 0; jj < 2; ++jj) {
                    const unsigned w[4] = {nyw[jj].x, nyw[jj].y, nyw[jj].z, nyw[jj].w};
#pragma unroll
                    for (int c = 0; c < 4; ++c) { y[8 * jj + 2 * c] = __uint_as_float(w[c] << 16); y[8 * jj + 2 * c + 1] = __uint_as_float(w[c] & 0xffff0000u); xv[8 * jj + c] = nxa[jj][c]; xv[8 * jj + 4 + c] = nxb[jj][c]; }
                }
                {
                    const bool more = !(g == 7 && i == 1) || (blk + (int)gridDim.x < NT / 128);
                    const size_t nrow = i == 0 ? row + 1 : (g < 7 ? row + 15 : (size_t)(blk + gridDim.x) * 128 + 2 * wid);
                    if (more) P7_LOAD(nrow);
                }
#pragma unroll
                for (int c = 0; c < 16; ++c) ss += y[c] * y[c];
                ss = wave_sum(ss);
                const float invy = rsqrtf(ss * (1.0f / 1024.0f) + EPS);
                float s1 = 0.f;
#pragma unroll
                for (int q = 0; q < 4; ++q) {
                    const int idx = 8 * lane + 512 * (q >> 1) + 4 * (q & 1);
                    const f32x4 gt = *(const f32x4*)(modl + idx), gp = *(const f32x4*)(gvec + idx);
#pragma unroll
                    for (int c = 0; c < 4; ++c) { const float v = xv[4 * q + c] + gt[c] * (y[4 * q + c] * invy * gp[c]); xv[4 * q + c] = v; s1 += v * v; }
                }
#pragma unroll
                for (int jj = 0; jj < 2; ++jj) {
                    u32x4 o; o.x = pk2(xv[8 * jj], xv[8 * jj + 1]); o.y = pk2(xv[8 * jj + 2], xv[8 * jj + 3]); o.z = pk2(xv[8 * jj + 4], xv[8 * jj + 5]); o.w = pk2(xv[8 * jj + 6], xv[8 * jj + 7]);
                    *(u32x4*)(x1row + 8 * lane + 512 * jj) = o;
                }
                s1 = wave_sum(s1);
                const float inv1 = rsqrtf(s1 * (1.0f / 1024.0f) + EPS);
#pragma unroll
                for (int jj = 0; jj < 2; ++jj) {
                    const int idx = 8 * lane + 512 * jj;
                    float hv[8];
#pragma unroll
                    for (int h4 = 0; h4 < 2; ++h4) {
                        const f32x4 g2 = *(const f32x4*)(gvec + 1024 + idx + 4 * h4), sh = *(const f32x4*)(modl + 1024 + idx + 4 * h4), sc = *(const f32x4*)(modl + 2048 + idx + 4 * h4);
#pragma unroll
                        for (int c = 0; c < 4; ++c) hv[4 * h4 + c] = xv[8 * jj + 4 * h4 + c] * inv1 * g2[c] * (1.0f + sc[c]) + sh[c];
                        *(f32x4*)(H + lr * 1028 + idx + 4 * h4) = (f32x4){hv[4 * h4], hv[4 * h4 + 1], hv[4 * h4 + 2], hv[4 * h4 + 3]};
                    }
                    u32x2 o; o.x = pk4_fp8((f32x4){hv[0], hv[1], hv[2], hv[3]} * HX2_SCALE); o.y = pk4_fp8((f32x4){hv[4], hv[5], hv[6], hv[7]} * HX2_SCALE);
                    *(u32x2*)(hx2 + row * 1024 + idx) = o;
                }
            }
            bf16x8 bl[4][4];
#define P7_BL(ks_) do { _Pragma("unroll") for (int n = 0; n < 4; ++n) bl[ks_][n] = *(const bf16x8*)(p.ws + WS_WRL + (size_t)((((wid * 4 + (ks_)) * 4 + n) * 64 + lane) * 16)); } while (0)
            P7_BL(0); P7_BL(1);
            __syncthreads();
            {
                f32x4 acc[4];
#pragma unroll
                for (int n = 0; n < 4; ++n) acc[n] = (f32x4){0.f, 0.f, 0.f, 0.f};
#pragma unroll
                for (int ks = 0; ks < 4; ++ks) {
                    if (ks == 1) { __builtin_amdgcn_sched_barrier(0); P7_BL(2); __builtin_amdgcn_sched_barrier(0); }
                    if (ks == 2) { __builtin_amdgcn_sched_barrier(0); P7_BL(3); __builtin_amdgcn_sched_barrier(0); }
                    const f32x4 h0 = *(const f32x4*)(H + fr * 1028 + 128 * wid + 32 * ks + 8 * fq), h1 = *(const f32x4*)(H + fr * 1028 + 128 * wid + 32 * ks + 8 * fq + 4);
                    const unsigned hh[4] = {pk2(h0[0], h0[1]), pk2(h0[2], h0[3]), pk2(h1[0], h1[1]), pk2(h1[2], h1[3])};
                    const unsigned ll[4] = {pk2(h0[0] - __uint_as_float(hh[0] << 16), h0[1] - __uint_as_float(hh[0] & 0xffff0000u)), pk2(h0[2] - __uint_as_float(hh[1] << 16), h0[3] - __uint_as_float(hh[1] & 0xffff0000u)),
                                            pk2(h1[0] - __uint_as_float(hh[2] << 16), h1[1] - __uint_as_float(hh[2] & 0xffff0000u)), pk2(h1[2] - __uint_as_float(hh[3] << 16), h1[3] - __uint_as_float(hh[3] & 0xffff0000u))};
                    u32x4 ahw = (u32x4){hh[0], hh[1], hh[2], hh[3]}, alw = (u32x4){ll[0], ll[1], ll[2], ll[3]};
                    asm volatile("s_nop 1" : "+v"(ahw), "+v"(alw));
                    const bf16x8 ah = __builtin_bit_cast(bf16x8, ahw), al = __builtin_bit_cast(bf16x8, alw);
#pragma unroll
                    for (int n = 0; n < 4; ++n) {
                        acc[n] = __builtin_amdgcn_mfma_f32_16x16x32_bf16(al, bh[ks][n], acc[n], 0, 0, 0);
                        acc[n] = __builtin_amdgcn_mfma_f32_16x16x32_bf16(ah, bl[ks][n], acc[n], 0, 0, 0);
                        acc[n] = __builtin_amdgcn_mfma_f32_16x16x32_bf16(ah, bh[ks][n], acc[n], 0, 0, 0);
                    }
                }
#pragma unroll
                for (int n = 0; n < 4; ++n)
#pragma unroll
                    for (int j = 0; j < 4; ++j) LP[(wid * 16 + 4 * fq + j) * 64 + 16 * n + fr] = acc[n][j];
            }
            __syncthreads();
            {
                float sg[2]; int kbv[2];
#pragma unroll
                for (int i = 0; i < 2; ++i) {
                    const int lr = 2 * wid + i;
                    float lg = 0.f;
#pragma unroll
                    for (int w8 = 0; w8 < 8; ++w8) lg += LP[(w8 * 16 + lr) * 64 + lane];
                    sg[i] = sigmoidf_(lg);
                    const float val = sg[i] + brt;
                    int kb = __float_as_int(val); kb ^= (kb >> 31) & 0x7fffffff; kb = (kb & ~63) | (63 - lane);
                    kbv[i] = kb;
                    ((int*)vls)[(wid * 2 + i) * 64 + lane] = kb;
                }
                asm volatile("s_waitcnt lgkmcnt(0)" ::: "memory");
#pragma unroll
                for (int i = 0; i < 2; ++i) {
                    const int* kl = (const int*)vls + (wid * 2 + i) * 64;
                    const int kb = kbv[i];
                    int rk = 0;
#pragma unroll
                    for (int j4 = 0; j4 < 16; ++j4) {
                        const u32x4 o = *(const u32x4*)(kl + 4 * j4);
                        rk += ((int)o.x > kb ? 1 : 0) + ((int)o.y > kb ? 1 : 0) + ((int)o.z > kb ? 1 : 0) + ((int)o.w > kb ? 1 : 0);
                    }
                    const bool sel = rk < TOPK;
                    const float ssum = wave_sum(sel ? sg[i] : 0.f);
                    const int rr = g * 16 + 2 * wid + i;
                    if (sel) { selE[rr * 8 + rk] = lane; selW[rr * 8 + rk] = sg[i] / ssum * 2.5f; rank[rr * 8 + rk] = atomicAdd(&lcnt[lane], 1); }
                }
            }
        }
        __syncthreads();
        {
            const int t2 = tidx();
            if (t2 < 64) { const int run = lcnt[t2]; ebase[t2] = run > 0 ? atomicAdd(&cursor[t2], run) : 0; }
        }
        __syncthreads();
        for (int i = tidx(); i < 1024; i += NTHREADS) {
            const int e = selE[i], pos = ebase[e] + rank[i];
            const int tokn = blk * 128 + (i >> 3);
            ltok[(size_t)e * LCAP + pos] = tokn;
            slotE[(size_t)tokn * 8 + (i & 7)] = e; slotP[(size_t)tokn * 8 + (i & 7)] = pos; slotW[(size_t)tokn * 8 + (i & 7)] = selW[i];
        }
    }
#undef P7_LOAD
#undef P7_BL
}

__device__ __forceinline__ float sigm(float x) { return __builtin_amdgcn_rcpf(1.0f + __expf(-x)); }

struct SchedDense {
    const char* A; const char* B; int nM, nN, KB;
    __device__ __forceinline__ bool next(int i, g8::Unit& u) const {
        int pm, pn; if (!g8::static_unit(i, nM, nN, pm, pn)) return false;
        u.A = A + (size_t)pm * 256 * KB; u.B = B + (size_t)pn * 256 * KB; u.x0 = pm; u.x1 = pn; u.x2 = 0; u.x3 = 0; return true;
    }
    __device__ __forceinline__ void aoffs(const g8::Unit&, const int (&)[2], const unsigned (&)[2], unsigned (&)[2][2]) const {}
};

struct EpiInProj {
    static constexpr int NST = 0;
    bf16_t *Q, *Kb, *V, *SO, *U; const float* b_in;
    __device__ __forceinline__ void operator()(const f32x4 (&acc)[2][2][4][2], const g8::Unit& u, int wr, int wc, int fr, int fq) const {
        const int pn = u.x1; const size_t row0 = (size_t)u.x0 * 256 + wr * 64 + fr;
        if (pn < 6) {
            bf16_t* base; int ld, cofs;
            if (pn == 0) { base = Q; ld = 256; cofs = 0; } else if (pn == 1) { base = Kb; ld = 256; cofs = 0; }
            else if (pn < 4) { base = V; ld = 512; cofs = (pn - 2) * 256; } else { base = SO; ld = 512; cofs = (pn - 4) * 256; }
#pragma unroll
            for (int bj = 0; bj < 2; ++bj) {
                const int c8 = bj * 128 + wc * 32 + 8 * fq;
                const f32x4 b0 = *(const f32x4*)(b_in + pn * 256 + c8), b1 = *(const f32x4*)(b_in + pn * 256 + c8 + 4);
#pragma unroll
                for (int ai = 0; ai < 2; ++ai)
#pragma unroll
                    for (int m = 0; m < 4; ++m) {
                        const size_t row = row0 + ai * 128 + m * 16;
                        f32x4 v0 = acc[ai][bj][m][0] + b0, v1 = acc[ai][bj][m][1] + b1;
                        if (pn == 1) { v0 = v0 * 0.125f; v1 = v1 * 0.125f; }
                        if (pn >= 4) {
#pragma unroll
                            for (int c = 0; c < 4; ++c) { v0[c] = sigm(v0[c]); v1[c] = sigm(v1[c]); }
                        }
                        u32x4 w; w.x = g8::cvt_pk_bf16(v0[0], v0[1]); w.y = g8::cvt_pk_bf16(v0[2], v0[3]); w.z = g8::cvt_pk_bf16(v1[0], v1[1]); w.w = g8::cvt_pk_bf16(v1[2], v1[3]);
                        *(u32x4*)(base + row * ld + cofs + c8) = w;
                    }
            }
        } else {
            const int ucol = (pn - 6) * 128 + wc * 32 + 8 * fq;
            const f32x4 a0 = *(const f32x4*)(b_in + 1552 + ucol), a1 = *(const f32x4*)(b_in + 1552 + ucol + 4);
            const f32x4 g0 = *(const f32x4*)(b_in + 2064 + ucol), g1 = *(const f32x4*)(b_in + 2064 + ucol + 4);
#pragma unroll
            for (int ai = 0; ai < 2; ++ai)
#pragma unroll
                for (int m = 0; m < 4; ++m) {
                    const size_t row = row0 + ai * 128 + m * 16;
                    const f32x4 ga0 = acc[ai][0][m][0] + a0, ga1 = acc[ai][0][m][1] + a1, gb0 = acc[ai][1][m][0] + g0, gb1 = acc[ai][1][m][1] + g1;
                    u32x4 w; w.x = g8::cvt_pk_bf16(ga0[0] * sigm(gb0[0]), ga0[1] * sigm(gb0[1])); w.y = g8::cvt_pk_bf16(ga0[2] * sigm(gb0[2]), ga0[3] * sigm(gb0[3]));
                    w.z = g8::cvt_pk_bf16(ga1[0] * sigm(gb1[0]), ga1[1] * sigm(gb1[1])); w.w = g8::cvt_pk_bf16(ga1[2] * sigm(gb1[2]), ga1[3] * sigm(gb1[3]));
                    *(u32x4*)(U + row * 512 + ucol) = w;
                }
        }
    }
};

__device__ __forceinline__ void ctx_kv_proj(const P& p, char* smem) {
    const int tid = tidx(), wid = tid >> 6, lane = tid & 63, fr = lane & 15, fq = lane >> 4, rf = wid & 3, kh = wid >> 2;
    const bf16_t* hx = (const bf16_t*)(p.ws + WS_HX) + (size_t)NT * 1024;
    const bf16_t* wt = (const bf16_t*)(p.ws + WS_WT_IN) + (size_t)256 * 1024;
    bf16_t* Kb = (bf16_t*)(p.ws + WS_K); bf16_t* V = (bf16_t*)(p.ws + WS_V);
    f32x4* red = (f32x4*)smem;
    for (int blk = blockIdx.x; blk < 256; blk += gridDim.x) {
        const int rb = blk >> 4, cb = blk & 15;
        const bf16_t* ap = hx + (size_t)(rb * 64 + rf * 16 + fr) * 1024 + kh * 512 + fq * 8;
        const bf16_t* bp = wt + (size_t)(cb * 48 + fr) * 1024 + kh * 512 + fq * 8;
        f32x4 acc[3];
#pragma unroll
        for (int n = 0; n < 3; ++n) acc[n] = (f32x4){0.f, 0.f, 0.f, 0.f};
#pragma unroll 8
        for (int ks = 0; ks < 16; ++ks) {
            const bf16x8 a = *(const bf16x8*)(ap + ks * 32);
#pragma unroll
            for (int n = 0; n < 3; ++n) { const bf16x8 b = *(const bf16x8*)(bp + (size_t)n * 16 * 1024 + ks * 32); acc[n] = __builtin_amdgcn_mfma_f32_16x16x32_bf16(b, a, acc[n], 0, 0, 0); }
        }
        __syncthreads();
        if (kh == 1) {
#pragma unroll
            for (int n = 0; n < 3; ++n) red[(rf * 3 + n) * 64 + lane] = acc[n];
        }
        __syncthreads();
        if (kh == 0) {
            const size_t row = (size_t)NT + rb * 64 + rf * 16 + fr;
#pragma unroll
            for (int n = 0; n < 3; ++n) {
                const int col = 256 + cb * 48 + n * 16 + 4 * fq;
                f32x4 v = acc[n] + red[(rf * 3 + n) * 64 + lane] + *(const f32x4*)(p.b_in + col);
                bf16_t* dst;
                if (col < 512) { v = v * 0.125f; dst = Kb + row * 256 + (col - 256); } else dst = V + row * 512 + (col - 512);
                u32x2 o; o.x = g8::cvt_pk_bf16(v[0], v[1]); o.y = g8::cvt_pk_bf16(v[2], v[3]);
                *(u32x2*)dst = o;
            }
        }
    }
}

struct MoeTab { int cnt[128]; int pt[129]; int cb[129]; };
__device__ __forceinline__ int vblock() { const int G = gridDim.x; return (G & 7) ? (int)blockIdx.x : (int)(blockIdx.x & 7) * (G >> 3) + (int)(blockIdx.x >> 3); }
struct MoeUnit { unsigned long long B; int arow, cnt, orow, pn, lbase, pad; };
constexpr int MAXU = 24;
constexpr int LDS_TAB = 131072;
constexpr int LDS_UTAB = LDS_TAB + 2048;
constexpr int LDS_TOK = LDS_UTAB + MAXU * 32;
static_assert(LDS_TOK + MAXU * 1024 <= 160 * 1024, "LDS tables overflow");

__device__ __forceinline__ void moe_prefix(const P& p, char* smem) {
    MoeTab* mt = (MoeTab*)(smem + LDS_TAB);
    const int* cursor = (const int*)(p.ws + WS_CURSOR);
    const int tid = tidx();
    __syncthreads();
    if (tid < 64) {
        const int c = cursor[tid], t = (c + 255) >> 8;
        int st = t, sc = c;
#pragma unroll
        for (int d = 1; d < 64; d <<= 1) { const int a1 = __shfl_up(st, d), a2 = __shfl_up(sc, d); if (tid >= d) { st += a1; sc += a2; } }
        mt->cnt[tid] = c; mt->pt[tid] = st - t; mt->cb[tid] = sc - c;
        const int tt = __shfl(st, 63), tc = __shfl(sc, 63);
        mt->cnt[64 + tid] = 0; mt->pt[64 + tid] = tt; mt->cb[64 + tid] = tc;
        if (tid == 0) { mt->pt[128] = tt; mt->cb[128] = tc; }
    }
    __syncthreads();
}

struct SchedMoe {
    const char* A; const MoeUnit* ut; const int* tok; int nloc, KB; bool gather;
    __device__ __forceinline__ bool next(int i, g8::Unit& u) const {
        if (i >= nloc) return false;
        const MoeUnit* q = ut + i;
        const unsigned blo = __builtin_amdgcn_readfirstlane((unsigned)(q->B & 0xffffffffull)), bhi = __builtin_amdgcn_readfirstlane((unsigned)(q->B >> 32));
        u.B = (const char*)(((unsigned long long)bhi << 32) | blo);
        u.x0 = __builtin_amdgcn_readfirstlane(q->cnt); u.x1 = __builtin_amdgcn_readfirstlane(q->pn); u.x2 = __builtin_amdgcn_readfirstlane(q->orow);
        u.x3 = i; u.A = gather ? A : A + (size_t)__builtin_amdgcn_readfirstlane(q->arow) * KB; return true;
    }
    __device__ __forceinline__ void aoffs(const g8::Unit& u, const int (&R)[2], const unsigned (&c2)[2], unsigned (&va)[2][2]) const {
#pragma unroll
        for (int h = 0; h < 2; ++h)
#pragma unroll
            for (int j = 0; j < 2; ++j) va[h][j] = (unsigned)(tok[u.x3 * 256 + h * 128 + R[j]] * KB) + c2[j];
    }
};

__device__ __forceinline__ void phase2(const P& p, char* smem) {
    ctx_kv_proj(p, smem);
    EpiInProj E; E.Q = (bf16_t*)(p.ws + WS_Q); E.Kb = (bf16_t*)(p.ws + WS_K); E.V = (bf16_t*)(p.ws + WS_V); E.SO = (bf16_t*)(p.ws + WS_SO); E.U = (bf16_t*)(p.ws + WS_U); E.b_in = p.b_in;
    {
        SchedDense S; S.A = (const char*)(p.ws + WS_HX); S.B = (const char*)(p.ws + WS_WT_IN); S.nM = NT / 256; S.nN = 4; S.KB = 2048;
        __syncthreads();
        g8::gemm<true, false, false, 127>((LAS unsigned char*)smem, 2048, S, E);
    }
    MoeUnit* ut = (MoeUnit*)(smem + LDS_UTAB); int* tok = (int*)(smem + LDS_TOK);
    const int nunits = (NT / 256) * 6;
    const int vb = vblock(), ntot = nunits > vb ? (nunits - vb + (int)gridDim.x - 1) / (int)gridDim.x : 0;
    for (int base = 0; base < ntot; base += MAXU) {
        const int nloc = (ntot - base) < MAXU ? (ntot - base) : MAXU;
        __syncthreads();
        if ((int)tidx() < nloc) {
            const int u = vb + (base + tidx()) * gridDim.x, pm = u / 6, pq = u % 6;
            MoeUnit q; q.pn = 4 + pq; q.pad = 0; q.lbase = 0; q.cnt = pm; q.arow = pm * 256; q.orow = q.arow;
            q.B = (unsigned long long)(p.ws + WS_WT_IN8 + (size_t)pq * 256 * 1024);
            ut[tidx()] = q;
        }
        __syncthreads();
        for (int idx = tidx(); idx < nloc * 256; idx += NTHREADS) tok[idx] = ut[idx >> 8].arow + (idx & 255);
        __syncthreads();
        SchedMoe S; S.A = (const char*)(p.ws + WS_HX8); S.ut = ut; S.tok = tok; S.nloc = nloc; S.KB = 1024; S.gather = true;
        g8::gemm<true, true, true, 127 - 8>((LAS unsigned char*)smem, 1024, S, E);
        __syncthreads();
    }
}

struct EpiOutProj {
    static constexpr int NST = 0;
    bf16_t* yx; const float* b_out;
    __device__ __forceinline__ void operator()(const f32x4 (&acc)[2][2][4][2], const g8::Unit& u, int wr, int wc, int fr, int fq) const {
        const size_t row0 = (size_t)u.x2 + wr * 64 + fr;
#pragma unroll
        for (int bj = 0; bj < 2; ++bj) {
            const int col = u.x1 * 256 + bj * 128 + wc * 32 + 8 * fq;
            const f32x4 b0 = *(const f32x4*)(b_out + col), b1 = *(const f32x4*)(b_out + col + 4);
#pragma unroll
            for (int ai = 0; ai < 2; ++ai)
#pragma unroll
                for (int m = 0; m < 4; ++m) {
                    const f32x4 v0 = acc[ai][bj][m][0] + b0, v1 = acc[ai][bj][m][1] + b1;
                    u32x4 w; w.x = g8::cvt_pk_bf16(v0[0], v0[1]); w.y = g8::cvt_pk_bf16(v0[2], v0[3]); w.z = g8::cvt_pk_bf16(v1[0], v1[1]); w.w = g8::cvt_pk_bf16(v1[2], v1[3]);
                    *(u32x4*)(yx + (row0 + ai * 128 + m * 16) * 1024 + col) = w;
                }
        }
    }
};

__device__ __forceinline__ void phase6(const P& p, char* smem) {
    MoeUnit* ut = (MoeUnit*)(smem + LDS_UTAB); int* tok = (int*)(smem + LDS_TOK);
    const int nunits = (NT / 256) * 4;
    const int vb = vblock(), ntot = nunits > vb ? (nunits - vb + (int)gridDim.x - 1) / (int)gridDim.x : 0;
    for (int base = 0; base < ntot; base += MAXU) {
        const int nloc = (ntot - base) < MAXU ? (ntot - base) : MAXU;
        __syncthreads();
        if ((int)tidx() < nloc) {
            const int u = vb + (base + tidx()) * gridDim.x;
            MoeUnit q; q.pn = u & 3; q.pad = 0; q.lbase = 0; q.cnt = 256; q.arow = (u >> 2) * 256; q.orow = q.arow;
            q.B = (unsigned long long)(p.ws + WS_WT_OUT + (size_t)q.pn * 256 * 1024);
            ut[tidx()] = q;
        }
        __syncthreads();
        for (int idx = tidx(); idx < nloc * 256; idx += NTHREADS) tok[idx] = ut[idx >> 8].arow + (idx & 255);
        __syncthreads();
        SchedMoe S; S.A = (const char*)(p.ws + WS_MIX); S.ut = ut; S.tok = tok; S.nloc = nloc; S.KB = 1024; S.gather = true;
        EpiOutProj E; E.yx = (bf16_t*)(p.ws + WS_YX); E.b_out = p.b_out;
        g8::gemm<true, true, true, 127 - 10>((LAS unsigned char*)smem, 1024, S, E);
        __syncthreads();
    }
}

struct EpiGateUp {
    static constexpr int NST = 8;
    unsigned char* act;
    __device__ __forceinline__ void operator()(const f32x4 (&acc)[2][2][4][2], const g8::Unit& u, int wr, int wc, int fr, int fq) const {
        unsigned char* base = act + (size_t)u.x2 * 256 + u.x1 * 128 + wc * 32 + 8 * fq;
#pragma unroll
        for (int ai = 0; ai < 2; ++ai)
#pragma unroll
            for (int m = 0; m < 4; ++m) {
                const int r = ai * 128 + wr * 64 + m * 16 + fr;
                const f32x4 g0 = acc[ai][0][m][0], g1 = acc[ai][0][m][1], u0 = acc[ai][1][m][0], u1 = acc[ai][1][m][1];
                f32x4 a0, a1;
#pragma unroll
                for (int c = 0; c < 4; ++c) { a0[c] = g0[c] * sigm(g0[c]) * u0[c]; a1[c] = g1[c] * sigm(g1[c]) * u1[c]; }
                u32x2 w; w.x = pk4_fp8(a0); w.y = pk4_fp8(a1);
                *(u32x2*)(base + r * 256) = w;
            }
    }
};

struct EpiDown {
    static constexpr int NST = 8;
    unsigned char* ye;
    __device__ __forceinline__ void operator()(const f32x4 (&acc)[2][2][4][2], const g8::Unit& u, int wr, int wc, int fr, int fq) const {
#pragma unroll
        for (int ai = 0; ai < 2; ++ai)
#pragma unroll
            for (int m = 0; m < 4; ++m) {
                const int r = ai * 128 + wr * 64 + m * 16 + fr;
                if (r < u.x0) {
                    u32x4 w; w.x = pk4_fp8(acc[ai][0][m][0]); w.y = pk4_fp8(acc[ai][0][m][1]); w.z = pk4_fp8(acc[ai][1][m][0]); w.w = pk4_fp8(acc[ai][1][m][1]);
                    *(u32x4*)(ye + (size_t)(u.x2 + r) * 1024 + ((u.x1 * 4 + wc) * 4 + fq) * 16) = w;
                }
            }
    }
};

__device__ __forceinline__ void phase9a(const P& p, char* smem) {
    moe_prefix(p, smem);
    const MoeTab* mt = (const MoeTab*)(smem + LDS_TAB);
    MoeUnit* ut = (MoeUnit*)(smem + LDS_UTAB); int* tok = (int*)(smem + LDS_TOK);
    const int* ltok = (const int*)(p.ws + WS_LTOK);
    const int TT = mt->pt[128], nunits = (TT + NT / 256) * 2;
    const int vb = vblock(), ntot = nunits > vb ? (nunits - vb + (int)gridDim.x - 1) / (int)gridDim.x : 0;
    for (int base = 0; base < ntot; base += MAXU) {
        const int nloc = (ntot - base) < MAXU ? (ntot - base) : MAXU;
        __syncthreads();
        if ((int)tidx() < nloc) {
            const int u = vb + (base + tidx()) * gridDim.x, mtile = u >> 1, pn = u & 1;
            MoeUnit q; q.pn = pn; q.pad = 0; q.arow = 0;
            if (mtile < TT) {
                int l = 0; { int hi = 63; while (l < hi) { const int mid = (l + hi) >> 1; if (mt->pt[mid + 1] > mtile) hi = mid; else l = mid + 1; } }
                const int ti = mtile - mt->pt[l], rem = mt->cnt[l] - ti * 256;
                q.cnt = rem < 256 ? rem : 256; q.orow = mtile * 256; q.lbase = l * LCAP + ti * 256;
                q.B = (unsigned long long)(p.ws + WS_WT_GU + ((size_t)(l & 63) * 512 + (size_t)pn * 256) * 1024);
            } else {
                const int s = mtile - TT;
                q.cnt = 256; q.orow = mtile * 256; q.lbase = -1 - s;
                q.B = (unsigned long long)(p.ws + WS_WT_GU + ((size_t)64 * 512 + (size_t)pn * 256) * 1024);
            }
            ut[tidx()] = q;
        }
        __syncthreads();
        for (int idx = tidx(); idx < nloc * 256; idx += NTHREADS) {
            const int i = idx >> 8, r = idx & 255; const int lb = ut[i].lbase, c = ut[i].cnt;
            tok[idx] = lb >= 0 ? ltok[lb + (r < c ? r : c - 1)] : (-1 - lb) * 256 + r;
        }
        __syncthreads();
        SchedMoe S; S.A = (const char*)(p.ws + WS_HX); S.ut = ut; S.tok = tok; S.nloc = nloc; S.KB = 1024; S.gather = true;
        EpiGateUp E; E.act = (unsigned char*)(p.ws + WS_ACT);
        g8::gemm<true, true, true, 127 - 8>((LAS unsigned char*)smem, 1024, S, E);
        __syncthreads();
    }
}

__device__ __forceinline__ void phase9b(const P& p, char* smem) {
    moe_prefix(p, smem);
    const MoeTab* mt = (const MoeTab*)(smem + LDS_TAB);
    MoeUnit* ut = (MoeUnit*)(smem + LDS_UTAB); int* tok = (int*)(smem + LDS_TOK);
    const int TT = mt->pt[128], nunits = (TT + NT / 256) * 4;
    const int vb = vblock(), ntot = nunits > vb ? (nunits - vb + (int)gridDim.x - 1) / (int)gridDim.x : 0;
    for (int base = 0; base < ntot; base += MAXU) {
        const int nloc = (ntot - base) < MAXU ? (ntot - base) : MAXU;
        __syncthreads();
        if ((int)tidx() < nloc) {
            const int u = vb + (base + tidx()) * gridDim.x, tl = u >> 2, pn = u & 3;
            MoeUnit q; q.pn = pn; q.pad = 0; q.lbase = 0;
            if (tl < TT) {
                int l = 0; { int hi = 63; while (l < hi) { const int mid = (l + hi) >> 1; if (mt->pt[mid + 1] > tl) hi = mid; else l = mid + 1; } }
                const int ti = tl - mt->pt[l], rem = mt->cnt[l] - ti * 256;
                q.cnt = 256; q.arow = tl * 256; q.orow = q.arow; (void)rem;
                q.B = (unsigned long long)(p.ws + WS_WT_D + ((size_t)(l & 63) * 1024 + (size_t)pn * 256) * 256);
            } else {
                const int sidx = tl - TT;
                q.cnt = 256; q.arow = tl * 256; q.orow = q.arow; (void)sidx;
                q.B = (unsigned long long)(p.ws + WS_WT_D + ((size_t)64 * 1024 + (size_t)pn * 256) * 256);
            }
            ut[tidx()] = q;
        }
        __syncthreads();
        for (int idx = tidx(); idx < nloc * 256; idx += NTHREADS) tok[idx] = ut[idx >> 8].arow + (idx & 255);
        __syncthreads();
        SchedMoe S; S.A = (const char*)(p.ws + WS_ACT); S.ut = ut; S.tok = tok; S.nloc = nloc; S.KB = 256; S.gather = true;
        EpiDown E; E.ye = (unsigned char*)(p.ws + WS_YE);
        int kb = 256; asm volatile("" : "+s"(kb));
        S.KB = kb;
        g8::gemm<true, true, true, 127>((LAS unsigned char*)smem, kb, S, E);
        __syncthreads();
    }
}

__device__ __forceinline__ void unpack_fp8x8(const u32x2 v, float (&f)[8]) {
    typedef float f2 __attribute__((ext_vector_type(2)));
    const f2 a = __builtin_amdgcn_cvt_pk_f32_fp8((int)v.x, false), b = __builtin_amdgcn_cvt_pk_f32_fp8((int)v.x, true);
    const f2 c = __builtin_amdgcn_cvt_pk_f32_fp8((int)v.y, false), d = __builtin_amdgcn_cvt_pk_f32_fp8((int)v.y, true);
    f[0] = a[0]; f[1] = a[1]; f[2] = b[0]; f[3] = b[1]; f[4] = c[0]; f[5] = c[1]; f[6] = d[0]; f[7] = d[1];
}
__device__ __forceinline__ void phase10(const P& p, char* smem) {
    moe_prefix(p, smem);
    const MoeTab* mt = (const MoeTab*)(smem + LDS_TAB);
    const int tid = tidx(), wid = tid >> 6, lane = tid & 63;
    float* modl = (float*)smem;
    const float* modp = (const float*)(p.ws + WS_MODP);
    {
        float t[8];
#pragma unroll
        for (int j = 0; j < 8; ++j) { const int i = tid + j * NTHREADS; t[j] = modval(modp, i >> 10, 5120 + (i & 1023)); }
#pragma unroll
        for (int j = 0; j < 8; ++j) modl[tid + j * NTHREADS] = t[j];
    }
    float* gl = modl + 4096;
    { const float a0 = p.g_post_ffn[tid], a1 = p.g_post_ffn[tid + NTHREADS]; gl[tid] = a0; gl[tid + NTHREADS] = a1; }
    __syncthreads();
    const unsigned char* ye = (const unsigned char*)(p.ws + WS_YE);
    const int* slotE = (const int*)(p.ws + WS_SLOTE); const int* slotP = (const int*)(p.ws + WS_SLOTP); const float* slotW = (const float*)(p.ws + WS_SLOTW);
    const int c0 = (lane >> 4) * 256 + ((lane >> 2) & 3) * 32 + (lane & 3) * 8;
    const int tstep = gridDim.x * 8;
    int sE = 0, sP = 0; float sW = 0.f;
    int nrow = 0; float nw = 0.f; u32x4 nrv[9], nxw[2];
#define P10_SLOTS(t_) do { if ((t_) < NT && lane < 8) { sE = slotE[(t_) * 8 + lane]; sP = slotP[(t_) * 8 + lane]; sW = slotW[(t_) * 8 + lane]; } } while (0)
#define P10_ROWS(t_) do { if ((t_) < NT) { nrow = lane < 8 ? mt->pt[sE] * 256 + sP : 0; nw = sW * (1.0f / YE_SCALE); \
        nrv[8] = *(const u32x4*)(ye + ((size_t)mt->pt[128] * 256 + (t_)) * 1024 + 16 * lane); \
        { const bf16_t* x1r_ = (const bf16_t*)(p.ws + WS_X1B) + (size_t)(t_) * 1024; nxw[0] = *(const u32x4*)(x1r_ + c0); nxw[1] = *(const u32x4*)(x1r_ + c0 + 128); } \
        _Pragma("unroll") for (int k = 0; k < 8; ++k) { const int row_ = __shfl(nrow, k); nrv[k] = *(const u32x4*)(ye + (size_t)row_ * 1024 + 16 * lane); } } } while (0)
    { const int t0 = blockIdx.x * 8 + wid; P10_SLOTS(t0); P10_ROWS(t0); P10_SLOTS(t0 + tstep); }
    for (int tokn = blockIdx.x * 8 + wid; tokn < NT; tokn += tstep) {
        u32x4 rv[9]; const float myw = nw; const u32x4 xw0 = nxw[0], xw1 = nxw[1];
#pragma unroll
        for (int k = 0; k < 9; ++k) rv[k] = nrv[k];
        P10_ROWS(tokn + tstep);
        P10_SLOTS(tokn + 2 * tstep);
        float a[16];
        {
            float f0[8], f1[8]; unpack_fp8x8((u32x2){rv[8].x, rv[8].y}, f0); unpack_fp8x8((u32x2){rv[8].z, rv[8].w}, f1);
#pragma unroll
            for (int i = 0; i < 8; ++i) { a[i] = f0[i] * (1.0f / YE_SCALE); a[8 + i] = f1[i] * (1.0f / YE_SCALE); }
        }
#pragma unroll
        for (int k = 0; k < 8; ++k) {
            const float wk = __shfl(myw, k);
            float f0[8], f1[8]; unpack_fp8x8((u32x2){rv[k].x, rv[k].y}, f0); unpack_fp8x8((u32x2){rv[k].z, rv[k].w}, f1);
#pragma unroll
            for (int i = 0; i < 8; ++i) { a[i] += wk * f0[i]; a[8 + i] += wk * f1[i]; }
        }
        float ss = 0.f;
#pragma unroll
        for (int i = 0; i < 16; ++i) ss += a[i] * a[i];
        ss = wave_sum(ss);
        const float inv = rsqrtf(ss * (1.0f / 1024.0f) + EPS);
        const float* gt = modl + (tokn / T) * 1024;
        float* orow = p.out + (size_t)tokn * 1024;
#pragma unroll
        for (int hh = 0; hh < 2; ++hh) {
            const u32x4 xw = hh ? xw1 : xw0;
            const unsigned wv[4] = {xw.x, xw.y, xw.z, xw.w};
#pragma unroll
            for (int q2 = 0; q2 < 2; ++q2) {
                const int idx = c0 + hh * 128 + q2 * 4, q = hh * 2 + q2;
                const f32x4 g = *(const f32x4*)(gl + idx), gg = *(const f32x4*)(gt + idx);
                f32x4 o;
                o[0] = __uint_as_float(wv[2 * q2] << 16); o[1] = __uint_as_float(wv[2 * q2] & 0xffff0000u); o[2] = __uint_as_float(wv[2 * q2 + 1] << 16); o[3] = __uint_as_float(wv[2 * q2 + 1] & 0xffff0000u);
#pragma unroll
                for (int c = 0; c < 4; ++c) o[c] += gg[c] * (a[q * 4 + c] * inv * g[c]);
                *(f32x4*)(orow + idx) = o;
            }
        }
    }
#undef P10_SLOTS
#undef P10_ROWS
}

#define XB_TMO      128
#define XB_XCNT(j)  (256  + 64 * (j))
#define XB_XSUB(j)  (1280 + 64 * (j))
#define XB_XGEN(j)  (2304 + 64 * (j))
#define XB_TOP      3328
#define XB_TOPGEN   3392
#define XCD_BAR_WORDS 3456
#define XB_SPIN_CAP (1u << 18)
__device__ __forceinline__ unsigned xb_ld(unsigned* p)              { return __hip_atomic_load(p, __ATOMIC_RELAXED, __HIP_MEMORY_SCOPE_AGENT); }
__device__ __forceinline__ unsigned xb_add(unsigned* p, unsigned v) { return __hip_atomic_fetch_add(p, v, __ATOMIC_RELAXED, __HIP_MEMORY_SCOPE_AGENT); }
__device__ __forceinline__ unsigned xb_xcc_id() { return (unsigned)__builtin_amdgcn_s_getreg((3 << 11) | 20) & 0xFu; }
#define XB_SPIN(cond, bar) do { unsigned _sp = 0; while (cond) { __builtin_amdgcn_s_sleep(1); \
    if ((++_sp & 255u) == 0u) { if (xb_ld(&(bar)[XB_TMO])) break; if (_sp > XB_SPIN_CAP) { atomicAdd(&(bar)[XB_TMO], 1u); break; } } } } while (0)
struct XcdBarrier { unsigned* bar; unsigned x; volatile LAS unsigned* st; };
__device__ __forceinline__ XcdBarrier xcd_barrier_post(unsigned* bar, volatile LAS unsigned* st) {
    XcdBarrier b; b.bar = bar; b.x = xb_xcc_id(); b.st = st;
    if (tidx() == 0) (void)xb_add(&bar[XB_XCNT(b.x)], 1u);
    return b;
}
__device__ __forceinline__ void xcd_barrier_complete(unsigned* bar, unsigned x, unsigned& nloc, unsigned& nx) {
    const unsigned G = gridDim.x * gridDim.y * gridDim.z;
    unsigned sum, cnt, mine, sp = 0u;
    for (;;) {
        sum = 0u; cnt = 0u; mine = 0u;
#pragma unroll
        for (unsigned j = 0; j < 16; ++j) { const unsigned c = xb_ld(&bar[XB_XCNT(j)]); sum += c; cnt += (c > 0u) ? 1u : 0u; mine = (j == x) ? c : mine; }
        if (sum == G) break;
        __builtin_amdgcn_s_sleep(1);
        if ((++sp & 255u) == 0u) { if (xb_ld(&bar[XB_TMO])) break; if (sp > XB_SPIN_CAP) { atomicAdd(&bar[XB_TMO], 1u); break; } }
    }
    nloc = mine > 0u ? mine : 1u; nx = cnt > 0u ? cnt : 1u;
}
__device__ __forceinline__ void xcd_barrier(const XcdBarrier& b) {
    asm volatile("s_waitcnt vmcnt(0)" ::: "memory");
    __syncthreads();
    if (tidx() == 0) {
        unsigned* bar = b.bar;
        __builtin_amdgcn_s_waitcnt(0);
        unsigned nloc = b.st[0], nx = b.st[1];
        if (nloc == 0u) { xcd_barrier_complete(bar, b.x, nloc, nx); b.st[0] = nloc; b.st[1] = nx; }
        const unsigned old = xb_add(&bar[XB_XSUB(b.x)], 1u);
        const unsigned gen = old / nloc;
        if (old + 1u == (gen + 1u) * nloc) {
            __builtin_amdgcn_fence(__ATOMIC_RELEASE, "agent");
            asm volatile("s_waitcnt vmcnt(0)" ::: "memory");
            const unsigned og = xb_add(&bar[XB_TOP], 1u);
            const unsigned tg = og / nx;
            if (og + 1u == (tg + 1u) * nx) xb_add(&bar[XB_TOPGEN], 1u);
            else XB_SPIN(xb_ld(&bar[XB_TOPGEN]) == tg, bar);
            __builtin_amdgcn_fence(__ATOMIC_ACQUIRE, "agent");
            xb_add(&bar[XB_XGEN(b.x)], 1u);
            asm volatile("s_waitcnt vmcnt(0)" ::: "memory");
        } else {
            XB_SPIN(xb_ld(&bar[XB_XGEN(b.x)]) == gen, bar);
            __builtin_amdgcn_fence(__ATOMIC_ACQUIRE, "agent");
            asm volatile("s_waitcnt vmcnt(0)" ::: "memory");
        }
    }
    __syncthreads();
}

constexpr int LDS_BYTES = 160 * 1024;
__global__ void __launch_bounds__(NTHREADS) k_mega(P p) {
    extern __shared__ __attribute__((aligned(16))) char smem[];
    cg::grid_group grid = cg::this_grid();
    volatile LAS unsigned* xbst = (volatile LAS unsigned*)(smem + 160 * 1024 - 64);
    if (tidx() == 0) { xbst[0] = 0u; xbst[1] = 0u; }
    __syncthreads();
    const XcdBarrier xb = xcd_barrier_post((unsigned*)(p.ws + WS_BAR), xbst);
#define RUN(bit, call) do { call; xcd_barrier(xb); if (DUP_MASK & (1 << (bit))) { call; xcd_barrier(xb); } } while (0)
    phase0(p, smem);
    if (p.ws == nullptr) grid.sync();
    if (DUP_MASK & 1) phase0(p, smem);
    RUN(1, phase1(p, smem));
    RUN(2, phase2(p, smem));
    RUN(3, phase3(p, smem));
    RUN(4, phase4(p, smem));
    RUN(5, phase5(p, smem));
    RUN(6, phase6(p, smem));
    phase7(p, smem); xcd_barrier(xb);
    if (DUP_MASK & 128) { if (blockIdx.x == 0 && tidx() < 128) ((int*)(p.ws + WS_CURSOR))[tidx()] = 0; xcd_barrier(xb); phase7(p, smem); xcd_barrier(xb); }
    RUN(8, phase9a(p, smem));
    RUN(9, phase9b(p, smem));
    phase10(p, smem);
#undef RUN
}

extern "C" void kernel_launch(void* const* d_in, const int* in_sizes, int n_in, void* d_out, int out_size, void* d_ws, size_t ws_size, hipStream_t stream) {
    if (n_in != 28 || ws_size < WS_END) { fprintf(stderr, "kernel_launch: unexpected inputs (%d) or workspace (%zu < %zu)\n", n_in, ws_size, (size_t)WS_END); return; }
    static int grid_blocks = 0;
    if (!grid_blocks) {
        int dev = 0, cus = 0, per_cu = 0;
        (void)hipGetDevice(&dev);
        (void)hipDeviceGetAttribute(&cus, hipDeviceAttributeMultiprocessorCount, dev);
        (void)hipFuncSetAttribute((const void*)k_mega, hipFuncAttributeMaxDynamicSharedMemorySize, LDS_BYTES);
        (void)hipOccupancyMaxActiveBlocksPerMultiprocessor(&per_cu, (const void*)k_mega, NTHREADS, LDS_BYTES);
        if (per_cu < 1) { fprintf(stderr, "kernel_launch: occupancy query returned %d\n", per_cu); per_cu = 1; }
        if (per_cu > 1) per_cu = 1;
        grid_blocks = cus * per_cu;
    }
    P p{};
    const float** f = (const float**)&p;
    for (int i = 0; i < 28; ++i) f[i] = (const float*)d_in[i];
    p.out = (float*)d_out; p.ws = (unsigned char*)d_ws;
    (void)hipMemsetAsync((char*)d_ws + WS_BAR, 0, (XB_ADAFLAG + 16) * 4, stream);
    void* args[] = {&p};
    hipError_t e = hipLaunchCooperativeKernel((const void*)k_mega, dim3(grid_blocks), dim3(NTHREADS), args, LDS_BYTES, stream);
    if (e != hipSuccess) fprintf(stderr, "cooperative launch failed: %s (grid %d)\n", hipGetErrorString(e), grid_blocks);
}
```

```cpp
#include <hip/hip_runtime.h>
#include <hip/hip_cooperative_groups.h>
#include <cstdio>
#include <cstdint>

#ifndef DUP_MASK
#define DUP_MASK 0
#endif
#ifndef N_LAUNCH_MODE
#define N_LAUNCH_MODE 0
#endif

namespace cg = cooperative_groups;

typedef unsigned short bf16_t;
typedef short bf16x8 __attribute__((ext_vector_type(8)));
typedef float f32x4 __attribute__((ext_vector_type(4)));
typedef unsigned u32x2 __attribute__((ext_vector_type(2)));
typedef float f32x2_t __attribute__((ext_vector_type(2)));
typedef unsigned u32x4 __attribute__((ext_vector_type(4)));
#define LAS __attribute__((address_space(3)))

constexpr int D = 1024, NB = 4, T = 8192, NT = NB * T, CTXL = 256, CT = NB * CTXL, NR = NT + CT;
constexpr int DIN = 2576, NH = 4, DV = 128, DK = 64, NE = 64, TOPK = 8, DE = 256;
constexpr int NCH = 66;
constexpr float EPS = 1e-6f;
constexpr int NTHREADS = 512;

constexpr size_t al256(size_t x) { return (x + 255) & ~(size_t)255; }
constexpr int HT = NT / 2;
constexpr int LCAP = NT;
constexpr size_t WS_WT_D = 0;
constexpr size_t WS_MODP = WS_WT_D + (size_t)65 * 1024 * 256 * 2;
constexpr size_t WS_LTOK = WS_MODP + (size_t)8 * 5 * 6144 * 4;
constexpr size_t WS_SLOTE = WS_LTOK + (size_t)64 * LCAP * 4;
constexpr size_t WS_SLOTP = WS_SLOTE + (size_t)NT * 8 * 4;
constexpr size_t WS_SLOTW = WS_SLOTP + (size_t)NT * 8 * 4;
constexpr size_t WS_CURSOR = WS_SLOTW + (size_t)NT * 8 * 4;
constexpr size_t WS_WRH = WS_CURSOR + 1024;
constexpr size_t WS_WRL = WS_WRH + 131072;
constexpr size_t WS_BAR = WS_WRL + 131072;
constexpr size_t WS_GP = WS_BAR + 16384;
constexpr size_t WS_Z1 = al256(WS_GP + (size_t)NR * 16 * 4);
constexpr size_t WS_WT_IN = WS_Z1;
constexpr size_t WS_WT_IN8 = WS_WT_IN + (size_t)1024 * 1024 * 2;
constexpr size_t WS_WT_OUT = WS_WT_IN + (size_t)2560 * 1024 * 2;
constexpr size_t WS_WT_GU = WS_WT_OUT + (size_t)1024 * 1024 * 2;
constexpr size_t WS_HX = WS_WT_GU + (size_t)65 * 512 * 1024 * 2;
constexpr size_t WS_RA = WS_HX + (size_t)NR * 1024 * 2;
constexpr size_t WS_Q = WS_RA;
constexpr size_t WS_K = WS_Q + (size_t)NR * 256 * 2;
constexpr size_t WS_V = WS_K + (size_t)NR * 256 * 2;
constexpr size_t WS_SO = WS_V + (size_t)NR * 512 * 2;
constexpr size_t WS_U = WS_SO + (size_t)NR * 512 * 2;
constexpr size_t WS_RA_END = WS_U + (size_t)NR * 512 * 2;
constexpr size_t WS_YX = WS_RA;
constexpr size_t WS_RB = WS_RA_END;
constexpr size_t WS_CLOC = WS_RB;
constexpr size_t WS_HX8 = WS_CLOC + (size_t)32 * NCH * 8192 * 2;
constexpr size_t WS_NLOC = WS_CLOC + (size_t)32 * NCH * 8192 * 4;
constexpr size_t WS_SCAL = WS_NLOC + (size_t)32 * NCH * 64 * 4;
constexpr size_t WS_CPREV = al256(WS_SCAL + (size_t)32 * NCH * 2 * 4);
constexpr size_t WS_NPREV = WS_CPREV + (size_t)32 * 64 * 8192 * 2;
constexpr size_t WS_MPREV = WS_NPREV + (size_t)32 * 64 * 64 * 4;
constexpr size_t WS_MIX = al256(WS_MPREV + (size_t)32 * 64 * 4);
constexpr size_t WS_RB_END = WS_MIX + (size_t)NT * 1024 * 2;
constexpr int MAXTILES = 64 + NT * 8 / 256 + NT / 256;
constexpr size_t WS_YE = WS_Z1;
constexpr size_t WS_ACT = WS_YE + (size_t)MAXTILES * 256 * 1024;
constexpr size_t WS_ACT_END = WS_ACT + (size_t)MAXTILES * 256 * 256;
constexpr size_t WS_X1B = al256(WS_ACT_END);
constexpr size_t WS_X1B_END = WS_X1B + (size_t)NT * 1024 * 2;
constexpr size_t WS_END = WS_X1B_END > WS_RB_END ? WS_X1B_END : WS_RB_END;
static_assert(WS_ACT >= WS_RA_END, "act must not overlap hx2 / gate-up weights / yx");
static_assert((size_t)NT * 1024 * 4 <= WS_RA_END - WS_RA, "yx alias overflow");
static_assert(WS_END <= (size_t)512 * 1024 * 1024, "workspace too large");

struct P {
    const float *x, *c, *ctx, *c_ctx, *w_ada, *b_ada, *g_pre_mix, *g_post_mix, *g_pre_ffn, *g_post_ffn;
    const float *w_in, *b_in, *b_gate, *norm_g, *conv_w, *conv_b, *ln_g, *ln_b, *w_out, *b_out;
    const float *w_router, *b_router, *we_gate, *we_up, *we_down, *ws_gate, *ws_up, *ws_down;
    float* out;
    unsigned char* ws;
};

__device__ __forceinline__ int tidx() { int t = threadIdx.x; asm volatile("" : "+v"(t)); return t; }
__device__ __forceinline__ unsigned hw_pk_bf16(float lo, float hi) { unsigned r; asm("s_nop 0\n\tv_cvt_pk_bf16_f32 %0, %1, %2" : "=v"(r) : "v"(lo), "v"(hi)); return r; }
__device__ __forceinline__ bf16_t f2bf(float f) { return (bf16_t)(hw_pk_bf16(f, f) & 0xffffu); }
__device__ __forceinline__ float bf2f(bf16_t b) { return __uint_as_float(((unsigned)b) << 16); }
__device__ __forceinline__ unsigned pk2(float lo, float hi) { return hw_pk_bf16(lo, hi); }
__device__ __forceinline__ unsigned pk2_sw(float lo, float hi) { unsigned a = __float_as_uint(lo), b = __float_as_uint(hi); a += 0x7FFFu + ((a >> 16) & 1u); b += 0x7FFFu + ((b >> 16) & 1u); return (a >> 16) | (b & 0xffff0000u); }
__device__ __forceinline__ unsigned pk4_fp8(const f32x4 v) {
    const float a = __builtin_amdgcn_fmed3f(v[0], -448.f, 448.f), b = __builtin_amdgcn_fmed3f(v[1], -448.f, 448.f);
    const float c = __builtin_amdgcn_fmed3f(v[2], -448.f, 448.f), d = __builtin_amdgcn_fmed3f(v[3], -448.f, 448.f);
    int w = __builtin_amdgcn_cvt_pk_fp8_f32(a, b, 0, false);
    w = __builtin_amdgcn_cvt_pk_fp8_f32(c, d, w, true);
    return (unsigned)w;
}
template <int CTRL, int RMASK> __device__ __forceinline__ float dpp_get(float oldv, float v) {
    return __int_as_float(__builtin_amdgcn_update_dpp(__float_as_int(oldv), __float_as_int(v), CTRL, RMASK, 0xf, false));
}
__device__ __forceinline__ float wave_sum(float v) {
    v += dpp_get<0xB1, 0xf>(0.f, v);
    v += dpp_get<0x4E, 0xf>(0.f, v);
    v += dpp_get<0x141, 0xf>(0.f, v);
    v += dpp_get<0x140, 0xf>(0.f, v);
    v += dpp_get<0x142, 0xa>(0.f, v);
    v += dpp_get<0x143, 0xc>(0.f, v);
    return __int_as_float(__builtin_amdgcn_readlane(__float_as_int(v), 63));
}
__device__ __forceinline__ float wave_max(float v) {
    v = fmaxf(v, dpp_get<0xB1, 0xf>(v, v));
    v = fmaxf(v, dpp_get<0x4E, 0xf>(v, v));
    v = fmaxf(v, dpp_get<0x141, 0xf>(v, v));
    v = fmaxf(v, dpp_get<0x140, 0xf>(v, v));
    v = fmaxf(v, dpp_get<0x142, 0xa>(v, v));
    v = fmaxf(v, dpp_get<0x143, 0xc>(v, v));
    return __int_as_float(__builtin_amdgcn_readlane(__float_as_int(v), 63));
}
__device__ __forceinline__ float sigmoidf_(float x) { return 1.0f / (1.0f + __expf(-x)); }
__device__ __forceinline__ float siluf_(float x) { return x / (1.0f + __expf(-x)); }
__device__ __forceinline__ float logsigmoidf_(float x) { return fminf(x, 0.0f) - log1pf(__expf(-fabsf(x))); }
__device__ __forceinline__ float modval(const float* modp, int r, int idx) { return modp[(size_t)r * 6144 + idx]; }
__device__ __forceinline__ void glds16(const void* g, char* l) {
    __builtin_amdgcn_global_load_lds((const __attribute__((address_space(1))) unsigned*)g, (LAS unsigned*)l, 16, 0, 0);
}

template <bool FWD> __device__ __forceinline__ float masked_sum128(const float* a, int t) {
    float s = 0.f;
#pragma unroll 8
    for (int j4 = 0; j4 < 32; ++j4) {
        const f32x4 v = *(const f32x4*)(a + 4 * j4); const int j = 4 * j4;
        if (FWD) s += ((j <= t ? v[0] : 0.f) + (j + 1 <= t ? v[1] : 0.f)) + ((j + 2 <= t ? v[2] : 0.f) + (j + 3 <= t ? v[3] : 0.f));
        else     s += ((j >= t ? v[0] : 0.f) + (j + 1 >= t ? v[1] : 0.f)) + ((j + 2 >= t ? v[2] : 0.f) + (j + 3 >= t ? v[3] : 0.f));
    }
    return s;
}
template <bool FWD> __device__ __forceinline__ float masked_max128(const float* a, int t) {
    float s = -INFINITY;
#pragma unroll 8
    for (int j4 = 0; j4 < 32; ++j4) {
        const f32x4 v = *(const f32x4*)(a + 4 * j4); const int j = 4 * j4;
        if (FWD) s = fmaxf(fmaxf(s, fmaxf(j <= t ? v[0] : -INFINITY, j + 1 <= t ? v[1] : -INFINITY)), fmaxf(j + 2 <= t ? v[2] : -INFINITY, j + 3 <= t ? v[3] : -INFINITY));
        else     s = fmaxf(fmaxf(s, fmaxf(j >= t ? v[0] : -INFINITY, j + 1 >= t ? v[1] : -INFINITY)), fmaxf(j + 2 >= t ? v[2] : -INFINITY, j + 3 >= t ? v[3] : -INFINITY));
    }
    return s;
}
__device__ __forceinline__ float reduce16(const float (&g)[16], int lane) {
    float h8[8], h4[4], h2[2];
    const bool b5 = lane & 32, b4 = lane & 16, b3 = lane & 8, b2 = lane & 4;
#pragma unroll
    for (int i = 0; i < 8; ++i) { const float keep = b5 ? g[i + 8] : g[i], send = b5 ? g[i] : g[i + 8]; h8[i] = keep + __shfl_xor(send, 32); }
#pragma unroll
    for (int i = 0; i < 4; ++i) { const float keep = b4 ? h8[i + 4] : h8[i], send = b4 ? h8[i] : h8[i + 4]; h4[i] = keep + __shfl_xor(send, 16); }
#pragma unroll
    for (int i = 0; i < 2; ++i) { const float keep = b3 ? h4[i + 2] : h4[i], send = b3 ? h4[i] : h4[i + 2]; h2[i] = keep + __shfl_xor(send, 8); }
    float r = (b2 ? h2[1] : h2[0]) + __shfl_xor(b2 ? h2[0] : h2[1], 4);
    r += __shfl_xor(r, 2); r += __shfl_xor(r, 1);
    return r;
}

template <int CTRL, int RMASK> __device__ __forceinline__ float dpp_get_bc(float oldv, float v) {
    return __int_as_float(__builtin_amdgcn_update_dpp(__float_as_int(oldv), __float_as_int(v), CTRL, RMASK, 0xf, false));
}
__device__ __forceinline__ float wscan_up_add(float v, int lane) {
    (void)lane;
    v += dpp_get_bc<0x111, 0xf>(0.f, v);
    v += dpp_get_bc<0x112, 0xf>(0.f, v);
    v += dpp_get_bc<0x114, 0xf>(0.f, v);
    v += dpp_get_bc<0x118, 0xf>(0.f, v);
    v += dpp_get_bc<0x142, 0xa>(0.f, v);
    v += dpp_get_bc<0x143, 0xc>(0.f, v);
    return v;
}
__device__ __forceinline__ float wscan_up_max(float v, int lane) {
    (void)lane;
    v = fmaxf(v, dpp_get_bc<0x111, 0xf>(v, v));
    v = fmaxf(v, dpp_get_bc<0x112, 0xf>(v, v));
    v = fmaxf(v, dpp_get_bc<0x114, 0xf>(v, v));
    v = fmaxf(v, dpp_get_bc<0x118, 0xf>(v, v));
    v = fmaxf(v, dpp_get_bc<0x142, 0xa>(v, v));
    v = fmaxf(v, dpp_get_bc<0x143, 0xc>(v, v));
    return v;
}
__device__ __forceinline__ float wscan_down_add(float v, int lane) {
    v = __shfl(v, 63 - lane); v = wscan_up_add(v, lane); return __shfl(v, 63 - lane);
}
__device__ __forceinline__ float wscan_down_max(float v, int lane) {
    v = __shfl(v, 63 - lane); v = wscan_up_max(v, lane); return __shfl(v, 63 - lane);
}
__device__ __forceinline__ int seq_row0(int s, int cid) { return cid < 2 ? NT + s * CTXL + cid * 128 : s * T + (cid - 2) * 128; }

namespace g8 {
constexpr int BM = 256, BK = 64, HALF = 128, HTB = HALF * BK * 2, STAGE_BYTES = 8 * HTB;
__device__ __forceinline__ int lds_byte(int r, int c) { const int st = (r >> 4) * 2 + (c >> 5), rr = r & 15, cc = c & 31, ob = rr * 64 + cc * 2; return st * 1024 + (ob ^ (((ob >> 9) & 1) << 5)); }
__device__ __forceinline__ void stage_rc(int b, int& R, int& C) { const int st = b / 1024, sb = b % 1024, swz = sb ^ (((sb >> 9) & 1) << 5); R = (st >> 1) * 16 + swz / 64; C = (st & 1) * 32 + (swz % 64) / 2; }
__device__ __forceinline__ int perm32(int rho) { const int n = rho >> 4, i = rho & 15; return 8 * (i >> 2) + 4 * n + (i & 3); }
__device__ __forceinline__ unsigned cvt_pk_bf16(float lo, float hi) { unsigned r; asm volatile("s_nop 0\n\tv_cvt_pk_bf16_f32 %0, %1, %2" : "=v"(r) : "v"(lo), "v"(hi)); return r; }

struct Unit { const char* A; const char* B; int x0, x1, x2, x3; };

typedef int v8i_t __attribute__((ext_vector_type(8)));
template <bool PERM, bool GATHER, bool FP8, int SCB, class Sched, class Epi>
__device__ __forceinline__ void gemm(LAS unsigned char* lds, const int KB, const Sched& S, const Epi& E) {
    const int tid = tidx(), wid = __builtin_amdgcn_readfirstlane(tid >> 6), lane = tid & 63, wr = wid >> 2, wc = wid & 3, fr = lane & 15, fq = lane >> 4;
    const int nt = KB / 128;
    int R[2]; unsigned c2[2], voffB[2], vb[2];
#pragma unroll
    for (int i = 0; i < 2; ++i) { int C; stage_rc(tid * 16 + i * 8192, R[i], C); const int Rb = PERM ? ((R[i] & ~31) + perm32(R[i] & 31)) : R[i]; voffB[i] = (unsigned)(Rb * KB + C * 2); vb[i] = (unsigned)(R[i] * KB + C * 2); c2[i] = (unsigned)C * 2u; }
    const size_t kstep = (size_t)(BK * 2);
    const size_t hstep = (size_t)HALF * KB;
    const unsigned ldsw = (unsigned)wid * 1024u;
    const int ca0 = FP8 ? (fq >> 1) * 32 + (fq & 1) * 16 : fq * 8, ca1 = FP8 ? ca0 + 8 : 32 + fq * 8;
    const int pa0 = lds_byte(wr * 64 + fr, ca0), pa1 = lds_byte(wr * 64 + fr, ca1), pb0 = lds_byte(wc * 32 + fr, ca0), pb1 = lds_byte(wc * 32 + fr, ca1);
#define G8_SA(b, h) (((b) * 2 + (h)) * HTB)
#define G8_SB(b, h) ((4 + (b) * 2 + (h)) * HTB)
#define G8_STAGE(bufoff, gbase, voff) do { _Pragma("unroll") for (int _i = 0; _i < 2; ++_i) \
        __builtin_amdgcn_global_load_lds((const __attribute__((address_space(1))) unsigned*)((const char*)(gbase) + (voff)[_i]), (LAS unsigned*)(lds + (bufoff) + ldsw + _i * 8192), 16, 0, 0); } while (0)
#define G8_LDA(dst, b, h) do { _Pragma("unroll") for (int m = 0; m < 4; ++m) _Pragma("unroll") for (int k = 0; k < 2; ++k) dst[m][k] = *(const LAS bf16x8*)(lds + G8_SA(b, h) + (k ? pa1 : pa0) + m * 2048); } while (0)
#define G8_LDB(dst, b, h) do { _Pragma("unroll") for (int n = 0; n < 2; ++n) _Pragma("unroll") for (int k = 0; k < 2; ++k) dst[n][k] = *(const LAS bf16x8*)(lds + G8_SB(b, h) + (k ? pb1 : pb0) + n * 2048); } while (0)
#define G8_CAT(x) __builtin_shufflevector(__builtin_bit_cast(u32x4, (x)[0]), __builtin_bit_cast(u32x4, (x)[1]), 0, 1, 2, 3, 4, 5, 6, 7)
#define G8_MMA(ai, bj, At, Bt) do { __builtin_amdgcn_s_setprio(1); _Pragma("unroll") for (int m = 0; m < 4; ++m) _Pragma("unroll") for (int n = 0; n < 2; ++n) { \
        if (FP8) acc[ai][bj][m][n] = __builtin_amdgcn_mfma_scale_f32_16x16x128_f8f6f4(__builtin_bit_cast(v8i_t, G8_CAT(Bt[n])), __builtin_bit_cast(v8i_t, G8_CAT(At[m])), acc[ai][bj][m][n], 0, 0, 0, 0x7F7F7F7F, 0, SCB * 0x01010101); \
        else { _Pragma("unroll") for (int k = 0; k < 2; ++k) acc[ai][bj][m][n] = __builtin_amdgcn_mfma_f32_16x16x32_bf16(Bt[n][k], At[m][k], acc[ai][bj][m][n], 0, 0, 0); } } \
        __builtin_amdgcn_s_setprio(0); } while (0)
#define G8_WAIT_V(n) asm volatile("s_waitcnt vmcnt(" #n ")" ::: "memory")
#define G8_WAIT_L(n) asm volatile("s_waitcnt lgkmcnt(" #n ")" ::: "memory")
#define G8_BAR __builtin_amdgcn_s_barrier()
#define G8_SCHED __builtin_amdgcn_sched_barrier(0)
    Unit cur, nxt; int ui = 0;
    if (!S.next(0, cur)) return;
    f32x4 acc[2][2][4][2];
#define G8_ZERO_ACC() do { _Pragma("unroll") for (int a = 0; a < 2; ++a) _Pragma("unroll") for (int b = 0; b < 2; ++b) _Pragma("unroll") for (int m = 0; m < 4; ++m) _Pragma("unroll") for (int n = 0; n < 2; ++n) { \
        f32x2_t z0_, z1_; asm volatile("v_mov_b64 %0, 0" : "=v"(z0_)); asm volatile("v_mov_b64 %0, 0" : "=v"(z1_)); acc[a][b][m][n] = __builtin_shufflevector(z0_, z1_, 0, 1, 2, 3); } } while (0)
    G8_ZERO_ACC();
    bf16x8 At[4][2], B0[2][2], B1[2][2];
    unsigned va[2][2];
    if (GATHER) S.aoffs(cur, R, c2, va);
    else { va[0][0] = vb[0]; va[0][1] = vb[1]; va[1][0] = vb[0]; va[1][1] = vb[1]; }
    const size_t ah = GATHER ? (size_t)0 : hstep;
    const char* cA = cur.A; const char* cB = cur.B;
    G8_STAGE(G8_SB(0, 0), cB, voffB); G8_STAGE(G8_SA(0, 0), cA, va[0]); G8_STAGE(G8_SB(0, 1), cB + hstep, voffB); G8_STAGE(G8_SA(0, 1), cA + ah, va[1]);
    if (wr == 1) G8_BAR;
    G8_WAIT_V(4); G8_BAR;
    G8_STAGE(G8_SB(1, 0), cB + kstep, voffB); G8_STAGE(G8_SA(1, 0), cA + kstep, va[0]); G8_STAGE(G8_SB(1, 1), cB + hstep + kstep, voffB);
    G8_WAIT_V(6); G8_BAR;
    for (;;) {
        const bool has_next = S.next(ui + 1, nxt);
        const char* nA = has_next ? nxt.A : cA; const char* nB = has_next ? nxt.B : cB;
#pragma unroll 1
        for (int t = 0; t < nt; t += 2) {
            const bool last = (t == nt - 2);
            const char* a1 = cA + (size_t)(t + 1) * kstep;
            G8_LDB(B0, 0, 0); G8_SCHED; G8_LDA(At, 0, 0); G8_STAGE(G8_SA(1, 1), a1 + ah, va[1]);
            G8_WAIT_L(8); G8_BAR; G8_WAIT_L(0); G8_MMA(0, 0, At, B0); G8_BAR; G8_SCHED;
            if (GATHER) { if (last && has_next) S.aoffs(nxt, R, c2, va); }
            const char* a2 = last ? nA : cA + (size_t)(t + 2) * kstep; const char* b2 = last ? nB : cB + (size_t)(t + 2) * kstep;
            const char* a3 = a2 + kstep; const char* b3 = b2 + kstep;
            G8_SCHED;
            G8_LDB(B1, 0, 1); G8_STAGE(G8_SB(0, 0), b2, voffB);
            G8_BAR; G8_WAIT_L(0); G8_MMA(0, 1, At, B1); G8_BAR;
            G8_LDA(At, 0, 1); G8_STAGE(G8_SA(0, 0), a2, va[0]);
            G8_BAR; G8_WAIT_L(0); G8_MMA(1, 0, At, B0); G8_BAR; G8_SCHED;
            G8_STAGE(G8_SB(0, 1), b2 + hstep, voffB);
            G8_WAIT_V(6); G8_BAR; G8_MMA(1, 1, At, B1); G8_BAR;
            G8_LDB(B0, 1, 0); G8_SCHED; G8_LDA(At, 1, 0); G8_STAGE(G8_SA(0, 1), a2 + ah, va[1]);
            G8_WAIT_L(8); G8_BAR; G8_WAIT_L(0); G8_MMA(0, 0, At, B0); G8_BAR; G8_SCHED;
            G8_LDB(B1, 1, 1); G8_STAGE(G8_SB(1, 0), b3, voffB);
            G8_BAR; G8_WAIT_L(0); G8_MMA(0, 1, At, B1); G8_BAR;
            G8_LDA(At, 1, 1); G8_STAGE(G8_SA(1, 0), a3, va[0]);
            G8_BAR; G8_WAIT_L(0); G8_MMA(1, 0, At, B0); G8_BAR; G8_SCHED;
            G8_STAGE(G8_SB(1, 1), b3 + hstep, voffB);
            G8_WAIT_V(6); G8_BAR; G8_MMA(1, 1, At, B1); G8_BAR;
        }
        E(acc, cur, wr, wc, fr, fq);
        if (!has_next) break;
        G8_ZERO_ACC();
        cur = nxt; cA = nA; cB = nB; ++ui;
    }
    G8_WAIT_V(0);
    if (wr == 0) G8_BAR;
    G8_BAR;
#undef G8_ZERO_ACC
#undef G8_SA
#undef G8_SB
#undef G8_STAGE
#undef G8_LDA
#undef G8_LDB
#undef G8_MMA
#undef G8_CAT
#undef G8_WAIT_V
#undef G8_WAIT_L
#undef G8_BAR
#undef G8_SCHED
}

__device__ __forceinline__ bool static_unit(int i, int nM, int nN, int& pm, int& pn) {
    const int nwg = nM * nN, G = gridDim.x;
    const long L = (long)i * G + blockIdx.x; if (L >= nwg) return false;
    int wgid = (int)L; { const int q = nwg / 8, r = nwg % 8, xcd = wgid % 8, off = wgid / 8; wgid = (xcd < r ? xcd * (q + 1) : r * (q + 1) + (xcd - r) * q) + off; }
    const int nig = 8 * nN, gid = wgid / nig, fm = gid * 8, gsz = (nM - fm) < 8 ? (nM - fm) : 8;
    pm = fm + ((wgid % nig) % gsz); pn = (wgid % nig) / gsz; return true;
}
}

constexpr int CVT_T0 = 640, CVT_T1 = CVT_T0 + 256, CVT_T2 = CVT_T1 + 65 * 128, CVT_T3 = CVT_T2 + 65 * 64, CVT_T4 = CVT_T3 + 128;
constexpr int ADA_ITEMS = 96;
constexpr float HX2_SCALE = 4.0f, WGU_SCALE = 64.0f;   static_assert(HX2_SCALE * WGU_SCALE == 256.0f, "the gate/up GEMM's MFMA block scale is 2^-8");
constexpr float YE_SCALE = 16.0f;
constexpr float HX8_SCALE = 4.0f, WIN8_SCALE = 64.0f;   static_assert(HX8_SCALE * WIN8_SCALE == 256.0f, "the fp8 in-projection's MFMA block scale is 2^-8");
constexpr float MIX_SCALE = 16.0f, WOUT_SCALE = 64.0f;   static_assert(MIX_SCALE * WOUT_SCALE == 1024.0f, "the out-projection's MFMA block scale is 2^-10");
constexpr float ACT_SCALE = 1.0f, WD_SCALE = YE_SCALE / ACT_SCALE;

__device__ __forceinline__ void ada_item(const P& p, int it, char* smem) {
    const int tid = tidx(), lane = tid & 63, kg = tid >> 6, cq = lane & 15, rg = lane >> 4;
    float* sc = (float*)smem;
    float* red = (float*)(smem + 20480);
    __syncthreads();
    {
        float t[10];
#pragma unroll
        for (int j = 0; j < 10; ++j) { const int i = tid + j * NTHREADS, r = i >> 10, k = i & 1023; t[j] = r < 4 ? p.c[r * 1024 + k] : p.c_ctx[k]; }
#pragma unroll
        for (int j = 0; j < 10; ++j) sc[tid + j * NTHREADS] = siluf_(t[j]);
    }
    __syncthreads();
    f32x4 a[5];
#pragma unroll
    for (int r = 0; r < 5; ++r) a[r] = (f32x4){0.f, 0.f, 0.f, 0.f};
    const float* w = p.w_ada + (size_t)(kg * 128 + rg) * 6144 + it * 64 + 4 * cq;
    const float* s0 = sc + kg * 128 + rg;
#pragma unroll 8
    for (int i = 0; i < 32; ++i) {
        const f32x4 wv = *(const f32x4*)(w + (size_t)(4 * i) * 6144);
#pragma unroll
        for (int r = 0; r < 5; ++r) a[r] += s0[r * 1024 + 4 * i] * wv;
    }
#pragma unroll
    for (int r = 0; r < 5; ++r)
#pragma unroll
        for (int c = 0; c < 4; ++c) { float v = a[r][c]; v += __shfl_xor(v, 16); v += __shfl_xor(v, 32); a[r][c] = v; }
    if (rg == 0) {
#pragma unroll
        for (int r = 0; r < 5; ++r) *(f32x4*)(red + kg * 320 + r * 64 + 4 * cq) = a[r];
    }
    __syncthreads();
    if (tid < 320) {
        const int r = tid >> 6, cc = it * 64 + (tid & 63);
        float v = p.b_ada[cc];
#pragma unroll
        for (int g = 0; g < 8; ++g) v += red[g * 320 + tid];
        ((float*)(p.ws + WS_MODP))[(size_t)r * 6144 + cc] = v;
    }
}

struct CvtTile { int job, e, k0, n0; };
__device__ __forceinline__ CvtTile cvt_decode(int t) {
    CvtTile c; c.e = 0; int kt, nt;
    if (t < CVT_T0) { kt = t / 40; nt = t % 40; c.job = nt >= 16 ? 4 : 0; }
    else if (t < CVT_T1) { c.job = 1; t -= CVT_T0; kt = t / 16; nt = t % 16; }
    else if (t < CVT_T2) { c.job = 2; t -= CVT_T1; c.e = t / 128; t %= 128; kt = t / 8; nt = t % 8; }
    else if (t < CVT_T3) { c.job = 3; t -= CVT_T2; c.e = t / 64; t %= 64; kt = t / 16; nt = t % 16; }
    else { c.job = 4; t -= CVT_T3; kt = t / 8; nt = 8 + t % 8; }
    c.k0 = kt * 64; c.n0 = nt * 64; return c;
}
__device__ __forceinline__ const float* cvt_src(const P& p, const CvtTile& c, int k, int n) {
    if (c.job == 0 || c.job == 4) {
        if (n < 1536) return p.w_in + (size_t)k * DIN + n;
        const int m = n - 1536, g = m >> 8, wi = m & 255; return p.w_in + (size_t)k * DIN + (wi < 128 ? 1552 + g * 128 + wi : 2064 + g * 128 + wi - 128);
    } else if (c.job == 1) return p.w_out + (size_t)k * 1024 + n;
    else if (c.job == 2) {
        const int g = n >> 8, wi = n & 255;
        const float* gb = c.e < 64 ? p.we_gate + (size_t)c.e * 1024 * 256 : p.ws_gate;
        const float* ub = c.e < 64 ? p.we_up + (size_t)c.e * 1024 * 256 : p.ws_up;
        return wi < 128 ? gb + (size_t)k * 256 + g * 128 + wi : ub + (size_t)k * 256 + g * 128 + wi - 128;
    }
    const float* db = c.e < 64 ? p.we_down + (size_t)c.e * 256 * 1024 : p.ws_down; return db + (size_t)k * 1024 + n;
}
__device__ __forceinline__ bf16_t* cvt_dst(const P& p, const CvtTile& c, int n, int k) {
    if (c.job == 0) return (bf16_t*)(p.ws + WS_WT_IN) + (size_t)n * 1024 + k;
    if (c.job == 1) return (bf16_t*)(p.ws + WS_WT_OUT) + (size_t)n * 1024 + k;
    if (c.job == 2) return (bf16_t*)(p.ws + WS_WT_GU) + (size_t)c.e * 512 * 1024 + (size_t)n * 1024 + k;
    return (bf16_t*)(p.ws + WS_WT_D) + (size_t)c.e * 1024 * 256 + (size_t)n * 256 + k;
}
__device__ __forceinline__ void cvt_load(const P& p, int t4, f32x4 (&v)[8]) {
    const int tid = tidx();
    if (t4 * 4 >= CVT_T0 || (t4 * 4) % 40 >= 16) {
        const int q2 = tid >> 8, kq = (tid >> 4) & 15, n4 = (tid & 15) * 4;
#pragma unroll
        for (int rnd = 0; rnd < 2; ++rnd) {
            const CvtTile c = cvt_decode(t4 * 4 + q2 + 2 * rnd);
#pragma unroll
            for (int r = 0; r < 4; ++r) v[rnd * 4 + r] = *(const f32x4*)cvt_src(p, c, c.k0 + 4 * kq + r, c.n0 + n4);
        }
    } else {
        const int kp = tid >> 4, n4 = (tid & 15) * 4;
#pragma unroll
        for (int q = 0; q < 4; ++q) {
            const CvtTile c = cvt_decode(t4 * 4 + q);
            v[2 * q] = *(const f32x4*)cvt_src(p, c, c.k0 + 2 * kp, c.n0 + n4);
            v[2 * q + 1] = *(const f32x4*)cvt_src(p, c, c.k0 + 2 * kp + 1, c.n0 + n4);
        }
    }
}
__device__ __forceinline__ void cvt_store(const P& p, int t4, const f32x4 (&v)[8], char* smem) {
    const int tid = tidx();
    unsigned* tile = (unsigned*)smem;
    if (t4 * 4 >= CVT_T0 || (t4 * 4) % 40 >= 16) {
        const int q2 = tid >> 8, kq = (tid >> 4) & 15, n4 = (tid & 15) * 4;
        CvtTile c[2];
#pragma unroll
        for (int rnd = 0; rnd < 2; ++rnd) {
            c[rnd] = cvt_decode(t4 * 4 + q2 + 2 * rnd);
#pragma unroll
            for (int cc = 0; cc < 4; ++cc)
                tile[(q2 + 2 * rnd) * 1088 + (n4 + cc) * 17 + kq] = pk4_fp8((f32x4){v[rnd * 4][cc], v[rnd * 4 + 1][cc], v[rnd * 4 + 2][cc], v[rnd * 4 + 3][cc]} * (c[rnd].job == 2 ? WGU_SCALE : (c[rnd].job == 3 ? WD_SCALE : (c[rnd].job == 4 ? WIN8_SCALE : WOUT_SCALE))));
        }
        __syncthreads();
        const int nn = (tid >> 2) & 63, part = tid & 3;
#pragma unroll
        for (int rnd = 0; rnd < 2; ++rnd) {
            const unsigned* src = tile + (q2 + 2 * rnd) * 1088 + nn * 17 + part * 4;
            u32x4 w; w.x = src[0]; w.y = src[1]; w.z = src[2]; w.w = src[3];
            unsigned char* dst = c[rnd].job == 2 ? (unsigned char*)(p.ws + WS_WT_GU) + (size_t)c[rnd].e * 512 * 1024 + (size_t)(c[rnd].n0 + nn) * 1024 + c[rnd].k0 + part * 16
                               : c[rnd].job == 3 ? (unsigned char*)(p.ws + WS_WT_D) + (size_t)c[rnd].e * 1024 * 256 + (size_t)(c[rnd].n0 + nn) * 256 + c[rnd].k0 + part * 16
                               : c[rnd].job == 4 ? (unsigned char*)(p.ws + WS_WT_IN8) + (size_t)(c[rnd].n0 + nn - 512) * 1024 + c[rnd].k0 + part * 16
                                                 : (unsigned char*)(p.ws + WS_WT_OUT) + (size_t)(c[rnd].n0 + nn) * 1024 + c[rnd].k0 + part * 16;
            *(u32x4*)dst = w;
        }
    } else {
        const int kp = tid >> 4, n4 = (tid & 15) * 4;
#pragma unroll
        for (int q = 0; q < 4; ++q)
#pragma unroll
            for (int cc = 0; cc < 4; ++cc) tile[q * 2112 + (n4 + cc) * 33 + kp] = pk2(v[2 * q][cc], v[2 * q + 1][cc]);
        __syncthreads();
        const int nn = tid >> 3, kw = (tid & 7) * 4;
#pragma unroll
        for (int q = 0; q < 4; ++q) {
            const CvtTile c = cvt_decode(t4 * 4 + q);
            u32x4 w; w.x = tile[q * 2112 + nn * 33 + kw]; w.y = tile[q * 2112 + nn * 33 + kw + 1]; w.z = tile[q * 2112 + nn * 33 + kw + 2]; w.w = tile[q * 2112 + nn * 33 + kw + 3];
            *(u32x4*)cvt_dst(p, c, c.n0 + nn, c.k0 + 2 * kw) = w;
        }
    }
}

__device__ __forceinline__ void wr_split_item(const P& p, int it) {
    const int idx = it * NTHREADS + tidx(), lane = idx & 63, n = (idx >> 6) & 3, ks = (idx >> 8) & 3, w = idx >> 10, fr = lane & 15, fq = lane >> 4;
    float v[8], lo[8]; unsigned hi[4];
#pragma unroll
    for (int j = 0; j < 8; ++j) v[j] = p.w_router[(size_t)(128 * w + 32 * ks + 8 * fq + j) * 64 + 16 * n + fr];
#pragma unroll
    for (int j = 0; j < 4; ++j) { hi[j] = pk2(v[2 * j], v[2 * j + 1]); lo[2 * j] = v[2 * j] - __uint_as_float(hi[j] << 16); lo[2 * j + 1] = v[2 * j + 1] - __uint_as_float(hi[j] & 0xffff0000u); }
    *(u32x4*)(p.ws + WS_WRH + (size_t)idx * 16) = (u32x4){hi[0], hi[1], hi[2], hi[3]};
    *(u32x4*)(p.ws + WS_WRL + (size_t)idx * 16) = (u32x4){pk2(lo[0], lo[1]), pk2(lo[2], lo[3]), pk2(lo[4], lo[5]), pk2(lo[6], lo[7])};
}

constexpr int XB_ADAFLAG = 3520;
__device__ __forceinline__ void ada_signal(const P& p) {
    asm volatile("s_waitcnt vmcnt(0)" ::: "memory");
    __syncthreads();
    if (tidx() == 0) { __builtin_amdgcn_fence(__ATOMIC_RELEASE, "agent"); __hip_atomic_fetch_add((unsigned*)(p.ws + WS_BAR) + XB_ADAFLAG, 1u, __ATOMIC_RELAXED, __HIP_MEMORY_SCOPE_AGENT); }
}
__device__ __forceinline__ void ada_wait(const P& p) {
    if (tidx() == 0) {
        unsigned* f = (unsigned*)(p.ws + WS_BAR) + XB_ADAFLAG; unsigned* tmo = (unsigned*)(p.ws + WS_BAR) + 128; unsigned sp = 0;
        while (__hip_atomic_load(f, __ATOMIC_RELAXED, __HIP_MEMORY_SCOPE_AGENT) < (unsigned)ADA_ITEMS) {
            __builtin_amdgcn_s_sleep(2);
            if ((++sp & 255u) == 0u) { if (__hip_atomic_load(tmo, __ATOMIC_RELAXED, __HIP_MEMORY_SCOPE_AGENT)) break; if (sp > (1u << 18)) { atomicAdd(tmo, 1u); break; } }
        }
        __builtin_amdgcn_fence(__ATOMIC_ACQUIRE, "agent");
    }
    __syncthreads();
}
__device__ __forceinline__ void phase0(const P& p, char* smem) {
    if (blockIdx.x == 0 && tidx() < 128) ((int*)(p.ws + WS_CURSOR))[tidx()] = 0;
    const int G = (int)gridDim.x, bid = (int)blockIdx.x;
    for (int it = G - 1 - bid; it < 16; it += G) wr_split_item(p, it);
    for (int it = bid; it < ADA_ITEMS; it += G) { ada_item(p, it, smem); ada_signal(p); }
    const int S = CVT_T4 / 4, nA = G > ADA_ITEMS ? ADA_ITEMS : 0;
    int R = (S - 2 * (G - nA) + G - 1) / G; if (R < 0) R = 0;
    const int base2 = R * G, G2 = G - nA, b2 = bid - nA;
#define P0_STEP(k_) ((k_) < R ? (k_) * G + bid : (b2 >= 0 ? base2 + b2 + ((k_) - R) * G2 : S))
    f32x4 v[8];
    int k = 0, st = P0_STEP(0);
    if (st < S) cvt_load(p, st, v);
    while (st < S) {
        f32x4 c[8];
#pragma unroll
        for (int i = 0; i < 8; ++i) c[i] = v[i];
        const int nx = P0_STEP(k + 1);
        __syncthreads();
        if (nx < S) cvt_load(p, nx, v);
        cvt_store(p, st, c, smem);
        st = nx; ++k;
    }
#undef P0_STEP
}

__device__ __forceinline__ void phase1(const P& p, char* smem) {
    const int tid = tidx(), wid = tid >> 6, lane = tid & 63;
    float* modl = (float*)smem;
    float* wgT = (float*)(smem + 40960);
    const float* modp = (const float*)(p.ws + WS_MODP);
    f32x4 nv[2][4];
#define P1_LOAD(r0_) do { _Pragma("unroll") for (int q = 0; q < 2; ++q) { const int row_ = (r0_) + q; const float* xr_ = row_ < NT ? p.x + (size_t)row_ * 1024 : p.ctx + (size_t)(row_ - NT) * 1024; \
        _Pragma("unroll") for (int j = 0; j < 4; ++j) nv[q][j] = *(const f32x4*)(xr_ + 4 * lane + 256 * j); } } while (0)
    if ((blockIdx.x * 8 + wid) * 2 < NR) P1_LOAD((blockIdx.x * 8 + wid) * 2);
    ada_wait(p);
    {
        float t0[20], t1[32];
#pragma unroll
        for (int j = 0; j < 20; ++j) { const int i = tid + j * NTHREADS; t0[j] = modval(modp, i >> 11, i & 2047); }
#pragma unroll
        for (int j = 0; j < 32; ++j) { const int i = tid + j * NTHREADS; t1[j] = p.w_in[(size_t)(i >> 4) * DIN + 1536 + (i & 15)]; }
#pragma unroll
        for (int j = 0; j < 20; ++j) modl[tid + j * NTHREADS] = t0[j];
#pragma unroll
        for (int j = 0; j < 32; ++j) { const int i = tid + j * NTHREADS; wgT[(i & 15) * 1024 + (i >> 4)] = t1[j]; }
    }
    float* gl = (float*)(smem + 40960 + 65536);
    { const float a0 = p.g_pre_mix[tid], a1 = p.g_pre_mix[tid + NTHREADS]; gl[tid] = a0; gl[tid + NTHREADS] = a1; }
    const int gi = ((lane >> 5) & 1) * 8 + ((lane >> 4) & 1) * 4 + ((lane >> 3) & 1) * 2 + ((lane >> 2) & 1);
    const float bb = p.b_in[1536 + gi] + p.b_gate[gi];
    __syncthreads();
    bf16_t* hx = (bf16_t*)(p.ws + WS_HX);
    float* gp = (float*)(p.ws + WS_GP);
    for (int row0 = (blockIdx.x * 8 + wid) * 2; row0 < NR; row0 += gridDim.x * 16) {
        f32x4 v[2][4]; float ss[2]; int rr[2];
#pragma unroll
        for (int q = 0; q < 2; ++q) {
            rr[q] = (row0 + q) < NT ? (row0 + q) / T : 4; ss[q] = 0.f;
#pragma unroll
            for (int j = 0; j < 4; ++j) { v[q][j] = nv[q][j]; ss[q] += v[q][j][0] * v[q][j][0] + v[q][j][1] * v[q][j][1] + v[q][j][2] * v[q][j][2] + v[q][j][3] * v[q][j][3]; }
        }
        { const int nx = row0 + gridDim.x * 16; if (nx < NR) P1_LOAD(nx); }
        ss[0] = wave_sum(ss[0]); ss[1] = wave_sum(ss[1]);
#pragma unroll
        for (int q = 0; q < 2; ++q) {
            const int row = row0 + q;
            const float inv = rsqrtf(ss[q] * (1.0f / 1024.0f) + EPS);
            const float* sh = modl + rr[q] * 2048; const float* scl = sh + 1024;
#pragma unroll
            for (int j = 0; j < 4; ++j) {
                const int idx = 4 * lane + 256 * j;
                const f32x4 g = *(const f32x4*)(gl + idx), s1 = *(const f32x4*)(sh + idx), s2 = *(const f32x4*)(scl + idx);
#pragma unroll
                for (int c = 0; c < 4; ++c) v[q][j][c] = v[q][j][c] * inv * g[c] * (1.0f + s2[c]) + s1[c];
                u32x2 o; o.x = pk2(v[q][j][0], v[q][j][1]); o.y = pk2(v[q][j][2], v[q][j][3]);
                *(u32x2*)(hx + (size_t)row * 1024 + idx) = o;
                if (row < NT) *(unsigned*)(p.ws + WS_HX8 + (size_t)row * 1024 + idx) = pk4_fp8(v[q][j] * HX8_SCALE);
            }
        }
        float ga[2][16];
#pragma unroll
        for (int jg = 0; jg < 16; ++jg) {
            f32x4 s0 = (f32x4){0.f, 0.f, 0.f, 0.f}, s1 = s0;
#pragma unroll
            for (int j = 0; j < 4; ++j) {
                const f32x4 w = *(const f32x4*)(wgT + jg * 1024 + 4 * lane + 256 * j);
                s0 = __builtin_elementwise_fma(v[0][j], w, s0); s1 = __builtin_elementwise_fma(v[1][j], w, s1);
            }
            ga[0][jg] = (s0[0] + s0[1]) + (s0[2] + s0[3]); ga[1][jg] = (s1[0] + s1[1]) + (s1[2] + s1[3]);
            if ((jg & 3) == 3) __builtin_amdgcn_sched_barrier(0);
        }
        const float r0 = reduce16(ga[0], lane), r1 = reduce16(ga[1], lane);
        if ((lane & 3) == 0) {
            gp[(size_t)row0 * 16 + gi] = r0 + bb; gp[(size_t)(row0 + 1) * 16 + gi] = r1 + bb;
        }
    }
#undef P1_LOAD
}

__device__ __forceinline__ void phase3(const P& p, char* smem) {
    const int tid = tidx(), wid = tid >> 6, lane = tid & 63, fr = lane & 15, fq = lane >> 4;
    char* KT = smem;
    char* KTWf = smem + 17408;
    char* KTWb = smem + 2 * 17408;
    char* VT = smem + 3 * 17408;
    float* sc = (float*)(smem + 3 * 17408 + 34816);
    float *li_f = sc, *lf_f = sc + 128, *li_b = sc + 256, *lf_b = sc + 384, *bfa = sc + 512, *rba = sc + 640, *wf = sc + 768, *wb = sc + 896, *red = sc + 1024;
    const bf16_t* Kb = (const bf16_t*)(p.ws + WS_K); const bf16_t* V = (const bf16_t*)(p.ws + WS_V);
    const float* gp = (const float*)(p.ws + WS_GP);
    bf16_t* Cloc = (bf16_t*)(p.ws + WS_CLOC); float* Nloc = (float*)(p.ws + WS_NLOC); float* Scal = (float*)(p.ws + WS_SCAL);
    const int nitems = NB * NH * NCH;
    u32x4 rk[2], rv[4]; float rg[4];
#define P3_LOAD(it_) do { const int s_ = (it_) / (NH * NCH), h_ = ((it_) / NCH) % NH, r0_ = seq_row0(s_, (it_) % NCH); const int pr_ = tid >> 2; \
        const bf16_t* ks_ = Kb + (size_t)(r0_ + pr_) * 256 + h_ * 64 + (tid & 3) * 16; rk[0] = *(const u32x4*)ks_; rk[1] = *(const u32x4*)(ks_ + 8); \
        const bf16_t* vs_ = V + (size_t)(r0_ + pr_) * 512 + h_ * 128 + (tid & 3) * 32; _Pragma("unroll") for (int q = 0; q < 4; ++q) rv[q] = *(const u32x4*)(vs_ + 8 * q); \
        if (tid < 128) { const f32x4* g_ = (const f32x4*)(gp + (size_t)(r0_ + tid) * 16); const f32x4 g0 = g_[0], g1 = g_[1], g2 = g_[2], g3 = g_[3]; rg[0] = g0[h_]; rg[1] = g1[h_]; rg[2] = g2[h_]; rg[3] = g3[h_]; } } while (0)
    if ((int)blockIdx.x < nitems) P3_LOAD(blockIdx.x);
    for (int it = blockIdx.x; it < nitems; it += gridDim.x) {
        const int s = it / (NH * NCH), h = (it / NCH) % NH, cid = it % NCH;
        __syncthreads();
        {
            const int pr = tid >> 2, kc = (tid & 3) * 16, vc = (tid & 3) * 32;
            const unsigned w[8] = {rk[0].x, rk[0].y, rk[0].z, rk[0].w, rk[1].x, rk[1].y, rk[1].z, rk[1].w};
#pragma unroll
            for (int i = 0; i < 8; ++i) { *(bf16_t*)(KT + (kc + 2 * i) * 272 + pr * 2) = (bf16_t)(w[i] & 0xffff); *(bf16_t*)(KT + (kc + 2 * i + 1) * 272 + pr * 2) = (bf16_t)(w[i] >> 16); }
#pragma unroll
            for (int q = 0; q < 4; ++q) {
                const unsigned wv[4] = {rv[q].x, rv[q].y, rv[q].z, rv[q].w};
#pragma unroll
                for (int i = 0; i < 4; ++i) { *(bf16_t*)(VT + (vc + 8 * q + 2 * i) * 272 + pr * 2) = (bf16_t)(wv[i] & 0xffff); *(bf16_t*)(VT + (vc + 8 * q + 2 * i + 1) * 272 + pr * 2) = (bf16_t)(wv[i] >> 16); }
            }
            if (tid < 128) { li_f[tid] = rg[0]; lf_f[tid] = logsigmoidf_(rg[1]); li_b[tid] = rg[2]; lf_b[tid] = logsigmoidf_(rg[3]); }
        }
        { const int nx = it + gridDim.x; if (nx < nitems) P3_LOAD(nx); }
        __syncthreads();
        if (wid == 0) {
            const float x0 = lf_f[2 * lane], x1 = lf_f[2 * lane + 1];
            const float sc_ = wscan_up_add(x0 + x1, lane);
            const float btot = __shfl(sc_, 63);
            const float g0 = btot - (sc_ - x1) + li_f[2 * lane], g1 = btot - sc_ + li_f[2 * lane + 1];
            const float mx = wave_max(fmaxf(g0, g1));
            *(f32x2_t*)(wf + 2 * lane) = (f32x2_t){__expf(g0 - mx), __expf(g1 - mx)};
            if (lane == 0) { red[0] = mx; bfa[127] = btot; }
        } else if (wid == 1) {
            const float x0 = lf_b[2 * lane], x1 = lf_b[2 * lane + 1];
            const float sc_ = wscan_down_add(x0 + x1, lane);
            const float btot = __shfl(sc_, 0);
            const float g0 = btot - sc_ + li_b[2 * lane], g1 = btot - (sc_ - x0) + li_b[2 * lane + 1];
            const float mx = wave_max(fmaxf(g0, g1));
            *(f32x2_t*)(wb + 2 * lane) = (f32x2_t){__expf(g0 - mx), __expf(g1 - mx)};
            if (lane == 0) { red[1] = mx; rba[0] = btot; }
        }
        __syncthreads();
#pragma unroll
        for (int rep = 0; rep < 2; ++rep) {
            const int i = tid + rep * NTHREADS, k = i >> 4, p8 = i & 15;
            const u32x4 kv = *(const u32x4*)(KT + k * 272 + p8 * 16);
            const f32x4 f0 = *(const f32x4*)(wf + 8 * p8), f1 = *(const f32x4*)(wf + 8 * p8 + 4), b0 = *(const f32x4*)(wb + 8 * p8), b1 = *(const f32x4*)(wb + 8 * p8 + 4);
            const float e[8] = {__uint_as_float(kv.x << 16), __uint_as_float(kv.x & 0xffff0000u), __uint_as_float(kv.y << 16), __uint_as_float(kv.y & 0xffff0000u),
                                __uint_as_float(kv.z << 16), __uint_as_float(kv.z & 0xffff0000u), __uint_as_float(kv.w << 16), __uint_as_float(kv.w & 0xffff0000u)};
            u32x4 of, ob;
            of.x = g8::cvt_pk_bf16(e[0] * f0[0], e[1] * f0[1]); of.y = g8::cvt_pk_bf16(e[2] * f0[2], e[3] * f0[3]); of.z = g8::cvt_pk_bf16(e[4] * f1[0], e[5] * f1[1]); of.w = g8::cvt_pk_bf16(e[6] * f1[2], e[7] * f1[3]);
            ob.x = g8::cvt_pk_bf16(e[0] * b0[0], e[1] * b0[1]); ob.y = g8::cvt_pk_bf16(e[2] * b0[2], e[3] * b0[3]); ob.z = g8::cvt_pk_bf16(e[4] * b1[0], e[5] * b1[1]); ob.w = g8::cvt_pk_bf16(e[6] * b1[2], e[7] * b1[3]);
            *(u32x4*)(KTWf + k * 272 + p8 * 16) = of; *(u32x4*)(KTWb + k * 272 + p8 * 16) = ob;
        }
        const int chain_f = (s * NH + h) * 2, chain_b = chain_f + 1;
        if (tid < 128) {
            const int dir = tid >> 6, k = tid & 63; const float* w = dir ? wb : wf;
            float a = 0.f;
#pragma unroll 4
            for (int p8 = 0; p8 < 16; ++p8) {
                const u32x4 kv = *(const u32x4*)(KT + k * 272 + p8 * 16);
                const f32x4 w0 = *(const f32x4*)(w + 8 * p8), w1 = *(const f32x4*)(w + 8 * p8 + 4);
                a += w0[0] * __uint_as_float(kv.x << 16) + w0[1] * __uint_as_float(kv.x & 0xffff0000u) + w0[2] * __uint_as_float(kv.y << 16) + w0[3] * __uint_as_float(kv.y & 0xffff0000u)
                   + w1[0] * __uint_as_float(kv.z << 16) + w1[1] * __uint_as_float(kv.z & 0xffff0000u) + w1[2] * __uint_as_float(kv.w << 16) + w1[3] * __uint_as_float(kv.w & 0xffff0000u);
            }
            Nloc[((size_t)(chain_f + dir) * NCH + cid) * 64 + k] = a;
        }
        if (tid == 0) {
            Scal[((size_t)chain_f * NCH + cid) * 2 + 0] = red[0]; Scal[((size_t)chain_f * NCH + cid) * 2 + 1] = bfa[127];
            Scal[((size_t)chain_b * NCH + cid) * 2 + 0] = red[1]; Scal[((size_t)chain_b * NCH + cid) * 2 + 1] = rba[0];
        }
        __syncthreads();
#pragma unroll
        for (int dir = 0; dir < 2; ++dir) {
            const char* KW = dir ? KTWb : KTWf;
            f32x4 acc[4];
#pragma unroll
            for (int n = 0; n < 4; ++n) acc[n] = (f32x4){0.f, 0.f, 0.f, 0.f};
#pragma unroll
            for (int ks = 0; ks < 4; ++ks) {
                const bf16x8 a = *(const bf16x8*)(VT + (16 * wid + fr) * 272 + (32 * ks + 8 * fq) * 2);
#pragma unroll
                for (int n = 0; n < 4; ++n) { const bf16x8 b = *(const bf16x8*)(KW + (16 * n + fr) * 272 + (32 * ks + 8 * fq) * 2); acc[n] = __builtin_amdgcn_mfma_f32_16x16x32_bf16(b, a, acc[n], 0, 0, 0); }
            }
            bf16_t* dst = Cloc + ((size_t)(chain_f + dir) * NCH + cid) * 8192 + (16 * wid + fr) * 64;
#pragma unroll
            for (int n = 0; n < 4; ++n) { u32x2 o; o.x = pk2_sw(acc[n][0], acc[n][1]); o.y = pk2_sw(acc[n][2], acc[n][3]); *(u32x2*)(dst + 16 * n + 4 * fq) = o; }
        }
    }
#undef P3_LOAD
}

__device__ __forceinline__ void phase4(const P& p, char* smem) {
    const int tid = tidx();
    const bf16_t* Cloc = (const bf16_t*)(p.ws + WS_CLOC); const float* Nloc = (const float*)(p.ws + WS_NLOC); const float* Scal = (const float*)(p.ws + WS_SCAL);
    bf16_t* Cprev = (bf16_t*)(p.ws + WS_CPREV); float* Nprev = (float*)(p.ws + WS_NPREV); float* Mprev = (float*)(p.ws + WS_MPREV);
    float* sl = (float*)smem;
    for (int it = blockIdx.x; it < 32 * 8; it += gridDim.x) {
        const int chain = it >> 3, slice = it & 7, dir = chain & 1;
        __syncthreads();
        for (int i = tid; i < NCH * 2; i += NTHREADS) sl[i] = Scal[(size_t)chain * NCH * 2 + i];
        __syncthreads();
        const int e0 = slice * 1024 + tid * 2;
        float c0 = 0.f, c1 = 0.f, nn = 0.f, m = 0.f;
        const bool do_n = (slice == 0 && tid < 64);
        float l0[2][11], l1[2][11], ln[2][11];
#define SCAN_LOAD(buf, st0_) do { _Pragma("unroll") for (int i = 0; i < 11; ++i) { \
            const int st = (st0_) + i, cid = dir == 0 ? st : (st < 2 ? 1 - st : NCH + 1 - st); \
            const unsigned v = *(const unsigned*)(Cloc + ((size_t)chain * NCH + cid) * 8192 + e0); l0[buf][i] = __uint_as_float(v << 16); l1[buf][i] = __uint_as_float(v & 0xffff0000u); \
            ln[buf][i] = do_n ? Nloc[((size_t)chain * NCH + cid) * 64 + tid] : 0.f; } } while (0)
#define SCAN_STEP(buf, st0_) do { _Pragma("unroll") for (int i = 0; i < 11; ++i) { \
            const int st = (st0_) + i, cid = dir == 0 ? st : (st < 2 ? 1 - st : NCH + 1 - st); \
            if (cid >= 2) { const size_t o = (size_t)chain * 64 + (cid - 2); *(unsigned*)(Cprev + o * 8192 + e0) = pk2(c0, c1); if (do_n) Nprev[o * 64 + tid] = nn; if (slice == 0 && tid == 0) Mprev[o] = m; } \
            const float ml = sl[cid * 2 + 0], bt = sl[cid * 2 + 1]; \
            const float mnew = fmaxf(bt + m, ml), a = __expf(bt + m - mnew), e = __expf(ml - mnew); \
            c0 = a * c0 + e * l0[buf][i]; c1 = a * c1 + e * l1[buf][i]; nn = a * nn + e * ln[buf][i]; m = mnew; } } while (0)
        SCAN_LOAD(0, 0);
#pragma unroll 1
        for (int st0 = 0; st0 < NCH; st0 += 22) {
            SCAN_LOAD(1, st0 + 11);
            SCAN_STEP(0, st0);
            if (st0 + 22 < NCH) SCAN_LOAD(0, st0 + 22);
            SCAN_STEP(1, st0 + 11);
        }
#undef SCAN_LOAD
#undef SCAN_STEP
    }
}

struct MlstmRegs { u32x4 q[2], k[2], cf[2], cb[2], v[4]; float g[4]; float np, mpf, mpb; };
__device__ __forceinline__ void mlstm_load(const P& p, int it, MlstmRegs& R) {
    const int tid = tidx();
    const int b = it >> 8, h = (it >> 6) & 3, c = it & 63, row0 = b * T + c * 128;
    const bf16_t* Q = (const bf16_t*)(p.ws + WS_Q); const bf16_t* Kb = (const bf16_t*)(p.ws + WS_K); const bf16_t* V = (const bf16_t*)(p.ws + WS_V);
    const float* gp = (const float*)(p.ws + WS_GP);
    const bf16_t* Cprev = (const bf16_t*)(p.ws + WS_CPREV); const float* Nprev = (const float*)(p.ws + WS_NPREV); const float* Mprev = (const float*)(p.ws + WS_MPREV);
    const int chain_f = (b * NH + h) * 2;
    const size_t of = (size_t)chain_f * 64 + c, ob = (size_t)(chain_f + 1) * 64 + c;
    const int pr = tid >> 2, kc = (tid & 3) * 16, vc = (tid & 3) * 32;
    const bf16_t* qs = Q + (size_t)(row0 + pr) * 256 + h * 64 + kc; const bf16_t* ks = Kb + (size_t)(row0 + pr) * 256 + h * 64 + kc;
    const bf16_t* cfs = Cprev + of * 8192 + pr * 64 + kc; const bf16_t* cbs = Cprev + ob * 8192 + pr * 64 + kc;
    const bf16_t* vs = V + (size_t)(row0 + pr) * 512 + h * 128 + vc;
    R.q[0] = *(const u32x4*)qs; R.q[1] = *(const u32x4*)(qs + 8); R.k[0] = *(const u32x4*)ks; R.k[1] = *(const u32x4*)(ks + 8);
    R.cf[0] = *(const u32x4*)cfs; R.cf[1] = *(const u32x4*)(cfs + 8); R.cb[0] = *(const u32x4*)cbs; R.cb[1] = *(const u32x4*)(cbs + 8);
#pragma unroll
    for (int q = 0; q < 4; ++q) R.v[q] = *(const u32x4*)(vs + 8 * q);
    if (tid < 128) { const f32x4* g = (const f32x4*)(gp + (size_t)(row0 + tid) * 16); const f32x4 g0 = g[0], g1 = g[1], g2 = g[2], g3 = g[3]; R.g[0] = g0[h]; R.g[1] = g1[h]; R.g[2] = g2[h]; R.g[3] = g3[h]; }
    else if (tid < 192) R.np = Nprev[of * 64 + tid - 128];
    else if (tid < 256) R.np = Nprev[ob * 64 + tid - 192];
    R.mpf = Mprev[of]; R.mpb = Mprev[ob];
}
__device__ __forceinline__ void mlstm_item(const P& p, int it, char* smem, const MlstmRegs& R) {
    const int tid = tidx(), wid = tid >> 6, lane = tid & 63, fr = lane & 15, fq = lane >> 4;
    const int b = it >> 8, h = (it >> 6) & 3, c = it & 63;
    const int row0 = b * T + c * 128;
    char* Qs = smem;
    char* Ks = smem + 18432;
    char* Cf = smem + 2 * 18432;
    char* Cb = smem + 3 * 18432;
    char* VT = smem + 4 * 18432;
    char* Ps = VT + 34816;
    float* sc = (float*)(Ps + 34816);
    float *li_f = sc, *lf_f = sc + 128, *li_b = sc + 256, *lf_b = sc + 384, *beta_f = sc + 768, *beta_b = sc + 896,
          *alpha_f = sc + 1024, *alpha_b = sc + 1152, *eint_f = sc + 1280, *eint_b = sc + 1408, *emm_f = sc + 1536, *emm_b = sc + 1664, *nq_f = sc + 1792, *nq_b = sc + 1920,
          *cfa = sc + 2048, *cba = sc + 2176, *npf = sc + 2304, *npb = sc + 2368;
    const bf16_t* SO = (const bf16_t*)(p.ws + WS_SO);
    unsigned char* mix = (unsigned char*)(p.ws + WS_MIX);
    {
        const int pr = tid >> 2, kc = (tid & 3) * 16, vc = (tid & 3) * 32;
        *(u32x4*)(Qs + pr * 144 + kc * 2) = R.q[0]; *(u32x4*)(Qs + pr * 144 + kc * 2 + 16) = R.q[1];
        *(u32x4*)(Ks + pr * 144 + kc * 2) = R.k[0]; *(u32x4*)(Ks + pr * 144 + kc * 2 + 16) = R.k[1];
        *(u32x4*)(Cf + pr * 144 + kc * 2) = R.cf[0]; *(u32x4*)(Cf + pr * 144 + kc * 2 + 16) = R.cf[1];
        *(u32x4*)(Cb + pr * 144 + kc * 2) = R.cb[0]; *(u32x4*)(Cb + pr * 144 + kc * 2 + 16) = R.cb[1];
#pragma unroll
        for (int q = 0; q < 4; ++q) {
            const unsigned w[4] = {R.v[q].x, R.v[q].y, R.v[q].z, R.v[q].w};
#pragma unroll
            for (int i = 0; i < 4; ++i) { *(bf16_t*)(VT + (vc + 8 * q + 2 * i) * 272 + pr * 2) = (bf16_t)(w[i] & 0xffff); *(bf16_t*)(VT + (vc + 8 * q + 2 * i + 1) * 272 + pr * 2) = (bf16_t)(w[i] >> 16); }
        }
        if (tid < 128) { li_f[tid] = R.g[0]; lf_f[tid] = logsigmoidf_(R.g[1]); li_b[tid] = R.g[2]; lf_b[tid] = logsigmoidf_(R.g[3]); }
        else if (tid < 192) npf[tid - 128] = R.np;
        else if (tid < 256) npb[tid - 192] = R.np;
    }
    const float mpf = R.mpf, mpb = R.mpb;
    __syncthreads();
    if (wid == 0) {
        const float x0 = lf_f[2 * lane], x1 = lf_f[2 * lane + 1];
        const float sc_ = wscan_up_add(x0 + x1, lane);
        const float b0 = sc_ - x1, b1 = sc_;
        const float be0 = li_f[2 * lane] - b0, be1 = li_f[2 * lane + 1] - b1;
        const float msc = wscan_up_max(fmaxf(be0, be1), lane);
        float ex = __shfl_up(msc, 1); if (lane == 0) ex = -INFINITY;
        const float pm0 = fmaxf(ex, be0), pm1 = msc;
        const float a0 = b0 + mpf, a1 = b1 + mpf, m0 = fmaxf(a0, b0 + pm0), m1 = fmaxf(a1, b1 + pm1);
        *(f32x2_t*)(beta_f + 2 * lane) = (f32x2_t){be0, be1};
        *(f32x2_t*)(alpha_f + 2 * lane) = (f32x2_t){b0 - m0, b1 - m1};
        *(f32x2_t*)(eint_f + 2 * lane) = (f32x2_t){__expf(a0 - m0), __expf(a1 - m1)};
        *(f32x2_t*)(emm_f + 2 * lane) = (f32x2_t){__expf(-m0), __expf(-m1)};
    } else if (wid == 1) {
        const float x0 = lf_b[2 * lane], x1 = lf_b[2 * lane + 1];
        const float sc_ = wscan_down_add(x0 + x1, lane);
        const float b0 = sc_, b1 = sc_ - x0;
        const float be0 = li_b[2 * lane] - b0, be1 = li_b[2 * lane + 1] - b1;
        const float msc = wscan_down_max(fmaxf(be0, be1), lane);
        float ex = __shfl_down(msc, 1); if (lane == 63) ex = -INFINITY;
        const float pm1 = fmaxf(ex, be1), pm0 = msc;
        const float a0 = b0 + mpb, a1 = b1 + mpb, m0 = fmaxf(a0, b0 + pm0), m1 = fmaxf(a1, b1 + pm1);
        *(f32x2_t*)(beta_b + 2 * lane) = (f32x2_t){be0, be1};
        *(f32x2_t*)(alpha_b + 2 * lane) = (f32x2_t){b0 - m0, b1 - m1};
        *(f32x2_t*)(eint_b + 2 * lane) = (f32x2_t){__expf(a0 - m0), __expf(a1 - m1)};
        *(f32x2_t*)(emm_b + 2 * lane) = (f32x2_t){__expf(-m0), __expf(-m1)};
    } else if (wid < 4) {
        const int t = tid - 128; float a = 0.f, bsum = 0.f;
#pragma unroll
        for (int k8 = 0; k8 < 8; ++k8) {
            const u32x4 qv = *(const u32x4*)(Qs + t * 144 + k8 * 16);
            const float q[8] = {__uint_as_float(qv.x << 16), __uint_as_float(qv.x & 0xffff0000u), __uint_as_float(qv.y << 16), __uint_as_float(qv.y & 0xffff0000u),
                                __uint_as_float(qv.z << 16), __uint_as_float(qv.z & 0xffff0000u), __uint_as_float(qv.w << 16), __uint_as_float(qv.w & 0xffff0000u)};
#pragma unroll
            for (int c = 0; c < 8; ++c) { a += npf[8 * k8 + c] * q[c]; bsum += npb[8 * k8 + c] * q[c]; }
        }
        nq_f[t] = a; nq_b[t] = bsum;
    }
    __syncthreads();
    {
        f32x4 acc[8];
#pragma unroll
        for (int n = 0; n < 8; ++n) acc[n] = (f32x4){0.f, 0.f, 0.f, 0.f};
#pragma unroll
        for (int ks = 0; ks < 2; ++ks) {
            const bf16x8 a = *(const bf16x8*)(Qs + (16 * wid + fr) * 144 + (32 * ks + 8 * fq) * 2);
#pragma unroll
            for (int n = 0; n < 8; ++n) { const bf16x8 bb = *(const bf16x8*)(Ks + (16 * n + fr) * 144 + (32 * ks + 8 * fq) * 2); acc[n] = __builtin_amdgcn_mfma_f32_16x16x32_bf16(bb, a, acc[n], 0, 0, 0); }
        }
        const int t = 16 * wid + fr;
        const float af = alpha_f[t], ab = alpha_b[t];
        float rsf = 0.f, rsb = 0.f;
        f32x4 sf[8], sb[8];
#pragma unroll
        for (int n = 0; n < 8; ++n) {
            const f32x4 bf4 = *(const f32x4*)(beta_f + 16 * n + 4 * fq), bb4 = *(const f32x4*)(beta_b + 16 * n + 4 * fq);
#pragma unroll
            for (int j = 0; j < 4; ++j) {
                const int s = 16 * n + 4 * fq + j; const float qk = acc[n][j];
                const float vf = s <= t ? qk * __expf(af + bf4[j]) : 0.f;
                const float vb = s >= t ? qk * __expf(ab + bb4[j]) : 0.f;
                sf[n][j] = vf; sb[n][j] = vb; rsf += vf; rsb += vb;
            }
        }
        rsf += __shfl_xor(rsf, 16); rsf += __shfl_xor(rsf, 32); rsb += __shfl_xor(rsb, 16); rsb += __shfl_xor(rsb, 32);
        const float denf = rsf + eint_f[t] * nq_f[t], denb = rsb + eint_b[t] * nq_b[t];
        const float rf = 1.0f / fmaxf(fabsf(denf), emm_f[t]), rb = 1.0f / fmaxf(fabsf(denb), emm_b[t]);
        if (fq == 0) { cfa[t] = eint_f[t] * rf; cba[t] = eint_b[t] * rb; }
#pragma unroll
        for (int n = 0; n < 8; ++n) {
            const f32x4 pv = rf * sf[n] + rb * sb[n];
            u32x2 o; o.x = g8::cvt_pk_bf16(pv[0], pv[1]); o.y = g8::cvt_pk_bf16(pv[2], pv[3]);
            *(u32x2*)(Ps + t * 272 + (16 * n + 4 * fq) * 2) = o;
        }
    }
    __syncthreads();
    {
        f32x4 aP[8], aT[8];
        const int t = 16 * wid + fr;
        const float cf = cfa[t], cb = cba[t];
        u32x2 sov[8];
#pragma unroll
        for (int n = 0; n < 8; ++n) sov[n] = *(const u32x2*)(SO + ((size_t)row0 + t) * 512 + h * 128 + 16 * n + 4 * fq);
#pragma unroll
        for (int n = 0; n < 8; ++n) aT[n] = (f32x4){0.f, 0.f, 0.f, 0.f};
#pragma unroll
        for (int ks = 0; ks < 2; ++ks) {
            const bf16x8 a = *(const bf16x8*)(Qs + (16 * wid + fr) * 144 + (32 * ks + 8 * fq) * 2);
#pragma unroll
            for (int n = 0; n < 8; ++n) { const bf16x8 b1 = *(const bf16x8*)(Cf + (16 * n + fr) * 144 + (32 * ks + 8 * fq) * 2); aT[n] = __builtin_amdgcn_mfma_f32_16x16x32_bf16(b1, a, aT[n], 0, 0, 0); }
        }
#pragma unroll
        for (int n = 0; n < 8; ++n) { aP[n] = cf * aT[n]; aT[n] = (f32x4){0.f, 0.f, 0.f, 0.f}; }
#pragma unroll
        for (int ks = 0; ks < 2; ++ks) {
            const bf16x8 a = *(const bf16x8*)(Qs + (16 * wid + fr) * 144 + (32 * ks + 8 * fq) * 2);
#pragma unroll
            for (int n = 0; n < 8; ++n) { const bf16x8 b2 = *(const bf16x8*)(Cb + (16 * n + fr) * 144 + (32 * ks + 8 * fq) * 2); aT[n] = __builtin_amdgcn_mfma_f32_16x16x32_bf16(b2, a, aT[n], 0, 0, 0); }
        }
#pragma unroll
        for (int n = 0; n < 8; ++n) aP[n] = aP[n] + cb * aT[n];
#pragma unroll 1
        for (int ks = 0; ks < 4; ++ks) {
            const bf16x8 a = *(const bf16x8*)(Ps + (16 * wid + fr) * 272 + (32 * ks + 8 * fq) * 2);
#pragma unroll
            for (int n = 0; n < 8; ++n) { const bf16x8 bb = *(const bf16x8*)(VT + (16 * n + fr) * 272 + (32 * ks + 8 * fq) * 2); aP[n] = __builtin_amdgcn_mfma_f32_16x16x32_bf16(bb, a, aP[n], 0, 0, 0); }
        }
        float ss = 0.f;
#pragma unroll
        for (int n = 0; n < 8; ++n) ss += aP[n][0] * aP[n][0] + aP[n][1] * aP[n][1] + aP[n][2] * aP[n][2] + aP[n][3] * aP[n][3];
        ss += __shfl_xor(ss, 16); ss += __shfl_xor(ss, 32);
        const float inv = rsqrtf(ss * (1.0f / 128.0f) + EPS);
        const size_t row = (size_t)row0 + t;
#pragma unroll
        for (int n = 0; n < 8; ++n) {
            const int v = 16 * n + 4 * fq;
            const f32x4 g = *(const f32x4*)((const float*)(smem + 153600) + h * 128 + v);
            const u32x2 so = sov[n];
            const float s0 = __uint_as_float(so.x << 16), s1 = __uint_as_float(so.x & 0xffff0000u), s2 = __uint_as_float(so.y << 16), s3 = __uint_as_float(so.y & 0xffff0000u);
            *(unsigned*)(mix + row * 1024 + h * 128 + v) = pk4_fp8((f32x4){aP[n][0] * inv * g[0] * s0, aP[n][1] * inv * g[1] * s1, aP[n][2] * inv * g[2] * s2, aP[n][3] * inv * g[3] * s3} * MIX_SCALE);
        }
    }
}

__device__ __forceinline__ void conv_load(const P& p, int it, u32x4 (&U8)[8]) {
    const bf16_t* U = (const bf16_t*)(p.ws + WS_U) + (size_t)it * 64 * 512;
    const int tid = tidx();
#pragma unroll
    for (int i = 0; i < 8; ++i) U8[i] = *(const u32x4*)(U + (size_t)(tid + 512 * i) * 8);
}
__device__ __forceinline__ void conv_stage(char* smem, const u32x4 (&U8)[8]) {
    const int tid = tidx();
    char* ul = smem + 1024 + 15 * 1024;
#pragma unroll
    for (int i = 0; i < 8; ++i) *(u32x4*)(ul + (size_t)(tid + 512 * i) * 16) = U8[i];
}
__device__ __forceinline__ void conv_item(const P& p, int it, char* smem, const f32x2_t (&w2)[16], const float cb, const float lg, const float lb) {
    const int tid = tidx(), lane = tid & 63;
    const int row0 = it * 64;
    unsigned char* mix = (unsigned char*)(p.ws + WS_MIX);
    float* stat = (float*)smem;
    const bf16_t* up = (const bf16_t*)(smem + 1024);
    bf16_t* yl = (bf16_t*)(smem + 1024 + 94 * 1024);
    const int ch = tid;
#pragma unroll
    for (int i = 0; i < 15; ++i) { ((bf16_t*)(smem + 1024))[i * 512 + ch] = 0; ((bf16_t*)(smem + 1024 + 79 * 1024))[i * 512 + ch] = 0; }
    __syncthreads();
#pragma unroll 1
    for (int g = 0; g < 4; ++g) {
        f32x2_t ua[23], ub[23];
#pragma unroll
        for (int k = 0; k < 23; ++k) {
            const float e0 = bf2f(up[(16 * g + 2 * k) * 512 + ch]), e1 = bf2f(up[(16 * g + 2 * k + 1) * 512 + ch]);
            ua[k][0] = e0; ua[k][1] = e1; ub[k][0] = e1; if (k > 0) ub[k - 1][1] = e0;
        }
        ub[22][1] = 0.f;
#pragma unroll
        for (int e = 0; e < 8; ++e) {
            f32x2_t a0 = (f32x2_t){cb, 0.f}, a1 = a0;
#pragma unroll
            for (int k = 0; k < 16; ++k) { a0 = __builtin_elementwise_fma(w2[k], ua[e + k], a0); a1 = __builtin_elementwise_fma(w2[k], ub[e + k], a1); }
            yl[(16 * g + 2 * e) * 512 + ch] = f2bf(a0[0] + a0[1]);
            yl[(16 * g + 2 * e + 1) * 512 + ch] = f2bf(a1[0] + a1[1]);
        }
    }
    __syncthreads();
    {
        const int pp = tid >> 3, sub = tid & 7;
        float s1 = 0.f, s2 = 0.f;
#pragma unroll
        for (int i = 0; i < 8; ++i) {
            const u32x4 v = *(const u32x4*)(yl + pp * 512 + sub * 64 + 8 * ((i + lane) & 7));
            const unsigned wv[4] = {v.x, v.y, v.z, v.w};
#pragma unroll
            for (int c = 0; c < 4; ++c) { const float lo = __uint_as_float(wv[c] << 16), hi = __uint_as_float(wv[c] & 0xffff0000u); s1 += lo + hi; s2 += lo * lo + hi * hi; }
        }
        s1 += __shfl_xor(s1, 1); s2 += __shfl_xor(s2, 1); s1 += __shfl_xor(s1, 2); s2 += __shfl_xor(s2, 2); s1 += __shfl_xor(s1, 4); s2 += __shfl_xor(s2, 4);
        if (sub == 0) { const float mu = s1 * (1.0f / 512.0f), var = fmaxf(s2 * (1.0f / 512.0f) - mu * mu, 0.f); stat[pp * 2] = mu; stat[pp * 2 + 1] = rsqrtf(var + EPS); }
    }
    __syncthreads();
#pragma unroll 8
    for (int pp = 0; pp < 64; ++pp) {
        const float z = (bf2f(yl[pp * 512 + ch]) - stat[pp * 2]) * stat[pp * 2 + 1] * lg + lb;
        yl[pp * 512 + ch] = f2bf(siluf_(z));
    }
    __syncthreads();
#pragma unroll
    for (int i = 0; i < 4; ++i) {
        const int q = tid + 512 * i, pp = q >> 5, c16 = (q & 31) * 16;
        const u32x4 a = *(const u32x4*)(yl + pp * 512 + c16), b = *(const u32x4*)(yl + pp * 512 + c16 + 8);
        const unsigned w[8] = {a.x, a.y, a.z, a.w, b.x, b.y, b.z, b.w};
        u32x4 o;
        o.x = pk4_fp8((f32x4){__uint_as_float(w[0] << 16), __uint_as_float(w[0] & 0xffff0000u), __uint_as_float(w[1] << 16), __uint_as_float(w[1] & 0xffff0000u)} * MIX_SCALE);
        o.y = pk4_fp8((f32x4){__uint_as_float(w[2] << 16), __uint_as_float(w[2] & 0xffff0000u), __uint_as_float(w[3] << 16), __uint_as_float(w[3] & 0xffff0000u)} * MIX_SCALE);
        o.z = pk4_fp8((f32x4){__uint_as_float(w[4] << 16), __uint_as_float(w[4] & 0xffff0000u), __uint_as_float(w[5] << 16), __uint_as_float(w[5] & 0xffff0000u)} * MIX_SCALE);
        o.w = pk4_fp8((f32x4){__uint_as_float(w[6] << 16), __uint_as_float(w[6] & 0xffff0000u), __uint_as_float(w[7] << 16), __uint_as_float(w[7] & 0xffff0000u)} * MIX_SCALE);
        *(u32x4*)(mix + (size_t)(row0 + pp) * 1024 + 512 + c16) = o;
    }
}

__device__ __forceinline__ void phase5(const P& p, char* smem) {
    {
        MlstmRegs R;
        int it = blockIdx.x;
        if (it < 1024) mlstm_load(p, it, R);
        { float* ng = (float*)(smem + 153600); const int t = tidx(); if (t < NH * 128) ng[t] = p.norm_g[t]; }
        for (; it < 1024; it += gridDim.x) {
            __syncthreads();
            const MlstmRegs C = R;
            const int nx = it + gridDim.x;
            if (nx < 1024) mlstm_load(p, nx, R);
            mlstm_item(p, it, smem, C);
        }
    }
    {
        u32x4 U8[8];
        int it = blockIdx.x;
        const int ch = tidx();
        f32x2_t w2[16];
#pragma unroll
        for (int k = 0; k < 16; ++k) { w2[k][0] = p.conv_w[(2 * k) * 512 + ch]; w2[k][1] = (2 * k + 1 < 31) ? p.conv_w[(2 * k + 1) * 512 + ch] : 0.f; }
        const float cb = p.conv_b[ch], lg = p.ln_g[ch], lb = p.ln_b[ch];
        if (it < 512) conv_load(p, it, U8);
        for (; it < 512; it += gridDim.x) {
            __syncthreads();
            conv_stage(smem, U8);
            const int nx = it + gridDim.x;
            if (nx < 512) conv_load(p, nx, U8);
            conv_item(p, it, smem, w2, cb, lg, lb);
        }
    }
}

__device__ __forceinline__ void phase7(const P& p, char* smem) {
    const int tid = tidx(), wid = tid >> 6, lane = tid & 63, fr = lane & 15, fq = lane >> 4;
    float* H = (float*)smem;
    float* LP = (float*)(smem + 65792);
    float* modl = (float*)(smem + 65792 + 32768);
    int* selE = (int*)(smem + 65792 + 32768 + 12288);
    float* selW = (float*)(smem + 65792 + 32768 + 12288 + 4096);
    int* rank = (int*)(smem + 65792 + 32768 + 12288 + 8192);
    int* ebase = (int*)(smem + 65792 + 32768 + 12288 + 12288);
    int* segcnt = ebase + 64;
    int* lcnt = segcnt;
    float* vls = (float*)(segcnt + 512);
    float* gvec = (float*)(smem + 131072);
    const float* modp = (const float*)(p.ws + WS_MODP);
    const bf16_t* yx = (const bf16_t*)(p.ws + WS_YX);
    unsigned char* hx2 = (unsigned char*)(p.ws + WS_HX);
    int* cursor = (int*)(p.ws + WS_CURSOR);
    int* ltok = (int*)(p.ws + WS_LTOK);
    int* slotE = (int*)(p.ws + WS_SLOTE); int* slotP = (int*)(p.ws + WS_SLOTP); float* slotW = (float*)(p.ws + WS_SLOTW);
    bf16x8 bh[4][4];
#pragma unroll
    for (int ks = 0; ks < 4; ++ks)
#pragma unroll
        for (int n = 0; n < 4; ++n) bh[ks][n] = *(const bf16x8*)(p.ws + WS_WRH + (size_t)((((wid * 4 + ks) * 4 + n) * 64 + lane) * 16));
    const float brt = p.b_router[lane];
    u32x4 nyw[2]; f32x4 nxa[2], nxb[2];
#define P7_LOAD(row_) do { const bf16_t* yr_ = yx + (size_t)(row_) * 1024; const float* xr_ = p.x + (size_t)(row_) * 1024; _Pragma("unroll") for (int jj = 0; jj < 2; ++jj) { \
        const int idx_ = 8 * lane + 512 * jj; nyw[jj] = *(const u32x4*)(yr_ + idx_); nxa[jj] = *(const f32x4*)(xr_ + idx_); nxb[jj] = *(const f32x4*)(xr_ + idx_ + 4); } } while (0)
    if ((int)blockIdx.x < NT / 128) P7_LOAD((size_t)blockIdx.x * 128 + 2 * wid);
    { const float a0 = p.g_post_mix[tid], a1 = p.g_post_mix[tid + NTHREADS], a2 = p.g_pre_ffn[tid], a3 = p.g_pre_ffn[tid + NTHREADS]; gvec[tid] = a0; gvec[tid + NTHREADS] = a1; gvec[1024 + tid] = a2; gvec[1024 + tid + NTHREADS] = a3; }
    for (int blk = blockIdx.x; blk < NT / 128; blk += gridDim.x) {
        const int b = (blk * 128) / T;
        __syncthreads();
        if (tidx() < 64) lcnt[tidx()] = 0;
        {
            const int t0 = tidx(); float t[6];
#pragma unroll
            for (int j = 0; j < 6; ++j) { const int i = t0 + j * NTHREADS, which = i >> 10, idx = i & 1023; t[j] = modval(modp, b, (which == 0 ? 2048 : (which == 1 ? 3072 : 4096)) + idx); }
#pragma unroll
            for (int j = 0; j < 6; ++j) modl[t0 + j * NTHREADS] = t[j];
        }
        __syncthreads();
        for (int g = 0; g < 8; ++g) {
#pragma unroll 1
            for (int i = 0; i < 2; ++i) {
                const int lr = 2 * wid + i; const size_t row = (size_t)blk * 128 + g * 16 + lr;
                bf16_t* x1row = (bf16_t*)(p.ws + WS_X1B) + row * 1024;
                float y[16], xv[16]; float ss = 0.f;
#pragma unroll
                for (int jj = 0; jj < 2; ++jj) {
                    const unsigned w[4] = {nyw[jj].x, nyw[jj].y, nyw[jj].z, nyw[jj].w};
#pragma unroll
                    for (int c = 0; c < 4; ++c) { y[8 * jj + 2 * c] = __uint_as_float(w[c] << 16); y[8 * jj + 2 * c + 1] = __uint_as_float(w[c] & 0xffff0000u); xv[8 * jj + c] = nxa[jj][c]; xv[8 * jj + 4 + c] = nxb[jj][c]; }
                }
                {
                    const bool more = !(g == 7 && i == 1) || (blk + (int)gridDim.x < NT / 128);
                    const size_t nrow = i == 0 ? row + 1 : (g < 7 ? row + 15 : (size_t)(blk + gridDim.x) * 128 + 2 * wid);
                    if (more) P7_LOAD(nrow);
                }
#pragma unroll
                for (int c = 0; c < 16; ++c) ss += y[c] * y[c];
                ss = wave_sum(ss);
                const float invy = rsqrtf(ss * (1.0f / 1024.0f) + EPS);
                float s1 = 0.f;
#pragma unroll
                for (int q = 0; q < 4; ++q) {
                    const int idx = 8 * lane + 512 * (q >> 1) + 4 * (q & 1);
                    const f32x4 gt = *(const f32x4*)(modl + idx), gp = *(const f32x4*)(gvec + idx);
#pragma unroll
                    for (int c = 0; c < 4; ++c) { const float v = xv[4 * q + c] + gt[c] * (y[4 * q + c] * invy * gp[c]); xv[4 * q + c] = v; s1 += v * v; }
                }
#pragma unroll
                for (int jj = 0; jj < 2; ++jj) {
                    u32x4 o; o.x = pk2(xv[8 * jj], xv[8 * jj + 1]); o.y = pk2(xv[8 * jj + 2], xv[8 * jj + 3]); o.z = pk2(xv[8 * jj + 4], xv[8 * jj + 5]); o.w = pk2(xv[8 * jj + 6], xv[8 * jj + 7]);
                    *(u32x4*)(x1row + 8 * lane + 512 * jj) = o;
                }
                s1 = wave_sum(s1);
                const float inv1 = rsqrtf(s1 * (1.0f / 1024.0f) + EPS);
#pragma unroll
                for (int jj = 0; jj < 2; ++jj) {
                    const int idx = 8 * lane + 512 * jj;
                    float hv[8];
#pragma unroll
                    for (int h4 = 0; h4 < 2; ++h4) {
                        const f32x4 g2 = *(const f32x4*)(gvec + 1024 + idx + 4 * h4), sh = *(const f32x4*)(modl + 1024 + idx + 4 * h4), sc = *(const f32x4*)(modl + 2048 + idx + 4 * h4);
#pragma unroll
                        for (int c = 0; c < 4; ++c) hv[4 * h4 + c] = xv[8 * jj + 4 * h4 + c] * inv1 * g2[c] * (1.0f + sc[c]) + sh[c];
                        *(f32x4*)(H + lr * 1028 + idx + 4 * h4) = (f32x4){hv[4 * h4], hv[4 * h4 + 1], hv[4 * h4 + 2], hv[4 * h4 + 3]};
                    }
                    u32x2 o; o.x = pk4_fp8((f32x4){hv[0], hv[1], hv[2], hv[3]} * HX2_SCALE); o.y = pk4_fp8((f32x4){hv[4], hv[5], hv[6], hv[7]} * HX2_SCALE);
                    *(u32x2*)(hx2 + row * 1024 + idx) = o;
                }
            }
            bf16x8 bl[4][4];
#define P7_BL(ks_) do { _Pragma("unroll") for (int n = 0; n < 4; ++n) bl[ks_][n] = *(const bf16x8*)(p.ws + WS_WRL + (size_t)((((wid * 4 + (ks_)) * 4 + n) * 64 + lane) * 16)); } while (0)
            P7_BL(0); P7_BL(1);
            __syncthreads();
            {
                f32x4 acc[4];
#pragma unroll
                for (int n = 0; n < 4; ++n) acc[n] = (f32x4){0.f, 0.f, 0.f, 0.f};
#pragma unroll
                for (int ks = 0; ks < 4; ++ks) {
                    if (ks == 1) { __builtin_amdgcn_sched_barrier(0); P7_BL(2); __builtin_amdgcn_sched_barrier(0); }
                    if (ks == 2) { __builtin_amdgcn_sched_barrier(0); P7_BL(3); __builtin_amdgcn_sched_barrier(0); }
                    const f32x4 h0 = *(const f32x4*)(H + fr * 1028 + 128 * wid + 32 * ks + 8 * fq), h1 = *(const f32x4*)(H + fr * 1028 + 128 * wid + 32 * ks + 8 * fq + 4);
                    const unsigned hh[4] = {pk2(h0[0], h0[1]), pk2(h0[2], h0[3]), pk2(h1[0], h1[1]), pk2(h1[2], h1[3])};
                    const unsigned ll[4] = {pk2(h0[0] - __uint_as_float(hh[0] << 16), h0[1] - __uint_as_float(hh[0] & 0xffff0000u)), pk2(h0[2] - __uint_as_float(hh[1] << 16), h0[3] - __uint_as_float(hh[1] & 0xffff0000u)),
                                            pk2(h1[0] - __uint_as_float(hh[2] << 16), h1[1] - __uint_as_float(hh[2] & 0xffff0000u)), pk2(h1[2] - __uint_as_float(hh[3] << 16), h1[3] - __uint_as_float(hh[3] & 0xffff0000u))};
                    u32x4 ahw = (u32x4){hh[0], hh[1], hh[2], hh[3]}, alw = (u32x4){ll[0], ll[1], ll[2], ll[3]};
                    asm volatile("s_nop 1" : "+v"(ahw), "+v"(alw));
                    const bf16x8 ah = __builtin_bit_cast(bf16x8, ahw), al = __builtin_bit_cast(bf16x8, alw);
#pragma unroll
                    for (int n = 0; n < 4; ++n) {
                        acc[n] = __builtin_amdgcn_mfma_f32_16x16x32_bf16(al, bh[ks][n], acc[n], 0, 0, 0);
                        acc[n] = __builtin_amdgcn_mfma_f32_16x16x32_bf16(ah, bl[ks][n], acc[n], 0, 0, 0);
                        acc[n] = __builtin_amdgcn_mfma_f32_16x16x32_bf16(ah, bh[ks][n], acc[n], 0, 0, 0);
                    }
                }
#pragma unroll
                for (int n = 0; n < 4; ++n)
#pragma unroll
                    for (int j = 0; j < 4; ++j) LP[(wid * 16 + 4 * fq + j) * 64 + 16 * n + fr] = acc[n][j];
            }
            __syncthreads();
            {
                float sg[2]; int kbv[2];
#pragma unroll
                for (int i = 0; i < 2; ++i) {
                    const int lr = 2 * wid + i;
                    float lg = 0.f;
#pragma unroll
                    for (int w8 = 0; w8 < 8; ++w8) lg += LP[(w8 * 16 + lr) * 64 + lane];
                    sg[i] = sigmoidf_(lg);
                    const float val = sg[i] + brt;
                    int kb = __float_as_int(val); kb ^= (kb >> 31) & 0x7fffffff; kb = (kb & ~63) | (63 - lane);
                    kbv[i] = kb;
                    ((int*)vls)[(wid * 2 + i) * 64 + lane] = kb;
                }
                asm volatile("s_waitcnt lgkmcnt(0)" ::: "memory");
#pragma unroll
                for (int i = 0; i < 2; ++i) {
                    const int* kl = (const int*)vls + (wid * 2 + i) * 64;
                    const int kb = kbv[i];
                    int rk = 0;
#pragma unroll
                    for (int j4 = 0; j4 < 16; ++j4) {
                        const u32x4 o = *(const u32x4*)(kl + 4 * j4);
                        rk += ((int)o.x > kb ? 1 : 0) + ((int)o.y > kb ? 1 : 0) + ((int)o.z > kb ? 1 : 0) + ((int)o.w > kb ? 1 : 0);
                    }
                    const bool sel = rk < TOPK;
                    const float ssum = wave_sum(sel ? sg[i] : 0.f);
                    const int rr = g * 16 + 2 * wid + i;
                    if (sel) { selE[rr * 8 + rk] = lane; selW[rr * 8 + rk] = sg[i] / ssum * 2.5f; rank[rr * 8 + rk] = atomicAdd(&lcnt[lane], 1); }
                }
            }
        }
        __syncthreads();
        {
            const int t2 = tidx();
            if (t2 < 64) { const int run = lcnt[t2]; ebase[t2] = run > 0 ? atomicAdd(&cursor[t2], run) : 0; }
        }
        __syncthreads();
        for (int i = tidx(); i < 1024; i += NTHREADS) {
            const int e = selE[i], pos = ebase[e] + rank[i];
            const int tokn = blk * 128 + (i >> 3);
            ltok[(size_t)e * LCAP + pos] = tokn;
            slotE[(size_t)tokn * 8 + (i & 7)] = e; slotP[(size_t)tokn * 8 + (i & 7)] = pos; slotW[(size_t)tokn * 8 + (i & 7)] = selW[i];
        }
    }
#undef P7_LOAD
#undef P7_BL
}

__device__ __forceinline__ float sigm(float x) { return __builtin_amdgcn_rcpf(1.0f + __expf(-x)); }

struct SchedDense {
    const char* A; const char* B; int nM, nN, KB;
    __device__ __forceinline__ bool next(int i, g8::Unit& u) const {
        int pm, pn; if (!g8::static_unit(i, nM, nN, pm, pn)) return false;
        u.A = A + (size_t)pm * 256 * KB; u.B = B + (size_t)pn * 256 * KB; u.x0 = pm; u.x1 = pn; u.x2 = 0; u.x3 = 0; return true;
    }
    __device__ __forceinline__ void aoffs(const g8::Unit&, const int (&)[2], const unsigned (&)[2], unsigned (&)[2][2]) const {}
};

struct EpiInProj {
    static constexpr int NST = 0;
    bf16_t *Q, *Kb, *V, *SO, *U; const float* b_in;
    __device__ __forceinline__ void operator()(const f32x4 (&acc)[2][2][4][2], const g8::Unit& u, int wr, int wc, int fr, int fq) const {
        const int pn = u.x1; const size_t row0 = (size_t)u.x0 * 256 + wr * 64 + fr;
        if (pn < 6) {
            bf16_t* base; int ld, cofs;
            if (pn == 0) { base = Q; ld = 256; cofs = 0; } else if (pn == 1) { base = Kb; ld = 256; cofs = 0; }
            else if (pn < 4) { base = V; ld = 512; cofs = (pn - 2) * 256; } else { base = SO; ld = 512; cofs = (pn - 4) * 256; }
#pragma unroll
            for (int bj = 0; bj < 2; ++bj) {
                const int c8 = bj * 128 + wc * 32 + 8 * fq;
                const f32x4 b0 = *(const f32x4*)(b_in + pn * 256 + c8), b1 = *(const f32x4*)(b_in + pn * 256 + c8 + 4);
#pragma unroll
                for (int ai = 0; ai < 2; ++ai)
#pragma unroll
                    for (int m = 0; m < 4; ++m) {
                        const size_t row = row0 + ai * 128 + m * 16;
                        f32x4 v0 = acc[ai][bj][m][0] + b0, v1 = acc[ai][bj][m][1] + b1;
                        if (pn == 1) { v0 = v0 * 0.125f; v1 = v1 * 0.125f; }
                        if (pn >= 4) {
#pragma unroll
                            for (int c = 0; c < 4; ++c) { v0[c] = sigm(v0[c]); v1[c] = sigm(v1[c]); }
                        }
                        u32x4 w; w.x = g8::cvt_pk_bf16(v0[0], v0[1]); w.y = g8::cvt_pk_bf16(v0[2], v0[3]); w.z = g8::cvt_pk_bf16(v1[0], v1[1]); w.w = g8::cvt_pk_bf16(v1[2], v1[3]);
                        *(u32x4*)(base + row * ld + cofs + c8) = w;
                    }
            }
        } else {
            const int ucol = (pn - 6) * 128 + wc * 32 + 8 * fq;
            const f32x4 a0 = *(const f32x4*)(b_in + 1552 + ucol), a1 = *(const f32x4*)(b_in + 1552 + ucol + 4);
            const f32x4 g0 = *(const f32x4*)(b_in + 2064 + ucol), g1 = *(const f32x4*)(b_in + 2064 + ucol + 4);
#pragma unroll
            for (int ai = 0; ai < 2; ++ai)
#pragma unroll
                for (int m = 0; m < 4; ++m) {
                    const size_t row = row0 + ai * 128 + m * 16;
                    const f32x4 ga0 = acc[ai][0][m][0] + a0, ga1 = acc[ai][0][m][1] + a1, gb0 = acc[ai][1][m][0] + g0, gb1 = acc[ai][1][m][1] + g1;
                    u32x4 w; w.x = g8::cvt_pk_bf16(ga0[0] * sigm(gb0[0]), ga0[1] * sigm(gb0[1])); w.y = g8::cvt_pk_bf16(ga0[2] * sigm(gb0[2]), ga0[3] * sigm(gb0[3]));
                    w.z = g8::cvt_pk_bf16(ga1[0] * sigm(gb1[0]), ga1[1] * sigm(gb1[1])); w.w = g8::cvt_pk_bf16(ga1[2] * sigm(gb1[2]), ga1[3] * sigm(gb1[3]));
                    *(u32x4*)(U + row * 512 + ucol) = w;
                }
        }
    }
};

__device__ __forceinline__ void ctx_kv_proj(const P& p, char* smem) {
    const int tid = tidx(), wid = tid >> 6, lane = tid & 63, fr = lane & 15, fq = lane >> 4, rf = wid & 3, kh = wid >> 2;
    const bf16_t* hx = (const bf16_t*)(p.ws + WS_HX) + (size_t)NT * 1024;
    const bf16_t* wt = (const bf16_t*)(p.ws + WS_WT_IN) + (size_t)256 * 1024;
    bf16_t* Kb = (bf16_t*)(p.ws + WS_K); bf16_t* V = (bf16_t*)(p.ws + WS_V);
    f32x4* red = (f32x4*)smem;
    for (int blk = blockIdx.x; blk < 256; blk += gridDim.x) {
        const int rb = blk >> 4, cb = blk & 15;
        const bf16_t* ap = hx + (size_t)(rb * 64 + rf * 16 + fr) * 1024 + kh * 512 + fq * 8;
        const bf16_t* bp = wt + (size_t)(cb * 48 + fr) * 1024 + kh * 512 + fq * 8;
        f32x4 acc[3];
#pragma unroll
        for (int n = 0; n < 3; ++n) acc[n] = (f32x4){0.f, 0.f, 0.f, 0.f};
#pragma unroll 8
        for (int ks = 0; ks < 16; ++ks) {
            const bf16x8 a = *(const bf16x8*)(ap + ks * 32);
#pragma unroll
            for (int n = 0; n < 3; ++n) { const bf16x8 b = *(const bf16x8*)(bp + (size_t)n * 16 * 1024 + ks * 32); acc[n] = __builtin_amdgcn_mfma_f32_16x16x32_bf16(b, a, acc[n], 0, 0, 0); }
        }
        __syncthreads();
        if (kh == 1) {
#pragma unroll
            for (int n = 0; n < 3; ++n) red[(rf * 3 + n) * 64 + lane] = acc[n];
        }
        __syncthreads();
        if (kh == 0) {
            const size_t row = (size_t)NT + rb * 64 + rf * 16 + fr;
#pragma unroll
            for (int n = 0; n < 3; ++n) {
                const int col = 256 + cb * 48 + n * 16 + 4 * fq;
                f32x4 v = acc[n] + red[(rf * 3 + n) * 64 + lane] + *(const f32x4*)(p.b_in + col);
                bf16_t* dst;
                if (col < 512) { v = v * 0.125f; dst = Kb + row * 256 + (col - 256); } else dst = V + row * 512 + (col - 512);
                u32x2 o; o.x = g8::cvt_pk_bf16(v[0], v[1]); o.y = g8::cvt_pk_bf16(v[2], v[3]);
                *(u32x2*)dst = o;
            }
        }
    }
}

struct MoeTab { int cnt[128]; int pt[129]; int cb[129]; };
__device__ __forceinline__ int vblock() { const int G = gridDim.x; return (G & 7) ? (int)blockIdx.x : (int)(blockIdx.x & 7) * (G >> 3) + (int)(blockIdx.x >> 3); }
struct MoeUnit { unsigned long long B; int arow, cnt, orow, pn, lbase, pad; };
constexpr int MAXU = 24;
constexpr int LDS_TAB = 131072;
constexpr int LDS_UTAB = LDS_TAB + 2048;
constexpr int LDS_TOK = LDS_UTAB + MAXU * 32;
static_assert(LDS_TOK + MAXU * 1024 <= 160 * 1024, "LDS tables overflow");

__device__ __forceinline__ void moe_prefix(const P& p, char* smem) {
    MoeTab* mt = (MoeTab*)(smem + LDS_TAB);
    const int* cursor = (const int*)(p.ws + WS_CURSOR);
    const int tid = tidx();
    __syncthreads();
    if (tid < 64) {
        const int c = cursor[tid], t = (c + 255) >> 8;
        int st = t, sc = c;
#pragma unroll
        for (int d = 1; d < 64; d <<= 1) { const int a1 = __shfl_up(st, d), a2 = __shfl_up(sc, d); if (tid >= d) { st += a1; sc += a2; } }
        mt->cnt[tid] = c; mt->pt[tid] = st - t; mt->cb[tid] = sc - c;
        const int tt = __shfl(st, 63), tc = __shfl(sc, 63);
        mt->cnt[64 + tid] = 0; mt->pt[64 + tid] = tt; mt->cb[64 + tid] = tc;
        if (tid == 0) { mt->pt[128] = tt; mt->cb[128] = tc; }
    }
    __syncthreads();
}

struct SchedMoe {
    const char* A; const MoeUnit* ut; const int* tok; int nloc, KB; bool gather;
    __device__ __forceinline__ bool next(int i, g8::Unit& u) const {
        if (i >= nloc) return false;
        const MoeUnit* q = ut + i;
        const unsigned blo = __builtin_amdgcn_readfirstlane((unsigned)(q->B & 0xffffffffull)), bhi = __builtin_amdgcn_readfirstlane((unsigned)(q->B >> 32));
        u.B = (const char*)(((unsigned long long)bhi << 32) | blo);
        u.x0 = __builtin_amdgcn_readfirstlane(q->cnt); u.x1 = __builtin_amdgcn_readfirstlane(q->pn); u.x2 = __builtin_amdgcn_readfirstlane(q->orow);
        u.x3 = i; u.A = gather ? A : A + (size_t)__builtin_amdgcn_readfirstlane(q->arow) * KB; return true;
    }
    __device__ __forceinline__ void aoffs(const g8::Unit& u, const int (&R)[2], const unsigned (&c2)[2], unsigned (&va)[2][2]) const {
#pragma unroll
        for (int h = 0; h < 2; ++h)
#pragma unroll
            for (int j = 0; j < 2; ++j) va[h][j] = (unsigned)(tok[u.x3 * 256 + h * 128 + R[j]] * KB) + c2[j];
    }
};

__device__ __forceinline__ void phase2(const P& p, char* smem) {
    ctx_kv_proj(p, smem);
    EpiInProj E; E.Q = (bf16_t*)(p.ws + WS_Q); E.Kb = (bf16_t*)(p.ws + WS_K); E.V = (bf16_t*)(p.ws + WS_V); E.SO = (bf16_t*)(p.ws + WS_SO); E.U = (bf16_t*)(p.ws + WS_U); E.b_in = p.b_in;
    {
        SchedDense S; S.A = (const char*)(p.ws + WS_HX); S.B = (const char*)(p.ws + WS_WT_IN); S.nM = NT / 256; S.nN = 2; S.KB = 2048;
        __syncthreads();
        g8::gemm<true, false, false, 127>((LAS unsigned char*)smem, 2048, S, E);
    }
    MoeUnit* ut = (MoeUnit*)(smem + LDS_UTAB); int* tok = (int*)(smem + LDS_TOK);
    const int nunits = (NT / 256) * 8;
    const int vb = vblock(), ntot = nunits > vb ? (nunits - vb + (int)gridDim.x - 1) / (int)gridDim.x : 0;
    for (int base = 0; base < ntot; base += MAXU) {
        const int nloc = (ntot - base) < MAXU ? (ntot - base) : MAXU;
        __syncthreads();
        if ((int)tidx() < nloc) {
            const int u = vb + (base + tidx()) * gridDim.x, pm = u >> 3, pq = u & 7;
            MoeUnit q; q.pn = 2 + pq; q.pad = 0; q.lbase = 0; q.cnt = pm; q.arow = pm * 256; q.orow = q.arow;
            q.B = (unsigned long long)(p.ws + WS_WT_IN8 + (size_t)pq * 256 * 1024);
            ut[tidx()] = q;
        }
        __syncthreads();
        for (int idx = tidx(); idx < nloc * 256; idx += NTHREADS) tok[idx] = ut[idx >> 8].arow + (idx & 255);
        __syncthreads();
        SchedMoe S; S.A = (const char*)(p.ws + WS_HX8); S.ut = ut; S.tok = tok; S.nloc = nloc; S.KB = 1024; S.gather = true;
        g8::gemm<true, true, true, 127 - 8>((LAS unsigned char*)smem, 1024, S, E);
        __syncthreads();
    }
}

struct EpiOutProj {
    static constexpr int NST = 0;
    bf16_t* yx; const float* b_out;
    __device__ __forceinline__ void operator()(const f32x4 (&acc)[2][2][4][2], const g8::Unit& u, int wr, int wc, int fr, int fq) const {
        const size_t row0 = (size_t)u.x2 + wr * 64 + fr;
#pragma unroll
        for (int bj = 0; bj < 2; ++bj) {
            const int col = u.x1 * 256 + bj * 128 + wc * 32 + 8 * fq;
            const f32x4 b0 = *(const f32x4*)(b_out + col), b1 = *(const f32x4*)(b_out + col + 4);
#pragma unroll
            for (int ai = 0; ai < 2; ++ai)
#pragma unroll
                for (int m = 0; m < 4; ++m) {
                    const f32x4 v0 = acc[ai][bj][m][0] + b0, v1 = acc[ai][bj][m][1] + b1;
                    u32x4 w; w.x = g8::cvt_pk_bf16(v0[0], v0[1]); w.y = g8::cvt_pk_bf16(v0[2], v0[3]); w.z = g8::cvt_pk_bf16(v1[0], v1[1]); w.w = g8::cvt_pk_bf16(v1[2], v1[3]);
                    *(u32x4*)(yx + (row0 + ai * 128 + m * 16) * 1024 + col) = w;
                }
        }
    }
};

__device__ __forceinline__ void phase6(const P& p, char* smem) {
    MoeUnit* ut = (MoeUnit*)(smem + LDS_UTAB); int* tok = (int*)(smem + LDS_TOK);
    const int nunits = (NT / 256) * 4;
    const int vb = vblock(), ntot = nunits > vb ? (nunits - vb + (int)gridDim.x - 1) / (int)gridDim.x : 0;
    for (int base = 0; base < ntot; base += MAXU) {
        const int nloc = (ntot - base) < MAXU ? (ntot - base) : MAXU;
        __syncthreads();
        if ((int)tidx() < nloc) {
            const int u = vb + (base + tidx()) * gridDim.x;
            MoeUnit q; q.pn = u & 3; q.pad = 0; q.lbase = 0; q.cnt = 256; q.arow = (u >> 2) * 256; q.orow = q.arow;
            q.B = (unsigned long long)(p.ws + WS_WT_OUT + (size_t)q.pn * 256 * 1024);
            ut[tidx()] = q;
        }
        __syncthreads();
        for (int idx = tidx(); idx < nloc * 256; idx += NTHREADS) tok[idx] = ut[idx >> 8].arow + (idx & 255);
        __syncthreads();
        SchedMoe S; S.A = (const char*)(p.ws + WS_MIX); S.ut = ut; S.tok = tok; S.nloc = nloc; S.KB = 1024; S.gather = true;
        EpiOutProj E; E.yx = (bf16_t*)(p.ws + WS_YX); E.b_out = p.b_out;
        g8::gemm<true, true, true, 127 - 10>((LAS unsigned char*)smem, 1024, S, E);
        __syncthreads();
    }
}

struct EpiGateUp {
    static constexpr int NST = 8;
    unsigned char* act;
    __device__ __forceinline__ void operator()(const f32x4 (&acc)[2][2][4][2], const g8::Unit& u, int wr, int wc, int fr, int fq) const {
        unsigned char* base = act + (size_t)u.x2 * 256 + u.x1 * 128 + wc * 32 + 8 * fq;
#pragma unroll
        for (int ai = 0; ai < 2; ++ai)
#pragma unroll
            for (int m = 0; m < 4; ++m) {
                const int r = ai * 128 + wr * 64 + m * 16 + fr;
                const f32x4 g0 = acc[ai][0][m][0], g1 = acc[ai][0][m][1], u0 = acc[ai][1][m][0], u1 = acc[ai][1][m][1];
                f32x4 a0, a1;
#pragma unroll
                for (int c = 0; c < 4; ++c) { a0[c] = g0[c] * sigm(g0[c]) * u0[c]; a1[c] = g1[c] * sigm(g1[c]) * u1[c]; }
                u32x2 w; w.x = pk4_fp8(a0); w.y = pk4_fp8(a1);
                *(u32x2*)(base + r * 256) = w;
            }
    }
};

struct EpiDown {
    static constexpr int NST = 8;
    unsigned char* ye;
    __device__ __forceinline__ void operator()(const f32x4 (&acc)[2][2][4][2], const g8::Unit& u, int wr, int wc, int fr, int fq) const {
#pragma unroll
        for (int ai = 0; ai < 2; ++ai)
#pragma unroll
            for (int m = 0; m < 4; ++m) {
                const int r = ai * 128 + wr * 64 + m * 16 + fr;
                if (r < u.x0) {
                    u32x4 w; w.x = pk4_fp8(acc[ai][0][m][0]); w.y = pk4_fp8(acc[ai][0][m][1]); w.z = pk4_fp8(acc[ai][1][m][0]); w.w = pk4_fp8(acc[ai][1][m][1]);
                    *(u32x4*)(ye + (size_t)(u.x2 + r) * 1024 + ((u.x1 * 4 + wc) * 4 + fq) * 16) = w;
                }
            }
    }
};

__device__ __forceinline__ void phase9a(const P& p, char* smem) {
    moe_prefix(p, smem);
    const MoeTab* mt = (const MoeTab*)(smem + LDS_TAB);
    MoeUnit* ut = (MoeUnit*)(smem + LDS_UTAB); int* tok = (int*)(smem + LDS_TOK);
    const int* ltok = (const int*)(p.ws + WS_LTOK);
    const int TT = mt->pt[128], nunits = (TT + NT / 256) * 2;
    const int vb = vblock(), ntot = nunits > vb ? (nunits - vb + (int)gridDim.x - 1) / (int)gridDim.x : 0;
    for (int base = 0; base < ntot; base += MAXU) {
        const int nloc = (ntot - base) < MAXU ? (ntot - base) : MAXU;
        __syncthreads();
        if ((int)tidx() < nloc) {
            const int u = vb + (base + tidx()) * gridDim.x, mtile = u >> 1, pn = u & 1;
            MoeUnit q; q.pn = pn; q.pad = 0; q.arow = 0;
            if (mtile < TT) {
                int l = 0; { int hi = 63; while (l < hi) { const int mid = (l + hi) >> 1; if (mt->pt[mid + 1] > mtile) hi = mid; else l = mid + 1; } }
                const int ti = mtile - mt->pt[l], rem = mt->cnt[l] - ti * 256;
                q.cnt = rem < 256 ? rem : 256; q.orow = mtile * 256; q.lbase = l * LCAP + ti * 256;
                q.B = (unsigned long long)(p.ws + WS_WT_GU + ((size_t)(l & 63) * 512 + (size_t)pn * 256) * 1024);
            } else {
                const int s = mtile - TT;
                q.cnt = 256; q.orow = mtile * 256; q.lbase = -1 - s;
                q.B = (unsigned long long)(p.ws + WS_WT_GU + ((size_t)64 * 512 + (size_t)pn * 256) * 1024);
            }
            ut[tidx()] = q;
        }
        __syncthreads();
        for (int idx = tidx(); idx < nloc * 256; idx += NTHREADS) {
            const int i = idx >> 8, r = idx & 255; const int lb = ut[i].lbase, c = ut[i].cnt;
            tok[idx] = lb >= 0 ? ltok[lb + (r < c ? r : c - 1)] : (-1 - lb) * 256 + r;
        }
        __syncthreads();
        SchedMoe S; S.A = (const char*)(p.ws + WS_HX); S.ut = ut; S.tok = tok; S.nloc = nloc; S.KB = 1024; S.gather = true;
        EpiGateUp E; E.act = (unsigned char*)(p.ws + WS_ACT);
        g8::gemm<true, true, true, 127 - 8>((LAS unsigned char*)smem, 1024, S, E);
        __syncthreads();
    }
}

__device__ __forceinline__ void phase9b(const P& p, char* smem) {
    moe_prefix(p, smem);
    const MoeTab* mt = (const MoeTab*)(smem + LDS_TAB);
    MoeUnit* ut = (MoeUnit*)(smem + LDS_UTAB); int* tok = (int*)(smem + LDS_TOK);
    const int TT = mt->pt[128], nunits = (TT + NT / 256) * 4;
    const int vb = vblock(), ntot = nunits > vb ? (nunits - vb + (int)gridDim.x - 1) / (int)gridDim.x : 0;
    for (int base = 0; base < ntot; base += MAXU) {
        const int nloc = (ntot - base) < MAXU ? (ntot - base) : MAXU;
        __syncthreads();
        if ((int)tidx() < nloc) {
            const int u = vb + (base + tidx()) * gridDim.x, tl = u >> 2, pn = u & 3;
            MoeUnit q; q.pn = pn; q.pad = 0; q.lbase = 0;
            if (tl < TT) {
                int l = 0; { int hi = 63; while (l < hi) { const int mid = (l + hi) >> 1; if (mt->pt[mid + 1] > tl) hi = mid; else l = mid + 1; } }
                const int ti = tl - mt->pt[l], rem = mt->cnt[l] - ti * 256;
                q.cnt = 256; q.arow = tl * 256; q.orow = q.arow; (void)rem;
                q.B = (unsigned long long)(p.ws + WS_WT_D + ((size_t)(l & 63) * 1024 + (size_t)pn * 256) * 256);
            } else {
                const int sidx = tl - TT;
                q.cnt = 256; q.arow = tl * 256; q.orow = q.arow; (void)sidx;
                q.B = (unsigned long long)(p.ws + WS_WT_D + ((size_t)64 * 1024 + (size_t)pn * 256) * 256);
            }
            ut[tidx()] = q;
        }
        __syncthreads();
        for (int idx = tidx(); idx < nloc * 256; idx += NTHREADS) tok[idx] = ut[idx >> 8].arow + (idx & 255);
        __syncthreads();
        SchedMoe S; S.A = (const char*)(p.ws + WS_ACT); S.ut = ut; S.tok = tok; S.nloc = nloc; S.KB = 256; S.gather = true;
        EpiDown E; E.ye = (unsigned char*)(p.ws + WS_YE);
        int kb = 256; asm volatile("" : "+s"(kb));
        S.KB = kb;
        g8::gemm<true, true, true, 127>((LAS unsigned char*)smem, kb, S, E);
        __syncthreads();
    }
}

__device__ __forceinline__ void unpack_fp8x8(const u32x2 v, float (&f)[8]) {
    typedef float f2 __attribute__((ext_vector_type(2)));
    const f2 a = __builtin_amdgcn_cvt_pk_f32_fp8((int)v.x, false), b = __builtin_amdgcn_cvt_pk_f32_fp8((int)v.x, true);
    const f2 c = __builtin_amdgcn_cvt_pk_f32_fp8((int)v.y, false), d = __builtin_amdgcn_cvt_pk_f32_fp8((int)v.y, true);
    f[0] = a[0]; f[1] = a[1]; f[2] = b[0]; f[3] = b[1]; f[4] = c[0]; f[5] = c[1]; f[6] = d[0]; f[7] = d[1];
}
__device__ __forceinline__ void phase10(const P& p, char* smem) {
    moe_prefix(p, smem);
    const MoeTab* mt = (const MoeTab*)(smem + LDS_TAB);
    const int tid = tidx(), wid = tid >> 6, lane = tid & 63;
    float* modl = (float*)smem;
    const float* modp = (const float*)(p.ws + WS_MODP);
    {
        float t[8];
#pragma unroll
        for (int j = 0; j < 8; ++j) { const int i = tid + j * NTHREADS; t[j] = modval(modp, i >> 10, 5120 + (i & 1023)); }
#pragma unroll
        for (int j = 0; j < 8; ++j) modl[tid + j * NTHREADS] = t[j];
    }
    float* gl = modl + 4096;
    { const float a0 = p.g_post_ffn[tid], a1 = p.g_post_ffn[tid + NTHREADS]; gl[tid] = a0; gl[tid + NTHREADS] = a1; }
    __syncthreads();
    const unsigned char* ye = (const unsigned char*)(p.ws + WS_YE);
    const int* slotE = (const int*)(p.ws + WS_SLOTE); const int* slotP = (const int*)(p.ws + WS_SLOTP); const float* slotW = (const float*)(p.ws + WS_SLOTW);
    const int c0 = (lane >> 4) * 256 + ((lane >> 2) & 3) * 32 + (lane & 3) * 8;
    const int tstep = gridDim.x * 8;
    int sE = 0, sP = 0; float sW = 0.f;
    int nrow = 0; float nw = 0.f; u32x4 nrv[9], nxw[2];
#define P10_SLOTS(t_) do { if ((t_) < NT && lane < 8) { sE = slotE[(t_) * 8 + lane]; sP = slotP[(t_) * 8 + lane]; sW = slotW[(t_) * 8 + lane]; } } while (0)
#define P10_ROWS(t_) do { if ((t_) < NT) { nrow = lane < 8 ? mt->pt[sE] * 256 + sP : 0; nw = sW * (1.0f / YE_SCALE); \
        nrv[8] = *(const u32x4*)(ye + ((size_t)mt->pt[128] * 256 + (t_)) * 1024 + 16 * lane); \
        { const bf16_t* x1r_ = (const bf16_t*)(p.ws + WS_X1B) + (size_t)(t_) * 1024; nxw[0] = *(const u32x4*)(x1r_ + c0); nxw[1] = *(const u32x4*)(x1r_ + c0 + 128); } \
        _Pragma("unroll") for (int k = 0; k < 8; ++k) { const int row_ = __shfl(nrow, k); nrv[k] = *(const u32x4*)(ye + (size_t)row_ * 1024 + 16 * lane); } } } while (0)
    { const int t0 = blockIdx.x * 8 + wid; P10_SLOTS(t0); P10_ROWS(t0); P10_SLOTS(t0 + tstep); }
    for (int tokn = blockIdx.x * 8 + wid; tokn < NT; tokn += tstep) {
        u32x4 rv[9]; const float myw = nw; const u32x4 xw0 = nxw[0], xw1 = nxw[1];
#pragma unroll
        for (int k = 0; k < 9; ++k) rv[k] = nrv[k];
        P10_ROWS(tokn + tstep);
        P10_SLOTS(tokn + 2 * tstep);
        float a[16];
        {
            float f0[8], f1[8]; unpack_fp8x8((u32x2){rv[8].x, rv[8].y}, f0); unpack_fp8x8((u32x2){rv[8].z, rv[8].w}, f1);
#pragma unroll
            for (int i = 0; i < 8; ++i) { a[i] = f0[i] * (1.0f / YE_SCALE); a[8 + i] = f1[i] * (1.0f / YE_SCALE); }
        }
#pragma unroll
        for (int k = 0; k < 8; ++k) {
            const float wk = __shfl(myw, k);
            float f0[8], f1[8]; unpack_fp8x8((u32x2){rv[k].x, rv[k].y}, f0); unpack_fp8x8((u32x2){rv[k].z, rv[k].w}, f1);
#pragma unroll
            for (int i = 0; i < 8; ++i) { a[i] += wk * f0[i]; a[8 + i] += wk * f1[i]; }
        }
        float ss = 0.f;
#pragma unroll
        for (int i = 0; i < 16; ++i) ss += a[i] * a[i];
        ss = wave_sum(ss);
        const float inv = rsqrtf(ss * (1.0f / 1024.0f) + EPS);
        const float* gt = modl + (tokn / T) * 1024;
        float* orow = p.out + (size_t)tokn * 1024;
#pragma unroll
        for (int hh = 0; hh < 2; ++hh) {
            const u32x4 xw = hh ? xw1 : xw0;
            const unsigned wv[4] = {xw.x, xw.y, xw.z, xw.w};
#pragma unroll
            for (int q2 = 0; q2 < 2; ++q2) {
                const int idx = c0 + hh * 128 + q2 * 4, q = hh * 2 + q2;
                const f32x4 g = *(const f32x4*)(gl + idx), gg = *(const f32x4*)(gt + idx);
                f32x4 o;
                o[0] = __uint_as_float(wv[2 * q2] << 16); o[1] = __uint_as_float(wv[2 * q2] & 0xffff0000u); o[2] = __uint_as_float(wv[2 * q2 + 1] << 16); o[3] = __uint_as_float(wv[2 * q2 + 1] & 0xffff0000u);
#pragma unroll
                for (int c = 0; c < 4; ++c) o[c] += gg[c] * (a[q * 4 + c] * inv * g[c]);
                *(f32x4*)(orow + idx) = o;
            }
        }
    }
#undef P10_SLOTS
#undef P10_ROWS
}

#define XB_TMO      128
#define XB_XCNT(j)  (256  + 64 * (j))
#define XB_XSUB(j)  (1280 + 64 * (j))
#define XB_XGEN(j)  (2304 + 64 * (j))
#define XB_TOP      3328
#define XB_TOPGEN   3392
#define XCD_BAR_WORDS 3456
#define XB_SPIN_CAP (1u << 18)
__device__ __forceinline__ unsigned xb_ld(unsigned* p)              { return __hip_atomic_load(p, __ATOMIC_RELAXED, __HIP_MEMORY_SCOPE_AGENT); }
__device__ __forceinline__ unsigned xb_add(unsigned* p, unsigned v) { return __hip_atomic_fetch_add(p, v, __ATOMIC_RELAXED, __HIP_MEMORY_SCOPE_AGENT); }
__device__ __forceinline__ unsigned xb_xcc_id() { return (unsigned)__builtin_amdgcn_s_getreg((3 << 11) | 20) & 0xFu; }
#define XB_SPIN(cond, bar) do { unsigned _sp = 0; while (cond) { __builtin_amdgcn_s_sleep(1); \
    if ((++_sp & 255u) == 0u) { if (xb_ld(&(bar)[XB_TMO])) break; if (_sp > XB_SPIN_CAP) { atomicAdd(&(bar)[XB_TMO], 1u); break; } } } } while (0)
struct XcdBarrier { unsigned* bar; unsigned x; volatile LAS unsigned* st; };
__device__ __forceinline__ XcdBarrier xcd_barrier_post(unsigned* bar, volatile LAS unsigned* st) {
    XcdBarrier b; b.bar = bar; b.x = xb_xcc_id(); b.st = st;
    if (tidx() == 0) (void)xb_add(&bar[XB_XCNT(b.x)], 1u);
    return b;
}
__device__ __forceinline__ void xcd_barrier_complete(unsigned* bar, unsigned x, unsigned& nloc, unsigned& nx) {
    const unsigned G = gridDim.x * gridDim.y * gridDim.z;
    unsigned sum, cnt, mine, sp = 0u;
    for (;;) {
        sum = 0u; cnt = 0u; mine = 0u;
#pragma unroll
        for (unsigned j = 0; j < 16; ++j) { const unsigned c = xb_ld(&bar[XB_XCNT(j)]); sum += c; cnt += (c > 0u) ? 1u : 0u; mine = (j == x) ? c : mine; }
        if (sum == G) break;
        __builtin_amdgcn_s_sleep(1);
        if ((++sp & 255u) == 0u) { if (xb_ld(&bar[XB_TMO])) break; if (sp > XB_SPIN_CAP) { atomicAdd(&bar[XB_TMO], 1u); break; } }
    }
    nloc = mine > 0u ? mine : 1u; nx = cnt > 0u ? cnt : 1u;
}
__device__ __forceinline__ void xcd_barrier(const XcdBarrier& b) {
    asm volatile("s_waitcnt vmcnt(0)" ::: "memory");
    __syncthreads();
    if (tidx() == 0) {
        unsigned* bar = b.bar;
        __builtin_amdgcn_s_waitcnt(0);
        unsigned nloc = b.st[0], nx = b.st[1];
        if (nloc == 0u) { xcd_barrier_complete(bar, b.x, nloc, nx); b.st[0] = nloc; b.st[1] = nx; }
        const unsigned old = xb_add(&bar[XB_XSUB(b.x)], 1u);
        const unsigned gen = old / nloc;
        if (old + 1u == (gen + 1u) * nloc) {
            __builtin_amdgcn_fence(__ATOMIC_RELEASE, "agent");
            asm volatile("s_waitcnt vmcnt(0)" ::: "memory");
            const unsigned og = xb_add(&bar[XB_TOP], 1u);
            const unsigned tg = og / nx;
            if (og + 1u == (tg + 1u) * nx) xb_add(&bar[XB_TOPGEN], 1u);
            else XB_SPIN(xb_ld(&bar[XB_TOPGEN]) == tg, bar);
            __builtin_amdgcn_fence(__ATOMIC_ACQUIRE, "agent");
            xb_add(&bar[XB_XGEN(b.x)], 1u);
            asm volatile("s_waitcnt vmcnt(0)" ::: "memory");
        } else {
            XB_SPIN(xb_ld(&bar[XB_XGEN(b.x)]) == gen, bar);
            __builtin_amdgcn_fence(__ATOMIC_ACQUIRE, "agent");
            asm volatile("s_waitcnt vmcnt(0)" ::: "memory");
        }
    }
    __syncthreads();
}

constexpr int LDS_BYTES = 160 * 1024;
__global__ void __launch_bounds__(NTHREADS) k_mega(P p) {
    extern __shared__ __attribute__((aligned(16))) char smem[];
    cg::grid_group grid = cg::this_grid();
    volatile LAS unsigned* xbst = (volatile LAS unsigned*)(smem + 160 * 1024 - 64);
    if (tidx() == 0) { xbst[0] = 0u; xbst[1] = 0u; }
    __syncthreads();
    const XcdBarrier xb = xcd_barrier_post((unsigned*)(p.ws + WS_BAR), xbst);
#define RUN(bit, call) do { call; xcd_barrier(xb); if (DUP_MASK & (1 << (bit))) { call; xcd_barrier(xb); } } while (0)
    phase0(p, smem);
    if (p.ws == nullptr) grid.sync();
    if (DUP_MASK & 1) phase0(p, smem);
    RUN(1, phase1(p, smem));
    RUN(2, phase2(p, smem));
    RUN(3, phase3(p, smem));
    RUN(4, phase4(p, smem));
    RUN(5, phase5(p, smem));
    RUN(6, phase6(p, smem));
    phase7(p, smem); xcd_barrier(xb);
    if (DUP_MASK & 128) { if (blockIdx.x == 0 && tidx() < 128) ((int*)(p.ws + WS_CURSOR))[tidx()] = 0; xcd_barrier(xb); phase7(p, smem); xcd_barrier(xb); }
    RUN(8, phase9a(p, smem));
    RUN(9, phase9b(p, smem));
    phase10(p, smem);
#undef RUN
}

extern "C" void kernel_launch(void* const* d_in, const int* in_sizes, int n_in, void* d_out, int out_size, void* d_ws, size_t ws_size, hipStream_t stream) {
    if (n_in != 28 || ws_size < WS_END) { fprintf(stderr, "kernel_launch: unexpected inputs (%d) or workspace (%zu < %zu)\n", n_in, ws_size, (size_t)WS_END); return; }
    static int grid_blocks = 0;
    if (!grid_blocks) {
        int dev = 0, cus = 0, per_cu = 0;
        (void)hipGetDevice(&dev);
        (void)hipDeviceGetAttribute(&cus, hipDeviceAttributeMultiprocessorCount, dev);
        (void)hipFuncSetAttribute((const void*)k_mega, hipFuncAttributeMaxDynamicSharedMemorySize, LDS_BYTES);
        (void)hipOccupancyMaxActiveBlocksPerMultiprocessor(&per_cu, (const void*)k_mega, NTHREADS, LDS_BYTES);
        if (per_cu < 1) { fprintf(stderr, "kernel_launch: occupancy query returned %d\n", per_cu); per_cu = 1; }
        if (per_cu > 1) per_cu = 1;
        grid_blocks = cus * per_cu;
    }
    P p{};
    const float** f = (const float**)&p;
    for (int i = 0; i < 28; ++i) f[i] = (const float*)d_in[i];
    p.out = (float*)d_out; p.ws = (unsigned char*)d_ws;
    (void)hipMemsetAsync((char*)d_ws + WS_BAR, 0, (XB_ADAFLAG + 16) * 4, stream);
    void* args[] = {&p};
    hipError_t e = hipLaunchCooperativeKernel((const void*)k_mega, dim3(grid_blocks), dim3(NTHREADS), args, LDS_BYTES, stream);
    if (e != hipSuccess) fprintf(stderr, "cooperative launch failed: %s (grid %d)\n", hipGetErrorString(e), grid_blocks);
}
```

```cpp
#include <hip/hip_runtime.h>
#include <hip/hip_cooperative_groups.h>
#include <cstdio>
#include <cstdint>

#ifndef DUP_MASK
#define DUP_MASK 0
#endif
#ifndef N_LAUNCH_MODE
#define N_LAUNCH_MODE 0
#endif

namespace cg = cooperative_groups;

typedef unsigned short bf16_t;
typedef short bf16x8 __attribute__((ext_vector_type(8)));
typedef float f32x4 __attribute__((ext_vector_type(4)));
typedef unsigned u32x2 __attribute__((ext_vector_type(2)));
typedef float f32x2_t __attribute__((ext_vector_type(2)));
typedef unsigned u32x4 __attribute__((ext_vector_type(4)));
#define LAS __attribute__((address_space(3)))

constexpr int D = 1024, NB = 4, T = 8192, NT = NB * T, CTXL = 256, CT = NB * CTXL, NR = NT + CT;
constexpr int DIN = 2576, NH = 4, DV = 128, DK = 64, NE = 64, TOPK = 8, DE = 256;
constexpr int NCH = 66;
constexpr float EPS = 1e-6f;
constexpr int NTHREADS = 512;

constexpr size_t al256(size_t x) { return (x + 255) & ~(size_t)255; }
constexpr int HT = NT / 2;
constexpr int LCAP = NT;
constexpr size_t WS_WT_D = 0;
constexpr size_t WS_MODP = WS_WT_D + (size_t)65 * 1024 * 256 * 2;
constexpr size_t WS_LTOK = WS_MODP + (size_t)8 * 5 * 6144 * 4;
constexpr size_t WS_SLOTE = WS_LTOK + (size_t)64 * LCAP * 4;
constexpr size_t WS_SLOTP = WS_SLOTE + (size_t)NT * 8 * 4;
constexpr size_t WS_SLOTW = WS_SLOTP + (size_t)NT * 8 * 4;
constexpr size_t WS_CURSOR = WS_SLOTW + (size_t)NT * 8 * 4;
constexpr size_t WS_WRH = WS_CURSOR + 1024;
constexpr size_t WS_WRL = WS_WRH + 131072;
constexpr size_t WS_BAR = WS_WRL + 131072;
constexpr size_t WS_GP = WS_BAR + 16384;
constexpr size_t WS_Z1 = al256(WS_GP + (size_t)NR * 16 * 4);
constexpr size_t WS_WT_IN = WS_Z1;
constexpr size_t WS_WT_IN8 = WS_WT_IN + (size_t)1024 * 1024 * 2;
constexpr size_t WS_WT_OUT = WS_WT_IN + (size_t)2560 * 1024 * 2;
constexpr size_t WS_WT_GU = WS_WT_OUT + (size_t)1024 * 1024 * 2;
constexpr size_t WS_HX = WS_WT_GU + (size_t)65 * 512 * 1024 * 2;
constexpr size_t WS_RA = WS_HX + (size_t)NR * 1024 * 2;
constexpr size_t WS_Q = WS_RA;
constexpr size_t WS_K = WS_Q + (size_t)NR * 256 * 2;
constexpr size_t WS_V = WS_K + (size_t)NR * 256 * 2;
constexpr size_t WS_SO = WS_V + (size_t)NR * 512 * 2;
constexpr size_t WS_U = WS_SO + (size_t)NR * 512 * 2;
constexpr size_t WS_RA_END = WS_U + (size_t)NR * 512 * 2;
constexpr size_t WS_YX = WS_RA;
constexpr size_t WS_RB = WS_RA_END;
constexpr size_t WS_CLOC = WS_RB;
constexpr size_t WS_HX8 = WS_CLOC + (size_t)32 * NCH * 8192 * 2;
constexpr size_t WS_NLOC = WS_CLOC + (size_t)32 * NCH * 8192 * 4;
constexpr size_t WS_SCAL = WS_NLOC + (size_t)32 * NCH * 64 * 4;
constexpr size_t WS_CPREV = al256(WS_SCAL + (size_t)32 * NCH * 2 * 4);
constexpr size_t WS_NPREV = WS_CPREV + (size_t)32 * 64 * 8192 * 2;
constexpr size_t WS_MPREV = WS_NPREV + (size_t)32 * 64 * 64 * 4;
constexpr size_t WS_MIX = al256(WS_MPREV + (size_t)32 * 64 * 4);
constexpr size_t WS_RB_END = WS_MIX + (size_t)NT * 1024 * 2;
constexpr int MAXTILES = 64 + NT * 8 / 256 + NT / 256;
constexpr size_t WS_YE = WS_Z1;
constexpr size_t WS_ACT = WS_YE + (size_t)MAXTILES * 256 * 1024;
constexpr size_t WS_ACT_END = WS_ACT + (size_t)MAXTILES * 256 * 256;
constexpr size_t WS_X1B = al256(WS_ACT_END);
constexpr size_t WS_X1B_END = WS_X1B + (size_t)NT * 1024 * 2;
constexpr size_t WS_END = WS_X1B_END > WS_RB_END ? WS_X1B_END : WS_RB_END;
static_assert(WS_ACT >= WS_RA_END, "act must not overlap hx2 / gate-up weights / yx");
static_assert((size_t)NT * 1024 * 4 <= WS_RA_END - WS_RA, "yx alias overflow");
static_assert(WS_END <= (size_t)512 * 1024 * 1024, "workspace too large");

struct P {
    const float *x, *c, *ctx, *c_ctx, *w_ada, *b_ada, *g_pre_mix, *g_post_mix, *g_pre_ffn, *g_post_ffn;
    const float *w_in, *b_in, *b_gate, *norm_g, *conv_w, *conv_b, *ln_g, *ln_b, *w_out, *b_out;
    const float *w_router, *b_router, *we_gate, *we_up, *we_down, *ws_gate, *ws_up, *ws_down;
    float* out;
    unsigned char* ws;
};

__device__ __forceinline__ int tidx() { int t = threadIdx.x; asm volatile("" : "+v"(t)); return t; }
__device__ __forceinline__ unsigned hw_pk_bf16(float lo, float hi) { unsigned r; asm("s_nop 0\n\tv_cvt_pk_bf16_f32 %0, %1, %2" : "=v"(r) : "v"(lo), "v"(hi)); return r; }
__device__ __forceinline__ bf16_t f2bf(float f) { return (bf16_t)(hw_pk_bf16(f, f) & 0xffffu); }
__device__ __forceinline__ float bf2f(bf16_t b) { return __uint_as_float(((unsigned)b) << 16); }
__device__ __forceinline__ unsigned pk2(float lo, float hi) { return hw_pk_bf16(lo, hi); }
__device__ __forceinline__ unsigned pk2_sw(float lo, float hi) { unsigned a = __float_as_uint(lo), b = __float_as_uint(hi); a += 0x7FFFu + ((a >> 16) & 1u); b += 0x7FFFu + ((b >> 16) & 1u); return (a >> 16) | (b & 0xffff0000u); }
__device__ __forceinline__ unsigned pk4_fp8(const f32x4 v) {
    const float a = __builtin_amdgcn_fmed3f(v[0], -448.f, 448.f), b = __builtin_amdgcn_fmed3f(v[1], -448.f, 448.f);
    const float c = __builtin_amdgcn_fmed3f(v[2], -448.f, 448.f), d = __builtin_amdgcn_fmed3f(v[3], -448.f, 448.f);
    int w = __builtin_amdgcn_cvt_pk_fp8_f32(a, b, 0, false);
    w = __builtin_amdgcn_cvt_pk_fp8_f32(c, d, w, true);
    return (unsigned)w;
}
template <int CTRL, int RMASK> __device__ __forceinline__ float dpp_get(float oldv, float v) {
    return __int_as_float(__builtin_amdgcn_update_dpp(__float_as_int(oldv), __float_as_int(v), CTRL, RMASK, 0xf, false));
}
__device__ __forceinline__ float wave_sum(float v) {
    v += dpp_get<0xB1, 0xf>(0.f, v);
    v += dpp_get<0x4E, 0xf>(0.f, v);
    v += dpp_get<0x141, 0xf>(0.f, v);
    v += dpp_get<0x140, 0xf>(0.f, v);
    v += dpp_get<0x142, 0xa>(0.f, v);
    v += dpp_get<0x143, 0xc>(0.f, v);
    return __int_as_float(__builtin_amdgcn_readlane(__float_as_int(v), 63));
}
__device__ __forceinline__ float wave_max(float v) {
    v = fmaxf(v, dpp_get<0xB1, 0xf>(v, v));
    v = fmaxf(v, dpp_get<0x4E, 0xf>(v, v));
    v = fmaxf(v, dpp_get<0x141, 0xf>(v, v));
    v = fmaxf(v, dpp_get<0x140, 0xf>(v, v));
    v = fmaxf(v, dpp_get<0x142, 0xa>(v, v));
    v = fmaxf(v, dpp_get<0x143, 0xc>(v, v));
    return __int_as_float(__builtin_amdgcn_readlane(__float_as_int(v), 63));
}
__device__ __forceinline__ float sigmoidf_(float x) { return 1.0f / (1.0f + __expf(-x)); }
__device__ __forceinline__ float siluf_(float x) { return x / (1.0f + __expf(-x)); }
__device__ __forceinline__ float logsigmoidf_(float x) { return fminf(x, 0.0f) - log1pf(__expf(-fabsf(x))); }
__device__ __forceinline__ float modval(const float* modp, int r, int idx) { return modp[(size_t)r * 6144 + idx]; }
__device__ __forceinline__ void glds16(const void* g, char* l) {
    __builtin_amdgcn_global_load_lds((const __attribute__((address_space(1))) unsigned*)g, (LAS unsigned*)l, 16, 0, 0);
}

template <bool FWD> __device__ __forceinline__ float masked_sum128(const float* a, int t) {
    float s = 0.f;
#pragma unroll 8
    for (int j4 = 0; j4 < 32; ++j4) {
        const f32x4 v = *(const f32x4*)(a + 4 * j4); const int j = 4 * j4;
        if (FWD) s += ((j <= t ? v[0] : 0.f) + (j + 1 <= t ? v[1] : 0.f)) + ((j + 2 <= t ? v[2] : 0.f) + (j + 3 <= t ? v[3] : 0.f));
        else     s += ((j >= t ? v[0] : 0.f) + (j + 1 >= t ? v[1] : 0.f)) + ((j + 2 >= t ? v[2] : 0.f) + (j + 3 >= t ? v[3] : 0.f));
    }
    return s;
}
template <bool FWD> __device__ __forceinline__ float masked_max128(const float* a, int t) {
    float s = -INFINITY;
#pragma unroll 8
    for (int j4 = 0; j4 < 32; ++j4) {
        const f32x4 v = *(const f32x4*)(a + 4 * j4); const int j = 4 * j4;
        if (FWD) s = fmaxf(fmaxf(s, fmaxf(j <= t ? v[0] : -INFINITY, j + 1 <= t ? v[1] : -INFINITY)), fmaxf(j + 2 <= t ? v[2] : -INFINITY, j + 3 <= t ? v[3] : -INFINITY));
        else     s = fmaxf(fmaxf(s, fmaxf(j >= t ? v[0] : -INFINITY, j + 1 >= t ? v[1] : -INFINITY)), fmaxf(j + 2 >= t ? v[2] : -INFINITY, j + 3 >= t ? v[3] : -INFINITY));
    }
    return s;
}
__device__ __forceinline__ float reduce16(const float (&g)[16], int lane) {
    float h8[8], h4[4], h2[2];
    const bool b5 = lane & 32, b4 = lane & 16, b3 = lane & 8, b2 = lane & 4;
#pragma unroll
    for (int i = 0; i < 8; ++i) { const float keep = b5 ? g[i + 8] : g[i], send = b5 ? g[i] : g[i + 8]; h8[i] = keep + __shfl_xor(send, 32); }
#pragma unroll
    for (int i = 0; i < 4; ++i) { const float keep = b4 ? h8[i + 4] : h8[i], send = b4 ? h8[i] : h8[i + 4]; h4[i] = keep + __shfl_xor(send, 16); }
#pragma unroll
    for (int i = 0; i < 2; ++i) { const float keep = b3 ? h4[i + 2] : h4[i], send = b3 ? h4[i] : h4[i + 2]; h2[i] = keep + __shfl_xor(send, 8); }
    float r = (b2 ? h2[1] : h2[0]) + __shfl_xor(b2 ? h2[0] : h2[1], 4);
    r += __shfl_xor(r, 2); r += __shfl_xor(r, 1);
    return r;
}

template <int CTRL, int RMASK> __device__ __forceinline__ float dpp_get_bc(float oldv, float v) {
    return __int_as_float(__builtin_amdgcn_update_dpp(__float_as_int(oldv), __float_as_int(v), CTRL, RMASK, 0xf, false));
}
__device__ __forceinline__ float wscan_up_add(float v, int lane) {
    (void)lane;
    v += dpp_get_bc<0x111, 0xf>(0.f, v);
    v += dpp_get_bc<0x112, 0xf>(0.f, v);
    v += dpp_get_bc<0x114, 0xf>(0.f, v);
    v += dpp_get_bc<0x118, 0xf>(0.f, v);
    v += dpp_get_bc<0x142, 0xa>(0.f, v);
    v += dpp_get_bc<0x143, 0xc>(0.f, v);
    return v;
}
__device__ __forceinline__ float wscan_up_max(float v, int lane) {
    (void)lane;
    v = fmaxf(v, dpp_get_bc<0x111, 0xf>(v, v));
    v = fmaxf(v, dpp_get_bc<0x112, 0xf>(v, v));
    v = fmaxf(v, dpp_get_bc<0x114, 0xf>(v, v));
    v = fmaxf(v, dpp_get_bc<0x118, 0xf>(v, v));
    v = fmaxf(v, dpp_get_bc<0x142, 0xa>(v, v));
    v = fmaxf(v, dpp_get_bc<0x143, 0xc>(v, v));
    return v;
}
__device__ __forceinline__ float wscan_down_add(float v, int lane) {
    v = __shfl(v, 63 - lane); v = wscan_up_add(v, lane); return __shfl(v, 63 - lane);
}
__device__ __forceinline__ float wscan_down_max(float v, int lane) {
    v = __shfl(v, 63 - lane); v = wscan_up_max(v, lane); return __shfl(v, 63 - lane);
}
__device__ __forceinline__ int seq_row0(int s, int cid) { return cid < 2 ? NT + s * CTXL + cid * 128 : s * T + (cid - 2) * 128; }

namespace g8 {
constexpr int BM = 256, BK = 64, HALF = 128, HTB = HALF * BK * 2, STAGE_BYTES = 8 * HTB;
__device__ __forceinline__ int lds_byte(int r, int c) { const int st = (r >> 4) * 2 + (c >> 5), rr = r & 15, cc = c & 31, ob = rr * 64 + cc * 2; return st * 1024 + (ob ^ (((ob >> 9) & 1) << 5)); }
__device__ __forceinline__ void stage_rc(int b, int& R, int& C) { const int st = b / 1024, sb = b % 1024, swz = sb ^ (((sb >> 9) & 1) << 5); R = (st >> 1) * 16 + swz / 64; C = (st & 1) * 32 + (swz % 64) / 2; }
__device__ __forceinline__ int perm32(int rho) { const int n = rho >> 4, i = rho & 15; return 8 * (i >> 2) + 4 * n + (i & 3); }
__device__ __forceinline__ unsigned cvt_pk_bf16(float lo, float hi) { unsigned r; asm volatile("s_nop 0\n\tv_cvt_pk_bf16_f32 %0, %1, %2" : "=v"(r) : "v"(lo), "v"(hi)); return r; }

struct Unit { const char* A; const char* B; int x0, x1, x2, x3; };

typedef int v8i_t __attribute__((ext_vector_type(8)));
template <bool PERM, bool GATHER, bool FP8, int SCB, class Sched, class Epi>
__device__ __forceinline__ void gemm(LAS unsigned char* lds, const int KB, const Sched& S, const Epi& E) {
    const int tid = tidx(), wid = __builtin_amdgcn_readfirstlane(tid >> 6), lane = tid & 63, wr = wid >> 2, wc = wid & 3, fr = lane & 15, fq = lane >> 4;
    const int nt = KB / 128;
    int R[2]; unsigned c2[2], voffB[2], vb[2];
#pragma unroll
    for (int i = 0; i < 2; ++i) { int C; stage_rc(tid * 16 + i * 8192, R[i], C); const int Rb = PERM ? ((R[i] & ~31) + perm32(R[i] & 31)) : R[i]; voffB[i] = (unsigned)(Rb * KB + C * 2); vb[i] = (unsigned)(R[i] * KB + C * 2); c2[i] = (unsigned)C * 2u; }
    const size_t kstep = (size_t)(BK * 2);
    const size_t hstep = (size_t)HALF * KB;
    const unsigned ldsw = (unsigned)wid * 1024u;
    const int ca0 = FP8 ? (fq >> 1) * 32 + (fq & 1) * 16 : fq * 8, ca1 = FP8 ? ca0 + 8 : 32 + fq * 8;
    const int pa0 = lds_byte(wr * 64 + fr, ca0), pa1 = lds_byte(wr * 64 + fr, ca1), pb0 = lds_byte(wc * 32 + fr, ca0), pb1 = lds_byte(wc * 32 + fr, ca1);
#define G8_SA(b, h) (((b) * 2 + (h)) * HTB)
#define G8_SB(b, h) ((4 + (b) * 2 + (h)) * HTB)
#define G8_STAGE(bufoff, gbase, voff) do { _Pragma("unroll") for (int _i = 0; _i < 2; ++_i) \
        __builtin_amdgcn_global_load_lds((const __attribute__((address_space(1))) unsigned*)((const char*)(gbase) + (voff)[_i]), (LAS unsigned*)(lds + (bufoff) + ldsw + _i * 8192), 16, 0, 0); } while (0)
#define G8_LDA(dst, b, h) do { _Pragma("unroll") for (int m = 0; m < 4; ++m) _Pragma("unroll") for (int k = 0; k < 2; ++k) dst[m][k] = *(const LAS bf16x8*)(lds + G8_SA(b, h) + (k ? pa1 : pa0) + m * 2048); } while (0)
#define G8_LDB(dst, b, h) do { _Pragma("unroll") for (int n = 0; n < 2; ++n) _Pragma("unroll") for (int k = 0; k < 2; ++k) dst[n][k] = *(const LAS bf16x8*)(lds + G8_SB(b, h) + (k ? pb1 : pb0) + n * 2048); } while (0)
#define G8_CAT(x) __builtin_shufflevector(__builtin_bit_cast(u32x4, (x)[0]), __builtin_bit_cast(u32x4, (x)[1]), 0, 1, 2, 3, 4, 5, 6, 7)
#define G8_MMA(ai, bj, At, Bt) do { __builtin_amdgcn_s_setprio(1); _Pragma("unroll") for (int m = 0; m < 4; ++m) _Pragma("unroll") for (int n = 0; n < 2; ++n) { \
        if (FP8) acc[ai][bj][m][n] = __builtin_amdgcn_mfma_scale_f32_16x16x128_f8f6f4(__builtin_bit_cast(v8i_t, G8_CAT(Bt[n])), __builtin_bit_cast(v8i_t, G8_CAT(At[m])), acc[ai][bj][m][n], 0, 0, 0, 0x7F7F7F7F, 0, SCB * 0x01010101); \
        else { _Pragma("unroll") for (int k = 0; k < 2; ++k) acc[ai][bj][m][n] = __builtin_amdgcn_mfma_f32_16x16x32_bf16(Bt[n][k], At[m][k], acc[ai][bj][m][n], 0, 0, 0); } } \
        __builtin_amdgcn_s_setprio(0); } while (0)
#define G8_WAIT_V(n) asm volatile("s_waitcnt vmcnt(" #n ")" ::: "memory")
#define G8_WAIT_L(n) asm volatile("s_waitcnt lgkmcnt(" #n ")" ::: "memory")
#define G8_BAR __builtin_amdgcn_s_barrier()
#define G8_SCHED __builtin_amdgcn_sched_barrier(0)
    Unit cur, nxt; int ui = 0;
    if (!S.next(0, cur)) return;
    f32x4 acc[2][2][4][2];
#define G8_ZERO_ACC() do { _Pragma("unroll") for (int a = 0; a < 2; ++a) _Pragma("unroll") for (int b = 0; b < 2; ++b) _Pragma("unroll") for (int m = 0; m < 4; ++m) _Pragma("unroll") for (int n = 0; n < 2; ++n) { \
        f32x2_t z0_, z1_; asm volatile("v_mov_b64 %0, 0" : "=v"(z0_)); asm volatile("v_mov_b64 %0, 0" : "=v"(z1_)); acc[a][b][m][n] = __builtin_shufflevector(z0_, z1_, 0, 1, 2, 3); } } while (0)
    G8_ZERO_ACC();
    bf16x8 At[4][2], B0[2][2], B1[2][2];
    unsigned va[2][2];
    if (GATHER) S.aoffs(cur, R, c2, va);
    else { va[0][0] = vb[0]; va[0][1] = vb[1]; va[1][0] = vb[0]; va[1][1] = vb[1]; }
    const size_t ah = GATHER ? (size_t)0 : hstep;
    const char* cA = cur.A; const char* cB = cur.B;
    G8_STAGE(G8_SB(0, 0), cB, voffB); G8_STAGE(G8_SA(0, 0), cA, va[0]); G8_STAGE(G8_SB(0, 1), cB + hstep, voffB); G8_STAGE(G8_SA(0, 1), cA + ah, va[1]);
    if (wr == 1) G8_BAR;
    G8_WAIT_V(4); G8_BAR;
    G8_STAGE(G8_SB(1, 0), cB + kstep, voffB); G8_STAGE(G8_SA(1, 0), cA + kstep, va[0]); G8_STAGE(G8_SB(1, 1), cB + hstep + kstep, voffB);
    G8_WAIT_V(6); G8_BAR;
    for (;;) {
        const bool has_next = S.next(ui + 1, nxt);
        const char* nA = has_next ? nxt.A : cA; const char* nB = has_next ? nxt.B : cB;
#pragma unroll 1
        for (int t = 0; t < nt; t += 2) {
            const bool last = (t == nt - 2);
            const char* a1 = cA + (size_t)(t + 1) * kstep;
            G8_LDB(B0, 0, 0); G8_SCHED; G8_LDA(At, 0, 0); G8_STAGE(G8_SA(1, 1), a1 + ah, va[1]);
            G8_WAIT_L(8); G8_BAR; G8_WAIT_L(0); G8_MMA(0, 0, At, B0); G8_BAR; G8_SCHED;
            if (GATHER) { if (last && has_next) S.aoffs(nxt, R, c2, va); }
            const char* a2 = last ? nA : cA + (size_t)(t + 2) * kstep; const char* b2 = last ? nB : cB + (size_t)(t + 2) * kstep;
            const char* a3 = a2 + kstep; const char* b3 = b2 + kstep;
            G8_SCHED;
            G8_LDB(B1, 0, 1); G8_STAGE(G8_SB(0, 0), b2, voffB);
            G8_BAR; G8_WAIT_L(0); G8_MMA(0, 1, At, B1); G8_BAR;
            G8_LDA(At, 0, 1); G8_STAGE(G8_SA(0, 0), a2, va[0]);
            G8_BAR; G8_WAIT_L(0); G8_MMA(1, 0, At, B0); G8_BAR; G8_SCHED;
            G8_STAGE(G8_SB(0, 1), b2 + hstep, voffB);
            G8_WAIT_V(6); G8_BAR; G8_MMA(1, 1, At, B1); G8_BAR;
            G8_LDB(B0, 1, 0); G8_SCHED; G8_LDA(At, 1, 0); G8_STAGE(G8_SA(0, 1), a2 + ah, va[1]);
            G8_WAIT_L(8); G8_BAR; G8_WAIT_L(0); G8_MMA(0, 0, At, B0); G8_BAR; G8_SCHED;
            G8_LDB(B1, 1, 1); G8_STAGE(G8_SB(1, 0), b3, voffB);
            G8_BAR; G8_WAIT_L(0); G8_MMA(0, 1, At, B1); G8_BAR;
            G8_LDA(At, 1, 1); G8_STAGE(G8_SA(1, 0), a3, va[0]);
            G8_BAR; G8_WAIT_L(0); G8_MMA(1, 0, At, B0); G8_BAR; G8_SCHED;
            G8_STAGE(G8_SB(1, 1), b3 + hstep, voffB);
            G8_WAIT_V(6); G8_BAR; G8_MMA(1, 1, At, B1); G8_BAR;
        }
        E(acc, cur, wr, wc, fr, fq);
        if (!has_next) break;
        G8_ZERO_ACC();
        cur = nxt; cA = nA; cB = nB; ++ui;
    }
    G8_WAIT_V(0);
    if (wr == 0) G8_BAR;
    G8_BAR;
#undef G8_ZERO_ACC
#undef G8_SA
#undef G8_SB
#undef G8_STAGE
#undef G8_LDA
#undef G8_LDB
#undef G8_MMA
#undef G8_CAT
#undef G8_WAIT_V
#undef G8_WAIT_L
#undef G8_BAR
#undef G8_SCHED
}

__device__ __forceinline__ bool static_unit(int i, int nM, int nN, int& pm, int& pn) {
    const int nwg = nM * nN, G = gridDim.x;
    const long L = (long)i * G + blockIdx.x; if (L >= nwg) return false;
    int wgid = (int)L; { const int q = nwg / 8, r = nwg % 8, xcd = wgid % 8, off = wgid / 8; wgid = (xcd < r ? xcd * (q + 1) : r * (q + 1) + (xcd - r) * q) + off; }
    const int nig = 8 * nN, gid = wgid / nig, fm = gid * 8, gsz = (nM - fm) < 8 ? (nM - fm) : 8;
    pm = fm + ((wgid % nig) % gsz); pn = (wgid % nig) / gsz; return true;
}
}

constexpr int CVT_T0 = 640, CVT_T1 = CVT_T0 + 256, CVT_T2 = CVT_T1 + 65 * 128, CVT_T3 = CVT_T2 + 65 * 64;
constexpr int ADA_ITEMS = 96;
constexpr float HX2_SCALE = 4.0f, WGU_SCALE = 64.0f;   static_assert(HX2_SCALE * WGU_SCALE == 256.0f, "the gate/up GEMM's MFMA block scale is 2^-8");
constexpr float YE_SCALE = 16.0f;
constexpr float HX8_SCALE = 4.0f, WIN8_SCALE = 64.0f;   static_assert(HX8_SCALE * WIN8_SCALE == 256.0f, "the fp8 in-projection's MFMA block scale is 2^-8");
constexpr float MIX_SCALE = 16.0f, WOUT_SCALE = 64.0f;   static_assert(MIX_SCALE * WOUT_SCALE == 1024.0f, "the out-projection's MFMA block scale is 2^-10");
constexpr float ACT_SCALE = 1.0f, WD_SCALE = YE_SCALE / ACT_SCALE;

__device__ __forceinline__ void ada_item(const P& p, int it, char* smem) {
    const int tid = tidx(), lane = tid & 63, kg = tid >> 6, cq = lane & 15, rg = lane >> 4;
    float* sc = (float*)smem;
    float* red = (float*)(smem + 20480);
    __syncthreads();
    {
        float t[10];
#pragma unroll
        for (int j = 0; j < 10; ++j) { const int i = tid + j * NTHREADS, r = i >> 10, k = i & 1023; t[j] = r < 4 ? p.c[r * 1024 + k] : p.c_ctx[k]; }
#pragma unroll
        for (int j = 0; j < 10; ++j) sc[tid + j * NTHREADS] = siluf_(t[j]);
    }
    __syncthreads();
    f32x4 a[5];
#pragma unroll
    for (int r = 0; r < 5; ++r) a[r] = (f32x4){0.f, 0.f, 0.f, 0.f};
    const float* w = p.w_ada + (size_t)(kg * 128 + rg) * 6144 + it * 64 + 4 * cq;
    const float* s0 = sc + kg * 128 + rg;
#pragma unroll 8
    for (int i = 0; i < 32; ++i) {
        const f32x4 wv = *(const f32x4*)(w + (size_t)(4 * i) * 6144);
#pragma unroll
        for (int r = 0; r < 5; ++r) a[r] += s0[r * 1024 + 4 * i] * wv;
    }
#pragma unroll
    for (int r = 0; r < 5; ++r)
#pragma unroll
        for (int c = 0; c < 4; ++c) { float v = a[r][c]; v += __shfl_xor(v, 16); v += __shfl_xor(v, 32); a[r][c] = v; }
    if (rg == 0) {
#pragma unroll
        for (int r = 0; r < 5; ++r) *(f32x4*)(red + kg * 320 + r * 64 + 4 * cq) = a[r];
    }
    __syncthreads();
    if (tid < 320) {
        const int r = tid >> 6, cc = it * 64 + (tid & 63);
        float v = p.b_ada[cc];
#pragma unroll
        for (int g = 0; g < 8; ++g) v += red[g * 320 + tid];
        ((float*)(p.ws + WS_MODP))[(size_t)r * 6144 + cc] = v;
    }
}

struct CvtTile { int job, e, k0, n0; };
__device__ __forceinline__ CvtTile cvt_decode(int t) {
    CvtTile c; c.e = 0; int kt, nt;
    if (t < CVT_T0) { kt = t / 40; nt = t % 40; c.job = nt >= 16 ? 4 : 0; }
    else if (t < CVT_T1) { c.job = 1; t -= CVT_T0; kt = t / 16; nt = t % 16; }
    else if (t < CVT_T2) { c.job = 2; t -= CVT_T1; c.e = t / 128; t %= 128; kt = t / 8; nt = t % 8; }
    else { c.job = 3; t -= CVT_T2; c.e = t / 64; t %= 64; kt = t / 16; nt = t % 16; }
    c.k0 = kt * 64; c.n0 = nt * 64; return c;
}
__device__ __forceinline__ const float* cvt_src(const P& p, const CvtTile& c, int k, int n) {
    if (c.job == 0 || c.job == 4) {
        if (n < 1536) return p.w_in + (size_t)k * DIN + n;
        const int m = n - 1536, g = m >> 8, wi = m & 255; return p.w_in + (size_t)k * DIN + (wi < 128 ? 1552 + g * 128 + wi : 2064 + g * 128 + wi - 128);
    } else if (c.job == 1) return p.w_out + (size_t)k * 1024 + n;
    else if (c.job == 2) {
        const int g = n >> 8, wi = n & 255;
        const float* gb = c.e < 64 ? p.we_gate + (size_t)c.e * 1024 * 256 : p.ws_gate;
        const float* ub = c.e < 64 ? p.we_up + (size_t)c.e * 1024 * 256 : p.ws_up;
        return wi < 128 ? gb + (size_t)k * 256 + g * 128 + wi : ub + (size_t)k * 256 + g * 128 + wi - 128;
    }
    const float* db = c.e < 64 ? p.we_down + (size_t)c.e * 256 * 1024 : p.ws_down; return db + (size_t)k * 1024 + n;
}
__device__ __forceinline__ bf16_t* cvt_dst(const P& p, const CvtTile& c, int n, int k) {
    if (c.job == 0) return (bf16_t*)(p.ws + WS_WT_IN) + (size_t)n * 1024 + k;
    if (c.job == 1) return (bf16_t*)(p.ws + WS_WT_OUT) + (size_t)n * 1024 + k;
    if (c.job == 2) return (bf16_t*)(p.ws + WS_WT_GU) + (size_t)c.e * 512 * 1024 + (size_t)n * 1024 + k;
    return (bf16_t*)(p.ws + WS_WT_D) + (size_t)c.e * 1024 * 256 + (size_t)n * 256 + k;
}
__device__ __forceinline__ void cvt_load(const P& p, int t4, f32x4 (&v)[8]) {
    const int tid = tidx();
    if (t4 * 4 >= CVT_T0 || (t4 * 4) % 40 >= 16) {
        const int q2 = tid >> 8, kq = (tid >> 4) & 15, n4 = (tid & 15) * 4;
#pragma unroll
        for (int rnd = 0; rnd < 2; ++rnd) {
            const CvtTile c = cvt_decode(t4 * 4 + q2 + 2 * rnd);
#pragma unroll
            for (int r = 0; r < 4; ++r) v[rnd * 4 + r] = *(const f32x4*)cvt_src(p, c, c.k0 + 4 * kq + r, c.n0 + n4);
        }
    } else {
        const int kp = tid >> 4, n4 = (tid & 15) * 4;
#pragma unroll
        for (int q = 0; q < 4; ++q) {
            const CvtTile c = cvt_decode(t4 * 4 + q);
            v[2 * q] = *(const f32x4*)cvt_src(p, c, c.k0 + 2 * kp, c.n0 + n4);
            v[2 * q + 1] = *(const f32x4*)cvt_src(p, c, c.k0 + 2 * kp + 1, c.n0 + n4);
        }
    }
}
__device__ __forceinline__ void cvt_store(const P& p, int t4, const f32x4 (&v)[8], char* smem) {
    const int tid = tidx();
    unsigned* tile = (unsigned*)smem;
    if (t4 * 4 >= CVT_T0 || (t4 * 4) % 40 >= 16) {
        const int q2 = tid >> 8, kq = (tid >> 4) & 15, n4 = (tid & 15) * 4;
        CvtTile c[2];
#pragma unroll
        for (int rnd = 0; rnd < 2; ++rnd) {
            c[rnd] = cvt_decode(t4 * 4 + q2 + 2 * rnd);
#pragma unroll
            for (int cc = 0; cc < 4; ++cc)
                tile[(q2 + 2 * rnd) * 1088 + (n4 + cc) * 17 + kq] = pk4_fp8((f32x4){v[rnd * 4][cc], v[rnd * 4 + 1][cc], v[rnd * 4 + 2][cc], v[rnd * 4 + 3][cc]} * (c[rnd].job == 2 ? WGU_SCALE : (c[rnd].job == 3 ? WD_SCALE : (c[rnd].job == 4 ? WIN8_SCALE : WOUT_SCALE))));
        }
        __syncthreads();
        const int nn = (tid >> 2) & 63, part = tid & 3;
#pragma unroll
        for (int rnd = 0; rnd < 2; ++rnd) {
            const unsigned* src = tile + (q2 + 2 * rnd) * 1088 + nn * 17 + part * 4;
            u32x4 w; w.x = src[0]; w.y = src[1]; w.z = src[2]; w.w = src[3];
            unsigned char* dst = c[rnd].job == 2 ? (unsigned char*)(p.ws + WS_WT_GU) + (size_t)c[rnd].e * 512 * 1024 + (size_t)(c[rnd].n0 + nn) * 1024 + c[rnd].k0 + part * 16
                               : c[rnd].job == 3 ? (unsigned char*)(p.ws + WS_WT_D) + (size_t)c[rnd].e * 1024 * 256 + (size_t)(c[rnd].n0 + nn) * 256 + c[rnd].k0 + part * 16
                               : c[rnd].job == 4 ? (unsigned char*)(p.ws + WS_WT_IN8) + (size_t)(c[rnd].n0 + nn - 1024) * 1024 + c[rnd].k0 + part * 16
                                                 : (unsigned char*)(p.ws + WS_WT_OUT) + (size_t)(c[rnd].n0 + nn) * 1024 + c[rnd].k0 + part * 16;
            *(u32x4*)dst = w;
        }
    } else {
        const int kp = tid >> 4, n4 = (tid & 15) * 4;
#pragma unroll
        for (int q = 0; q < 4; ++q)
#pragma unroll
            for (int cc = 0; cc < 4; ++cc) tile[q * 2112 + (n4 + cc) * 33 + kp] = pk2(v[2 * q][cc], v[2 * q + 1][cc]);
        __syncthreads();
        const int nn = tid >> 3, kw = (tid & 7) * 4;
#pragma unroll
        for (int q = 0; q < 4; ++q) {
            const CvtTile c = cvt_decode(t4 * 4 + q);
            u32x4 w; w.x = tile[q * 2112 + nn * 33 + kw]; w.y = tile[q * 2112 + nn * 33 + kw + 1]; w.z = tile[q * 2112 + nn * 33 + kw + 2]; w.w = tile[q * 2112 + nn * 33 + kw + 3];
            *(u32x4*)cvt_dst(p, c, c.n0 + nn, c.k0 + 2 * kw) = w;
        }
    }
}

__device__ __forceinline__ void wr_split_item(const P& p, int it) {
    const int idx = it * NTHREADS + tidx(), lane = idx & 63, n = (idx >> 6) & 3, ks = (idx >> 8) & 3, w = idx >> 10, fr = lane & 15, fq = lane >> 4;
    float v[8], lo[8]; unsigned hi[4];
#pragma unroll
    for (int j = 0; j < 8; ++j) v[j] = p.w_router[(size_t)(128 * w + 32 * ks + 8 * fq + j) * 64 + 16 * n + fr];
#pragma unroll
    for (int j = 0; j < 4; ++j) { hi[j] = pk2(v[2 * j], v[2 * j + 1]); lo[2 * j] = v[2 * j] - __uint_as_float(hi[j] << 16); lo[2 * j + 1] = v[2 * j + 1] - __uint_as_float(hi[j] & 0xffff0000u); }
    *(u32x4*)(p.ws + WS_WRH + (size_t)idx * 16) = (u32x4){hi[0], hi[1], hi[2], hi[3]};
    *(u32x4*)(p.ws + WS_WRL + (size_t)idx * 16) = (u32x4){pk2(lo[0], lo[1]), pk2(lo[2], lo[3]), pk2(lo[4], lo[5]), pk2(lo[6], lo[7])};
}

constexpr int XB_ADAFLAG = 3520;
__device__ __forceinline__ void ada_signal(const P& p) {
    asm volatile("s_waitcnt vmcnt(0)" ::: "memory");
    __syncthreads();
    if (tidx() == 0) { __builtin_amdgcn_fence(__ATOMIC_RELEASE, "agent"); __hip_atomic_fetch_add((unsigned*)(p.ws + WS_BAR) + XB_ADAFLAG, 1u, __ATOMIC_RELAXED, __HIP_MEMORY_SCOPE_AGENT); }
}
__device__ __forceinline__ void ada_wait(const P& p) {
    if (tidx() == 0) {
        unsigned* f = (unsigned*)(p.ws + WS_BAR) + XB_ADAFLAG; unsigned* tmo = (unsigned*)(p.ws + WS_BAR) + 128; unsigned sp = 0;
        while (__hip_atomic_load(f, __ATOMIC_RELAXED, __HIP_MEMORY_SCOPE_AGENT) < (unsigned)ADA_ITEMS) {
            __builtin_amdgcn_s_sleep(2);
            if ((++sp & 255u) == 0u) { if (__hip_atomic_load(tmo, __ATOMIC_RELAXED, __HIP_MEMORY_SCOPE_AGENT)) break; if (sp > (1u << 18)) { atomicAdd(tmo, 1u); break; } }
        }
        __builtin_amdgcn_fence(__ATOMIC_ACQUIRE, "agent");
    }
    __syncthreads();
}
__device__ __forceinline__ void phase0(const P& p, char* smem) {
    if (blockIdx.x == 0 && tidx() < 128) ((int*)(p.ws + WS_CURSOR))[tidx()] = 0;
    const int G = (int)gridDim.x, bid = (int)blockIdx.x;
    for (int it = G - 1 - bid; it < 16; it += G) wr_split_item(p, it);
    for (int it = bid; it < ADA_ITEMS; it += G) { ada_item(p, it, smem); ada_signal(p); }
    const int S = CVT_T3 / 4, nA = G > ADA_ITEMS ? ADA_ITEMS : 0;
    int R = (S - 2 * (G - nA) + G - 1) / G; if (R < 0) R = 0;
    const int base2 = R * G, G2 = G - nA, b2 = bid - nA;
#define P0_STEP(k_) ((k_) < R ? (k_) * G + bid : (b2 >= 0 ? base2 + b2 + ((k_) - R) * G2 : S))
    f32x4 va[8], vb[8];
    int k = 0, s0 = P0_STEP(0), s1 = P0_STEP(1);
    if (s0 < S) cvt_load(p, s0, va);
    if (s1 < S) cvt_load(p, s1, vb);
    while (s0 < S) {
        {
            f32x4 c[8];
#pragma unroll
            for (int i = 0; i < 8; ++i) c[i] = va[i];
            const int s2 = P0_STEP(k + 2);
            __syncthreads();
            if (s2 < S) cvt_load(p, s2, va);
            cvt_store(p, s0, c, smem);
            s0 = s2;
        }
        if (s1 >= S) break;
        {
            f32x4 c[8];
#pragma unroll
            for (int i = 0; i < 8; ++i) c[i] = vb[i];
            const int s3 = P0_STEP(k + 3);
            __syncthreads();
            if (s3 < S) cvt_load(p, s3, vb);
            cvt_store(p, s1, c, smem);
            s1 = s3;
        }
        k += 2;
    }
#undef P0_STEP
}

__device__ __forceinline__ void phase1(const P& p, char* smem) {
    const int tid = tidx(), wid = tid >> 6, lane = tid & 63;
    float* modl = (float*)smem;
    float* wgT = (float*)(smem + 40960);
    const float* modp = (const float*)(p.ws + WS_MODP);
    f32x4 nv[2][4];
#define P1_LOAD(r0_) do { _Pragma("unroll") for (int q = 0; q < 2; ++q) { const int row_ = (r0_) + q; const float* xr_ = row_ < NT ? p.x + (size_t)row_ * 1024 : p.ctx + (size_t)(row_ - NT) * 1024; \
        _Pragma("unroll") for (int j = 0; j < 4; ++j) nv[q][j] = *(const f32x4*)(xr_ + 4 * lane + 256 * j); } } while (0)
    if ((blockIdx.x * 8 + wid) * 2 < NR) P1_LOAD((blockIdx.x * 8 + wid) * 2);
    ada_wait(p);
    {
        float t0[20], t1[32];
#pragma unroll
        for (int j = 0; j < 20; ++j) { const int i = tid + j * NTHREADS; t0[j] = modval(modp, i >> 11, i & 2047); }
#pragma unroll
        for (int j = 0; j < 32; ++j) { const int i = tid + j * NTHREADS; t1[j] = p.w_in[(size_t)(i >> 4) * DIN + 1536 + (i & 15)]; }
#pragma unroll
        for (int j = 0; j < 20; ++j) modl[tid + j * NTHREADS] = t0[j];
#pragma unroll
        for (int j = 0; j < 32; ++j) { const int i = tid + j * NTHREADS; wgT[(i & 15) * 1024 + (i >> 4)] = t1[j]; }
    }
    float* gl = (float*)(smem + 40960 + 65536);
    { const float a0 = p.g_pre_mix[tid], a1 = p.g_pre_mix[tid + NTHREADS]; gl[tid] = a0; gl[tid + NTHREADS] = a1; }
    const int gi = ((lane >> 5) & 1) * 8 + ((lane >> 4) & 1) * 4 + ((lane >> 3) & 1) * 2 + ((lane >> 2) & 1);
    const float bb = p.b_in[1536 + gi] + p.b_gate[gi];
    __syncthreads();
    bf16_t* hx = (bf16_t*)(p.ws + WS_HX);
    float* gp = (float*)(p.ws + WS_GP);
    for (int row0 = (blockIdx.x * 8 + wid) * 2; row0 < NR; row0 += gridDim.x * 16) {
        f32x4 v[2][4]; float ss[2]; int rr[2];
#pragma unroll
        for (int q = 0; q < 2; ++q) {
            rr[q] = (row0 + q) < NT ? (row0 + q) / T : 4; ss[q] = 0.f;
#pragma unroll
            for (int j = 0; j < 4; ++j) { v[q][j] = nv[q][j]; ss[q] += v[q][j][0] * v[q][j][0] + v[q][j][1] * v[q][j][1] + v[q][j][2] * v[q][j][2] + v[q][j][3] * v[q][j][3]; }
        }
        { const int nx = row0 + gridDim.x * 16; if (nx < NR) P1_LOAD(nx); }
        ss[0] = wave_sum(ss[0]); ss[1] = wave_sum(ss[1]);
#pragma unroll
        for (int q = 0; q < 2; ++q) {
            const int row = row0 + q;
            const float inv = rsqrtf(ss[q] * (1.0f / 1024.0f) + EPS);
            const float* sh = modl + rr[q] * 2048; const float* scl = sh + 1024;
#pragma unroll
            for (int j = 0; j < 4; ++j) {
                const int idx = 4 * lane + 256 * j;
                const f32x4 g = *(const f32x4*)(gl + idx), s1 = *(const f32x4*)(sh + idx), s2 = *(const f32x4*)(scl + idx);
#pragma unroll
                for (int c = 0; c < 4; ++c) v[q][j][c] = v[q][j][c] * inv * g[c] * (1.0f + s2[c]) + s1[c];
                u32x2 o; o.x = pk2(v[q][j][0], v[q][j][1]); o.y = pk2(v[q][j][2], v[q][j][3]);
                *(u32x2*)(hx + (size_t)row * 1024 + idx) = o;
                if (row < NT) *(unsigned*)(p.ws + WS_HX8 + (size_t)row * 1024 + idx) = pk4_fp8(v[q][j] * HX8_SCALE);
            }
        }
        float ga[2][16];
#pragma unroll
        for (int jg = 0; jg < 16; ++jg) {
            f32x4 s0 = (f32x4){0.f, 0.f, 0.f, 0.f}, s1 = s0;
#pragma unroll
            for (int j = 0; j < 4; ++j) {
                const f32x4 w = *(const f32x4*)(wgT + jg * 1024 + 4 * lane + 256 * j);
                s0 = __builtin_elementwise_fma(v[0][j], w, s0); s1 = __builtin_elementwise_fma(v[1][j], w, s1);
            }
            ga[0][jg] = (s0[0] + s0[1]) + (s0[2] + s0[3]); ga[1][jg] = (s1[0] + s1[1]) + (s1[2] + s1[3]);
            if ((jg & 3) == 3) __builtin_amdgcn_sched_barrier(0);
        }
        const float r0 = reduce16(ga[0], lane), r1 = reduce16(ga[1], lane);
        if ((lane & 3) == 0) {
            gp[(size_t)row0 * 16 + gi] = r0 + bb; gp[(size_t)(row0 + 1) * 16 + gi] = r1 + bb;
        }
    }
#undef P1_LOAD
}

__device__ __forceinline__ void phase3(const P& p, char* smem) {
    const int tid = tidx(), wid = tid >> 6, lane = tid & 63, fr = lane & 15, fq = lane >> 4;
    char* KT = smem;
    char* KTWf = smem + 17408;
    char* KTWb = smem + 2 * 17408;
    char* VT = smem + 3 * 17408;
    float* sc = (float*)(smem + 3 * 17408 + 34816);
    float *li_f = sc, *lf_f = sc + 128, *li_b = sc + 256, *lf_b = sc + 384, *bfa = sc + 512, *rba = sc + 640, *wf = sc + 768, *wb = sc + 896, *red = sc + 1024;
    const bf16_t* Kb = (const bf16_t*)(p.ws + WS_K); const bf16_t* V = (const bf16_t*)(p.ws + WS_V);
    const float* gp = (const float*)(p.ws + WS_GP);
    bf16_t* Cloc = (bf16_t*)(p.ws + WS_CLOC); float* Nloc = (float*)(p.ws + WS_NLOC); float* Scal = (float*)(p.ws + WS_SCAL);
    const int nitems = NB * NH * NCH;
    u32x4 rk[2], rv[4]; float rg[4];
#define P3_LOAD(it_) do { const int s_ = (it_) / (NH * NCH), h_ = ((it_) / NCH) % NH, r0_ = seq_row0(s_, (it_) % NCH); const int pr_ = tid >> 2; \
        const bf16_t* ks_ = Kb + (size_t)(r0_ + pr_) * 256 + h_ * 64 + (tid & 3) * 16; rk[0] = *(const u32x4*)ks_; rk[1] = *(const u32x4*)(ks_ + 8); \
        const bf16_t* vs_ = V + (size_t)(r0_ + pr_) * 512 + h_ * 128 + (tid & 3) * 32; _Pragma("unroll") for (int q = 0; q < 4; ++q) rv[q] = *(const u32x4*)(vs_ + 8 * q); \
        if (tid < 128) { const f32x4* g_ = (const f32x4*)(gp + (size_t)(r0_ + tid) * 16); const f32x4 g0 = g_[0], g1 = g_[1], g2 = g_[2], g3 = g_[3]; rg[0] = g0[h_]; rg[1] = g1[h_]; rg[2] = g2[h_]; rg[3] = g3[h_]; } } while (0)
    if ((int)blockIdx.x < nitems) P3_LOAD(blockIdx.x);
    for (int it = blockIdx.x; it < nitems; it += gridDim.x) {
        const int s = it / (NH * NCH), h = (it / NCH) % NH, cid = it % NCH;
        __syncthreads();
        {
            const int pr = tid >> 2, kc = (tid & 3) * 16, vc = (tid & 3) * 32;
            const unsigned w[8] = {rk[0].x, rk[0].y, rk[0].z, rk[0].w, rk[1].x, rk[1].y, rk[1].z, rk[1].w};
#pragma unroll
            for (int i = 0; i < 8; ++i) { *(bf16_t*)(KT + (kc + 2 * i) * 272 + pr * 2) = (bf16_t)(w[i] & 0xffff); *(bf16_t*)(KT + (kc + 2 * i + 1) * 272 + pr * 2) = (bf16_t)(w[i] >> 16); }
#pragma unroll
            for (int q = 0; q < 4; ++q) {
                const unsigned wv[4] = {rv[q].x, rv[q].y, rv[q].z, rv[q].w};
#pragma unroll
                for (int i = 0; i < 4; ++i) { *(bf16_t*)(VT + (vc + 8 * q + 2 * i) * 272 + pr * 2) = (bf16_t)(wv[i] & 0xffff); *(bf16_t*)(VT + (vc + 8 * q + 2 * i + 1) * 272 + pr * 2) = (bf16_t)(wv[i] >> 16); }
            }
            if (tid < 128) { li_f[tid] = rg[0]; lf_f[tid] = logsigmoidf_(rg[1]); li_b[tid] = rg[2]; lf_b[tid] = logsigmoidf_(rg[3]); }
        }
        { const int nx = it + gridDim.x; if (nx < nitems) P3_LOAD(nx); }
        __syncthreads();
        if (wid == 0) {
            const float x0 = lf_f[2 * lane], x1 = lf_f[2 * lane + 1];
            const float sc_ = wscan_up_add(x0 + x1, lane);
            const float btot = __shfl(sc_, 63);
            const float g0 = btot - (sc_ - x1) + li_f[2 * lane], g1 = btot - sc_ + li_f[2 * lane + 1];
            const float mx = wave_max(fmaxf(g0, g1));
            *(f32x2_t*)(wf + 2 * lane) = (f32x2_t){__expf(g0 - mx), __expf(g1 - mx)};
            if (lane == 0) { red[0] = mx; bfa[127] = btot; }
        } else if (wid == 1) {
            const float x0 = lf_b[2 * lane], x1 = lf_b[2 * lane + 1];
            const float sc_ = wscan_down_add(x0 + x1, lane);
            const float btot = __shfl(sc_, 0);
            const float g0 = btot - sc_ + li_b[2 * lane], g1 = btot - (sc_ - x0) + li_b[2 * lane + 1];
            const float mx = wave_max(fmaxf(g0, g1));
            *(f32x2_t*)(wb + 2 * lane) = (f32x2_t){__expf(g0 - mx), __expf(g1 - mx)};
            if (lane == 0) { red[1] = mx; rba[0] = btot; }
        }
        __syncthreads();
#pragma unroll
        for (int rep = 0; rep < 2; ++rep) {
            const int i = tid + rep * NTHREADS, k = i >> 4, p8 = i & 15;
            const u32x4 kv = *(const u32x4*)(KT + k * 272 + p8 * 16);
            const f32x4 f0 = *(const f32x4*)(wf + 8 * p8), f1 = *(const f32x4*)(wf + 8 * p8 + 4), b0 = *(const f32x4*)(wb + 8 * p8), b1 = *(const f32x4*)(wb + 8 * p8 + 4);
            const float e[8] = {__uint_as_float(kv.x << 16), __uint_as_float(kv.x & 0xffff0000u), __uint_as_float(kv.y << 16), __uint_as_float(kv.y & 0xffff0000u),
                                __uint_as_float(kv.z << 16), __uint_as_float(kv.z & 0xffff0000u), __uint_as_float(kv.w << 16), __uint_as_float(kv.w & 0xffff0000u)};
            u32x4 of, ob;
            of.x = g8::cvt_pk_bf16(e[0] * f0[0], e[1] * f0[1]); of.y = g8::cvt_pk_bf16(e[2] * f0[2], e[3] * f0[3]); of.z = g8::cvt_pk_bf16(e[4] * f1[0], e[5] * f1[1]); of.w = g8::cvt_pk_bf16(e[6] * f1[2], e[7] * f1[3]);
            ob.x = g8::cvt_pk_bf16(e[0] * b0[0], e[1] * b0[1]); ob.y = g8::cvt_pk_bf16(e[2] * b0[2], e[3] * b0[3]); ob.z = g8::cvt_pk_bf16(e[4] * b1[0], e[5] * b1[1]); ob.w = g8::cvt_pk_bf16(e[6] * b1[2], e[7] * b1[3]);
            *(u32x4*)(KTWf + k * 272 + p8 * 16) = of; *(u32x4*)(KTWb + k * 272 + p8 * 16) = ob;
        }
        const int chain_f = (s * NH + h) * 2, chain_b = chain_f + 1;
        if (tid < 128) {
            const int dir = tid >> 6, k = tid & 63; const float* w = dir ? wb : wf;
            float a = 0.f;
#pragma unroll 4
            for (int p8 = 0; p8 < 16; ++p8) {
                const u32x4 kv = *(const u32x4*)(KT + k * 272 + p8 * 16);
                const f32x4 w0 = *(const f32x4*)(w + 8 * p8), w1 = *(const f32x4*)(w + 8 * p8 + 4);
                a += w0[0] * __uint_as_float(kv.x << 16) + w0[1] * __uint_as_float(kv.x & 0xffff0000u) + w0[2] * __uint_as_float(kv.y << 16) + w0[3] * __uint_as_float(kv.y & 0xffff0000u)
                   + w1[0] * __uint_as_float(kv.z << 16) + w1[1] * __uint_as_float(kv.z & 0xffff0000u) + w1[2] * __uint_as_float(kv.w << 16) + w1[3] * __uint_as_float(kv.w & 0xffff0000u);
            }
            Nloc[((size_t)(chain_f + dir) * NCH + cid) * 64 + k] = a;
        }
        if (tid == 0) {
            Scal[((size_t)chain_f * NCH + cid) * 2 + 0] = red[0]; Scal[((size_t)chain_f * NCH + cid) * 2 + 1] = bfa[127];
            Scal[((size_t)chain_b * NCH + cid) * 2 + 0] = red[1]; Scal[((size_t)chain_b * NCH + cid) * 2 + 1] = rba[0];
        }
        __syncthreads();
#pragma unroll
        for (int dir = 0; dir < 2; ++dir) {
            const char* KW = dir ? KTWb : KTWf;
            f32x4 acc[4];
#pragma unroll
            for (int n = 0; n < 4; ++n) acc[n] = (f32x4){0.f, 0.f, 0.f, 0.f};
#pragma unroll
            for (int ks = 0; ks < 4; ++ks) {
                const bf16x8 a = *(const bf16x8*)(VT + (16 * wid + fr) * 272 + (32 * ks + 8 * fq) * 2);
#pragma unroll
                for (int n = 0; n < 4; ++n) { const bf16x8 b = *(const bf16x8*)(KW + (16 * n + fr) * 272 + (32 * ks + 8 * fq) * 2); acc[n] = __builtin_amdgcn_mfma_f32_16x16x32_bf16(b, a, acc[n], 0, 0, 0); }
            }
            bf16_t* dst = Cloc + ((size_t)(chain_f + dir) * NCH + cid) * 8192 + (16 * wid + fr) * 64;
#pragma unroll
            for (int n = 0; n < 4; ++n) { u32x2 o; o.x = pk2_sw(acc[n][0], acc[n][1]); o.y = pk2_sw(acc[n][2], acc[n][3]); *(u32x2*)(dst + 16 * n + 4 * fq) = o; }
        }
    }
#undef P3_LOAD
}

__device__ __forceinline__ void phase4(const P& p, char* smem) {
    const int tid = tidx();
    const bf16_t* Cloc = (const bf16_t*)(p.ws + WS_CLOC); const float* Nloc = (const float*)(p.ws + WS_NLOC); const float* Scal = (const float*)(p.ws + WS_SCAL);
    bf16_t* Cprev = (bf16_t*)(p.ws + WS_CPREV); float* Nprev = (float*)(p.ws + WS_NPREV); float* Mprev = (float*)(p.ws + WS_MPREV);
    float* sl = (float*)smem;
    for (int it = blockIdx.x; it < 32 * 8; it += gridDim.x) {
        const int chain = it >> 3, slice = it & 7, dir = chain & 1;
        __syncthreads();
        for (int i = tid; i < NCH * 2; i += NTHREADS) sl[i] = Scal[(size_t)chain * NCH * 2 + i];
        __syncthreads();
        const int e0 = slice * 1024 + tid * 2;
        float c0 = 0.f, c1 = 0.f, nn = 0.f, m = 0.f;
        const bool do_n = (slice == 0 && tid < 64);
        float l0[2][11], l1[2][11], ln[2][11];
#define SCAN_LOAD(buf, st0_) do { _Pragma("unroll") for (int i = 0; i < 11; ++i) { \
            const int st = (st0_) + i, cid = dir == 0 ? st : (st < 2 ? 1 - st : NCH + 1 - st); \
            const unsigned v = *(const unsigned*)(Cloc + ((size_t)chain * NCH + cid) * 8192 + e0); l0[buf][i] = __uint_as_float(v << 16); l1[buf][i] = __uint_as_float(v & 0xffff0000u); \
            ln[buf][i] = do_n ? Nloc[((size_t)chain * NCH + cid) * 64 + tid] : 0.f; } } while (0)
#define SCAN_STEP(buf, st0_) do { _Pragma("unroll") for (int i = 0; i < 11; ++i) { \
            const int st = (st0_) + i, cid = dir == 0 ? st : (st < 2 ? 1 - st : NCH + 1 - st); \
            if (cid >= 2) { const size_t o = (size_t)chain * 64 + (cid - 2); *(unsigned*)(Cprev + o * 8192 + e0) = pk2(c0, c1); if (do_n) Nprev[o * 64 + tid] = nn; if (slice == 0 && tid == 0) Mprev[o] = m; } \
            const float ml = sl[cid * 2 + 0], bt = sl[cid * 2 + 1]; \
            const float mnew = fmaxf(bt + m, ml), a = __expf(bt + m - mnew), e = __expf(ml - mnew); \
            c0 = a * c0 + e * l0[buf][i]; c1 = a * c1 + e * l1[buf][i]; nn = a * nn + e * ln[buf][i]; m = mnew; } } while (0)
        SCAN_LOAD(0, 0);
#pragma unroll 1
        for (int st0 = 0; st0 < NCH; st0 += 22) {
            SCAN_LOAD(1, st0 + 11);
            SCAN_STEP(0, st0);
            if (st0 + 22 < NCH) SCAN_LOAD(0, st0 + 22);
            SCAN_STEP(1, st0 + 11);
        }
#undef SCAN_LOAD
#undef SCAN_STEP
    }
}

struct MlstmRegs { u32x4 q[2], k[2], cf[2], cb[2], v[4]; float g[4]; float np, mpf, mpb; };
__device__ __forceinline__ void mlstm_load(const P& p, int it, MlstmRegs& R) {
    const int tid = tidx();
    const int b = it >> 8, h = (it >> 6) & 3, c = it & 63, row0 = b * T + c * 128;
    const bf16_t* Q = (const bf16_t*)(p.ws + WS_Q); const bf16_t* Kb = (const bf16_t*)(p.ws + WS_K); const bf16_t* V = (const bf16_t*)(p.ws + WS_V);
    const float* gp = (const float*)(p.ws + WS_GP);
    const bf16_t* Cprev = (const bf16_t*)(p.ws + WS_CPREV); const float* Nprev = (const float*)(p.ws + WS_NPREV); const float* Mprev = (const float*)(p.ws + WS_MPREV);
    const int chain_f = (b * NH + h) * 2;
    const size_t of = (size_t)chain_f * 64 + c, ob = (size_t)(chain_f + 1) * 64 + c;
    const int pr = tid >> 2, kc = (tid & 3) * 16, vc = (tid & 3) * 32;
    const bf16_t* qs = Q + (size_t)(row0 + pr) * 256 + h * 64 + kc; const bf16_t* ks = Kb + (size_t)(row0 + pr) * 256 + h * 64 + kc;
    const bf16_t* cfs = Cprev + of * 8192 + pr * 64 + kc; const bf16_t* cbs = Cprev + ob * 8192 + pr * 64 + kc;
    const bf16_t* vs = V + (size_t)(row0 + pr) * 512 + h * 128 + vc;
    R.q[0] = *(const u32x4*)qs; R.q[1] = *(const u32x4*)(qs + 8); R.k[0] = *(const u32x4*)ks; R.k[1] = *(const u32x4*)(ks + 8);
    R.cf[0] = *(const u32x4*)cfs; R.cf[1] = *(const u32x4*)(cfs + 8); R.cb[0] = *(const u32x4*)cbs; R.cb[1] = *(const u32x4*)(cbs + 8);
#pragma unroll
    for (int q = 0; q < 4; ++q) R.v[q] = *(const u32x4*)(vs + 8 * q);
    if (tid < 128) { const f32x4* g = (const f32x4*)(gp + (size_t)(row0 + tid) * 16); const f32x4 g0 = g[0], g1 = g[1], g2 = g[2], g3 = g[3]; R.g[0] = g0[h]; R.g[1] = g1[h]; R.g[2] = g2[h]; R.g[3] = g3[h]; }
    else if (tid < 192) R.np = Nprev[of * 64 + tid - 128];
    else if (tid < 256) R.np = Nprev[ob * 64 + tid - 192];
    R.mpf = Mprev[of]; R.mpb = Mprev[ob];
}
__device__ __forceinline__ void mlstm_item(const P& p, int it, char* smem, const MlstmRegs& R) {
    const int tid = tidx(), wid = tid >> 6, lane = tid & 63, fr = lane & 15, fq = lane >> 4;
    const int b = it >> 8, h = (it >> 6) & 3, c = it & 63;
    const int row0 = b * T + c * 128;
    char* Qs = smem;
    char* Ks = smem + 18432;
    char* Cf = smem + 2 * 18432;
    char* Cb = smem + 3 * 18432;
    char* VT = smem + 4 * 18432;
    char* Ps = VT + 34816;
    float* sc = (float*)(Ps + 34816);
    float *li_f = sc, *lf_f = sc + 128, *li_b = sc + 256, *lf_b = sc + 384, *beta_f = sc + 768, *beta_b = sc + 896,
          *alpha_f = sc + 1024, *alpha_b = sc + 1152, *eint_f = sc + 1280, *eint_b = sc + 1408, *emm_f = sc + 1536, *emm_b = sc + 1664, *nq_f = sc + 1792, *nq_b = sc + 1920,
          *cfa = sc + 2048, *cba = sc + 2176, *npf = sc + 2304, *npb = sc + 2368;
    const bf16_t* SO = (const bf16_t*)(p.ws + WS_SO);
    unsigned char* mix = (unsigned char*)(p.ws + WS_MIX);
    {
        const int pr = tid >> 2, kc = (tid & 3) * 16, vc = (tid & 3) * 32;
        *(u32x4*)(Qs + pr * 144 + kc * 2) = R.q[0]; *(u32x4*)(Qs + pr * 144 + kc * 2 + 16) = R.q[1];
        *(u32x4*)(Ks + pr * 144 + kc * 2) = R.k[0]; *(u32x4*)(Ks + pr * 144 + kc * 2 + 16) = R.k[1];
        *(u32x4*)(Cf + pr * 144 + kc * 2) = R.cf[0]; *(u32x4*)(Cf + pr * 144 + kc * 2 + 16) = R.cf[1];
        *(u32x4*)(Cb + pr * 144 + kc * 2) = R.cb[0]; *(u32x4*)(Cb + pr * 144 + kc * 2 + 16) = R.cb[1];
#pragma unroll
        for (int q = 0; q < 4; ++q) {
            const unsigned w[4] = {R.v[q].x, R.v[q].y, R.v[q].z, R.v[q].w};
#pragma unroll
            for (int i = 0; i < 4; ++i) { *(bf16_t*)(VT + (vc + 8 * q + 2 * i) * 272 + pr * 2) = (bf16_t)(w[i] & 0xffff); *(bf16_t*)(VT + (vc + 8 * q + 2 * i + 1) * 272 + pr * 2) = (bf16_t)(w[i] >> 16); }
        }
        if (tid < 128) { li_f[tid] = R.g[0]; lf_f[tid] = logsigmoidf_(R.g[1]); li_b[tid] = R.g[2]; lf_b[tid] = logsigmoidf_(R.g[3]); }
        else if (tid < 192) npf[tid - 128] = R.np;
        else if (tid < 256) npb[tid - 192] = R.np;
    }
    const float mpf = R.mpf, mpb = R.mpb;
    __syncthreads();
    if (wid == 0) {
        const float x0 = lf_f[2 * lane], x1 = lf_f[2 * lane + 1];
        const float sc_ = wscan_up_add(x0 + x1, lane);
        const float b0 = sc_ - x1, b1 = sc_;
        const float be0 = li_f[2 * lane] - b0, be1 = li_f[2 * lane + 1] - b1;
        const float msc = wscan_up_max(fmaxf(be0, be1), lane);
        float ex = __shfl_up(msc, 1); if (lane == 0) ex = -INFINITY;
        const float pm0 = fmaxf(ex, be0), pm1 = msc;
        const float a0 = b0 + mpf, a1 = b1 + mpf, m0 = fmaxf(a0, b0 + pm0), m1 = fmaxf(a1, b1 + pm1);
        *(f32x2_t*)(beta_f + 2 * lane) = (f32x2_t){be0, be1};
        *(f32x2_t*)(alpha_f + 2 * lane) = (f32x2_t){b0 - m0, b1 - m1};
        *(f32x2_t*)(eint_f + 2 * lane) = (f32x2_t){__expf(a0 - m0), __expf(a1 - m1)};
        *(f32x2_t*)(emm_f + 2 * lane) = (f32x2_t){__expf(-m0), __expf(-m1)};
    } else if (wid == 1) {
        const float x0 = lf_b[2 * lane], x1 = lf_b[2 * lane + 1];
        const float sc_ = wscan_down_add(x0 + x1, lane);
        const float b0 = sc_, b1 = sc_ - x0;
        const float be0 = li_b[2 * lane] - b0, be1 = li_b[2 * lane + 1] - b1;
        const float msc = wscan_down_max(fmaxf(be0, be1), lane);
        float ex = __shfl_down(msc, 1); if (lane == 63) ex = -INFINITY;
        const float pm1 = fmaxf(ex, be1), pm0 = msc;
        const float a0 = b0 + mpb, a1 = b1 + mpb, m0 = fmaxf(a0, b0 + pm0), m1 = fmaxf(a1, b1 + pm1);
        *(f32x2_t*)(beta_b + 2 * lane) = (f32x2_t){be0, be1};
        *(f32x2_t*)(alpha_b + 2 * lane) = (f32x2_t){b0 - m0, b1 - m1};
        *(f32x2_t*)(eint_b + 2 * lane) = (f32x2_t){__expf(a0 - m0), __expf(a1 - m1)};
        *(f32x2_t*)(emm_b + 2 * lane) = (f32x2_t){__expf(-m0), __expf(-m1)};
    } else if (wid < 4) {
        const int t = tid - 128; float a = 0.f, bsum = 0.f;
#pragma unroll
        for (int k8 = 0; k8 < 8; ++k8) {
            const u32x4 qv = *(const u32x4*)(Qs + t * 144 + k8 * 16);
            const float q[8] = {__uint_as_float(qv.x << 16), __uint_as_float(qv.x & 0xffff0000u), __uint_as_float(qv.y << 16), __uint_as_float(qv.y & 0xffff0000u),
                                __uint_as_float(qv.z << 16), __uint_as_float(qv.z & 0xffff0000u), __uint_as_float(qv.w << 16), __uint_as_float(qv.w & 0xffff0000u)};
#pragma unroll
            for (int c = 0; c < 8; ++c) { a += npf[8 * k8 + c] * q[c]; bsum += npb[8 * k8 + c] * q[c]; }
        }
        nq_f[t] = a; nq_b[t] = bsum;
    }
    __syncthreads();
    {
        f32x4 acc[8];
#pragma unroll
        for (int n = 0; n < 8; ++n) acc[n] = (f32x4){0.f, 0.f, 0.f, 0.f};
#pragma unroll
        for (int ks = 0; ks < 2; ++ks) {
            const bf16x8 a = *(const bf16x8*)(Qs + (16 * wid + fr) * 144 + (32 * ks + 8 * fq) * 2);
#pragma unroll
            for (int n = 0; n < 8; ++n) { const bf16x8 bb = *(const bf16x8*)(Ks + (16 * n + fr) * 144 + (32 * ks + 8 * fq) * 2); acc[n] = __builtin_amdgcn_mfma_f32_16x16x32_bf16(bb, a, acc[n], 0, 0, 0); }
        }
        const int t = 16 * wid + fr;
        const float af = alpha_f[t], ab = alpha_b[t];
        float rsf = 0.f, rsb = 0.f;
        f32x4 sf[8], sb[8];
#pragma unroll
        for (int n = 0; n < 8; ++n) {
            const f32x4 bf4 = *(const f32x4*)(beta_f + 16 * n + 4 * fq), bb4 = *(const f32x4*)(beta_b + 16 * n + 4 * fq);
#pragma unroll
            for (int j = 0; j < 4; ++j) {
                const int s = 16 * n + 4 * fq + j; const float qk = acc[n][j];
                const float vf = s <= t ? qk * __expf(af + bf4[j]) : 0.f;
                const float vb = s >= t ? qk * __expf(ab + bb4[j]) : 0.f;
                sf[n][j] = vf; sb[n][j] = vb; rsf += vf; rsb += vb;
            }
        }
        rsf += __shfl_xor(rsf, 16); rsf += __shfl_xor(rsf, 32); rsb += __shfl_xor(rsb, 16); rsb += __shfl_xor(rsb, 32);
        const float denf = rsf + eint_f[t] * nq_f[t], denb = rsb + eint_b[t] * nq_b[t];
        const float rf = 1.0f / fmaxf(fabsf(denf), emm_f[t]), rb = 1.0f / fmaxf(fabsf(denb), emm_b[t]);
        if (fq == 0) { cfa[t] = eint_f[t] * rf; cba[t] = eint_b[t] * rb; }
#pragma unroll
        for (int n = 0; n < 8; ++n) {
            const f32x4 pv = rf * sf[n] + rb * sb[n];
            u32x2 o; o.x = g8::cvt_pk_bf16(pv[0], pv[1]); o.y = g8::cvt_pk_bf16(pv[2], pv[3]);
            *(u32x2*)(Ps + t * 272 + (16 * n + 4 * fq) * 2) = o;
        }
    }
    __syncthreads();
    {
        f32x4 aP[8], aT[8];
        const int t = 16 * wid + fr;
        const float cf = cfa[t], cb = cba[t];
        u32x2 sov[8];
#pragma unroll
        for (int n = 0; n < 8; ++n) sov[n] = *(const u32x2*)(SO + ((size_t)row0 + t) * 512 + h * 128 + 16 * n + 4 * fq);
#pragma unroll
        for (int n = 0; n < 8; ++n) aT[n] = (f32x4){0.f, 0.f, 0.f, 0.f};
#pragma unroll
        for (int ks = 0; ks < 2; ++ks) {
            const bf16x8 a = *(const bf16x8*)(Qs + (16 * wid + fr) * 144 + (32 * ks + 8 * fq) * 2);
#pragma unroll
            for (int n = 0; n < 8; ++n) { const bf16x8 b1 = *(const bf16x8*)(Cf + (16 * n + fr) * 144 + (32 * ks + 8 * fq) * 2); aT[n] = __builtin_amdgcn_mfma_f32_16x16x32_bf16(b1, a, aT[n], 0, 0, 0); }
        }
#pragma unroll
        for (int n = 0; n < 8; ++n) { aP[n] = cf * aT[n]; aT[n] = (f32x4){0.f, 0.f, 0.f, 0.f}; }
#pragma unroll
        for (int ks = 0; ks < 2; ++ks) {
            const bf16x8 a = *(const bf16x8*)(Qs + (16 * wid + fr) * 144 + (32 * ks + 8 * fq) * 2);
#pragma unroll
            for (int n = 0; n < 8; ++n) { const bf16x8 b2 = *(const bf16x8*)(Cb + (16 * n + fr) * 144 + (32 * ks + 8 * fq) * 2); aT[n] = __builtin_amdgcn_mfma_f32_16x16x32_bf16(b2, a, aT[n], 0, 0, 0); }
        }
#pragma unroll
        for (int n = 0; n < 8; ++n) aP[n] = aP[n] + cb * aT[n];
#pragma unroll 1
        for (int ks = 0; ks < 4; ++ks) {
            const bf16x8 a = *(const bf16x8*)(Ps + (16 * wid + fr) * 272 + (32 * ks + 8 * fq) * 2);
#pragma unroll
            for (int n = 0; n < 8; ++n) { const bf16x8 bb = *(const bf16x8*)(VT + (16 * n + fr) * 272 + (32 * ks + 8 * fq) * 2); aP[n] = __builtin_amdgcn_mfma_f32_16x16x32_bf16(bb, a, aP[n], 0, 0, 0); }
        }
        float ss = 0.f;
#pragma unroll
        for (int n = 0; n < 8; ++n) ss += aP[n][0] * aP[n][0] + aP[n][1] * aP[n][1] + aP[n][2] * aP[n][2] + aP[n][3] * aP[n][3];
        ss += __shfl_xor(ss, 16); ss += __shfl_xor(ss, 32);
        const float inv = rsqrtf(ss * (1.0f / 128.0f) + EPS);
        const size_t row = (size_t)row0 + t;
#pragma unroll
        for (int n = 0; n < 8; ++n) {
            const int v = 16 * n + 4 * fq;
            const f32x4 g = *(const f32x4*)((const float*)(smem + 153600) + h * 128 + v);
            const u32x2 so = sov[n];
            const float s0 = __uint_as_float(so.x << 16), s1 = __uint_as_float(so.x & 0xffff0000u), s2 = __uint_as_float(so.y << 16), s3 = __uint_as_float(so.y & 0xffff0000u);
            *(unsigned*)(mix + row * 1024 + h * 128 + v) = pk4_fp8((f32x4){aP[n][0] * inv * g[0] * s0, aP[n][1] * inv * g[1] * s1, aP[n][2] * inv * g[2] * s2, aP[n][3] * inv * g[3] * s3} * MIX_SCALE);
        }
    }
}

__device__ __forceinline__ void conv_load(const P& p, int it, u32x4 (&U8)[8]) {
    const bf16_t* U = (const bf16_t*)(p.ws + WS_U) + (size_t)it * 64 * 512;
    const int tid = tidx();
#pragma unroll
    for (int i = 0; i < 8; ++i) U8[i] = *(const u32x4*)(U + (size_t)(tid + 512 * i) * 8);
}
__device__ __forceinline__ void conv_stage(char* smem, const u32x4 (&U8)[8]) {
    const int tid = tidx();
    char* ul = smem + 1024 + 15 * 1024;
#pragma unroll
    for (int i = 0; i < 8; ++i) *(u32x4*)(ul + (size_t)(tid + 512 * i) * 16) = U8[i];
}
__device__ __forceinline__ void conv_item(const P& p, int it, char* smem, const f32x2_t (&w2)[16], const float cb, const float lg, const float lb) {
    const int tid = tidx(), lane = tid & 63;
    const int row0 = it * 64;
    unsigned char* mix = (unsigned char*)(p.ws + WS_MIX);
    float* stat = (float*)smem;
    const bf16_t* up = (const bf16_t*)(smem + 1024);
    bf16_t* yl = (bf16_t*)(smem + 1024 + 94 * 1024);
    const int ch = tid;
#pragma unroll
    for (int i = 0; i < 15; ++i) { ((bf16_t*)(smem + 1024))[i * 512 + ch] = 0; ((bf16_t*)(smem + 1024 + 79 * 1024))[i * 512 + ch] = 0; }
    __syncthreads();
#pragma unroll 1
    for (int g = 0; g < 4; ++g) {
        f32x2_t ua[23], ub[23];
#pragma unroll
        for (int k = 0; k < 23; ++k) {
            const float e0 = bf2f(up[(16 * g + 2 * k) * 512 + ch]), e1 = bf2f(up[(16 * g + 2 * k + 1) * 512 + ch]);
            ua[k][0] = e0; ua[k][1] = e1; ub[k][0] = e1; if (k > 0) ub[k - 1][1] = e0;
        }
        ub[22][1] = 0.f;
#pragma unroll
        for (int e = 0; e < 8; ++e) {
            f32x2_t a0 = (f32x2_t){cb, 0.f}, a1 = a0;
#pragma unroll
            for (int k = 0; k < 16; ++k) { a0 = __builtin_elementwise_fma(w2[k], ua[e + k], a0); a1 = __builtin_elementwise_fma(w2[k], ub[e + k], a1); }
            yl[(16 * g + 2 * e) * 512 + ch] = f2bf(a0[0] + a0[1]);
            yl[(16 * g + 2 * e + 1) * 512 + ch] = f2bf(a1[0] + a1[1]);
        }
    }
    __syncthreads();
    {
        const int pp = tid >> 3, sub = tid & 7;
        float s1 = 0.f, s2 = 0.f;
#pragma unroll
        for (int i = 0; i < 8; ++i) {
            const u32x4 v = *(const u32x4*)(yl + pp * 512 + sub * 64 + 8 * ((i + lane) & 7));
            const unsigned wv[4] = {v.x, v.y, v.z, v.w};
#pragma unroll
            for (int c = 0; c < 4; ++c) { const float lo = __uint_as_float(wv[c] << 16), hi = __uint_as_float(wv[c] & 0xffff0000u); s1 += lo + hi; s2 += lo * lo + hi * hi; }
        }
        s1 += __shfl_xor(s1, 1); s2 += __shfl_xor(s2, 1); s1 += __shfl_xor(s1, 2); s2 += __shfl_xor(s2, 2); s1 += __shfl_xor(s1, 4); s2 += __shfl_xor(s2, 4);
        if (sub == 0) { const float mu = s1 * (1.0f / 512.0f), var = fmaxf(s2 * (1.0f / 512.0f) - mu * mu, 0.f); stat[pp * 2] = mu; stat[pp * 2 + 1] = rsqrtf(var + EPS); }
    }
    __syncthreads();
#pragma unroll 8
    for (int pp = 0; pp < 64; ++pp) {
        const float z = (bf2f(yl[pp * 512 + ch]) - stat[pp * 2]) * stat[pp * 2 + 1] * lg + lb;
        yl[pp * 512 + ch] = f2bf(siluf_(z));
    }
    __syncthreads();
#pragma unroll
    for (int i = 0; i < 4; ++i) {
        const int q = tid + 512 * i, pp = q >> 5, c16 = (q & 31) * 16;
        const u32x4 a = *(const u32x4*)(yl + pp * 512 + c16), b = *(const u32x4*)(yl + pp * 512 + c16 + 8);
        const unsigned w[8] = {a.x, a.y, a.z, a.w, b.x, b.y, b.z, b.w};
        u32x4 o;
        o.x = pk4_fp8((f32x4){__uint_as_float(w[0] << 16), __uint_as_float(w[0] & 0xffff0000u), __uint_as_float(w[1] << 16), __uint_as_float(w[1] & 0xffff0000u)} * MIX_SCALE);
        o.y = pk4_fp8((f32x4){__uint_as_float(w[2] << 16), __uint_as_float(w[2] & 0xffff0000u), __uint_as_float(w[3] << 16), __uint_as_float(w[3] & 0xffff0000u)} * MIX_SCALE);
        o.z = pk4_fp8((f32x4){__uint_as_float(w[4] << 16), __uint_as_float(w[4] & 0xffff0000u), __uint_as_float(w[5] << 16), __uint_as_float(w[5] & 0xffff0000u)} * MIX_SCALE);
        o.w = pk4_fp8((f32x4){__uint_as_float(w[6] << 16), __uint_as_float(w[6] & 0xffff0000u), __uint_as_float(w[7] << 16), __uint_as_float(w[7] & 0xffff0000u)} * MIX_SCALE);
        *(u32x4*)(mix + (size_t)(row0 + pp) * 1024 + 512 + c16) = o;
    }
}

__device__ __forceinline__ void phase5(const P& p, char* smem) {
    {
        MlstmRegs R;
        int it = blockIdx.x;
        if (it < 1024) mlstm_load(p, it, R);
        { float* ng = (float*)(smem + 153600); const int t = tidx(); if (t < NH * 128) ng[t] = p.norm_g[t]; }
        for (; it < 1024; it += gridDim.x) {
            __syncthreads();
            const MlstmRegs C = R;
            const int nx = it + gridDim.x;
            if (nx < 1024) mlstm_load(p, nx, R);
            mlstm_item(p, it, smem, C);
        }
    }
    {
        u32x4 U8[8];
        int it = blockIdx.x;
        const int ch = tidx();
        f32x2_t w2[16];
#pragma unroll
        for (int k = 0; k < 16; ++k) { w2[k][0] = p.conv_w[(2 * k) * 512 + ch]; w2[k][1] = (2 * k + 1 < 31) ? p.conv_w[(2 * k + 1) * 512 + ch] : 0.f; }
        const float cb = p.conv_b[ch], lg = p.ln_g[ch], lb = p.ln_b[ch];
        if (it < 512) conv_load(p, it, U8);
        for (; it < 512; it += gridDim.x) {
            __syncthreads();
            conv_stage(smem, U8);
            const int nx = it + gridDim.x;
            if (nx < 512) conv_load(p, nx, U8);
            conv_item(p, it, smem, w2, cb, lg, lb);
        }
    }
}

__device__ __forceinline__ void phase7(const P& p, char* smem) {
    const int tid = tidx(), wid = tid >> 6, lane = tid & 63, fr = lane & 15, fq = lane >> 4;
    float* H = (float*)smem;
    float* LP = (float*)(smem + 65792);
    float* modl = (float*)(smem + 65792 + 32768);
    int* selE = (int*)(smem + 65792 + 32768 + 12288);
    float* selW = (float*)(smem + 65792 + 32768 + 12288 + 4096);
    int* rank = (int*)(smem + 65792 + 32768 + 12288 + 8192);
    int* ebase = (int*)(smem + 65792 + 32768 + 12288 + 12288);
    int* segcnt = ebase + 64;
    int* lcnt = segcnt;
    float* vls = (float*)(segcnt + 512);
    float* gvec = (float*)(smem + 131072);
    const float* modp = (const float*)(p.ws + WS_MODP);
    const bf16_t* yx = (const bf16_t*)(p.ws + WS_YX);
    unsigned char* hx2 = (unsigned char*)(p.ws + WS_HX);
    int* cursor = (int*)(p.ws + WS_CURSOR);
    int* ltok = (int*)(p.ws + WS_LTOK);
    int* slotE = (int*)(p.ws + WS_SLOTE); int* slotP = (int*)(p.ws + WS_SLOTP); float* slotW = (float*)(p.ws + WS_SLOTW);
    bf16x8 bh[4][4];
#pragma unroll
    for (int ks = 0; ks < 4; ++ks)
#pragma unroll
        for (int n = 0; n < 4; ++n) bh[ks][n] = *(const bf16x8*)(p.ws + WS_WRH + (size_t)((((wid * 4 + ks) * 4 + n) * 64 + lane) * 16));
    const float brt = p.b_router[lane];
    u32x4 nyw[2]; f32x4 nxa[2], nxb[2];
#define P7_LOAD(row_) do { const bf16_t* yr_ = yx + (size_t)(row_) * 1024; const float* xr_ = p.x + (size_t)(row_) * 1024; _Pragma("unroll") for (int jj = 0; jj < 2; ++jj) { \
        const int idx_ = 8 * lane + 512 * jj; nyw[jj] = *(const u32x4*)(yr_ + idx_); nxa[jj] = *(const f32x4*)(xr_ + idx_); nxb[jj] = *(const f32x4*)(xr_ + idx_ + 4); } } while (0)
    if ((int)blockIdx.x < NT / 128) P7_LOAD((size_t)blockIdx.x * 128 + 2 * wid);
    { const float a0 = p.g_post_mix[tid], a1 = p.g_post_mix[tid + NTHREADS], a2 = p.g_pre_ffn[tid], a3 = p.g_pre_ffn[tid + NTHREADS]; gvec[tid] = a0; gvec[tid + NTHREADS] = a1; gvec[1024 + tid] = a2; gvec[1024 + tid + NTHREADS] = a3; }
    for (int blk = blockIdx.x; blk < NT / 128; blk += gridDim.x) {
        const int b = (blk * 128) / T;
        __syncthreads();
        if (tidx() < 64) lcnt[tidx()] = 0;
        {
            const int t0 = tidx(); float t[6];
#pragma unroll
            for (int j = 0; j < 6; ++j) { const int i = t0 + j * NTHREADS, which = i >> 10, idx = i & 1023; t[j] = modval(modp, b, (which == 0 ? 2048 : (which == 1 ? 3072 : 4096)) + idx); }
#pragma unroll
            for (int j = 0; j < 6; ++j) modl[t0 + j * NTHREADS] = t[j];
        }
        __syncthreads();
        for (int g = 0; g < 8; ++g) {
#pragma unroll 1
            for (int i = 0; i < 2; ++i) {
                const int lr = 2 * wid + i; const size_t row = (size_t)blk * 128 + g * 16 + lr;
                bf16_t* x1row = (bf16_t*)(p.ws + WS_X1B) + row * 1024;
                float y[16], xv[16]; float ss = 0.f;
#pragma unroll
                for (int jj = 0; jj < 2; ++jj) {
                    const unsigned w[4] = {nyw[jj].x, nyw[jj].y, nyw[jj].z, nyw[jj].w};
#pragma unroll
                    for (int c = 0; c < 4; ++c) { y[8 * jj + 2 * c] = __uint_as_float(w[c] << 16); y[8 * jj + 2 * c + 1] = __uint_as_float(w[c] & 0xffff0000u); xv[8 * jj + c] = nxa[jj][c]; xv[8 * jj + 4 + c] = nxb[jj][c]; }
                }
                {
                    const bool more = !(g == 7 && i == 1) || (blk + (int)gridDim.x < NT / 128);
                    const size_t nrow = i == 0 ? row + 1 : (g < 7 ? row + 15 : (size_t)(blk + gridDim.x) * 128 + 2 * wid);
                    if (more) P7_LOAD(nrow);
                }
#pragma unroll
                for (int c = 0; c < 16; ++c) ss += y[c] * y[c];
                ss = wave_sum(ss);
                const float invy = rsqrtf(ss * (1.0f / 1024.0f) + EPS);
                float s1 = 0.f;
#pragma unroll
                for (int q = 0; q < 4; ++q) {
                    const int idx = 8 * lane + 512 * (q >> 1) + 4 * (q & 1);
                    const f32x4 gt = *(const f32x4*)(modl + idx), gp = *(const f32x4*)(gvec + idx);
#pragma unroll
                    for (int c = 0; c < 4; ++c) { const float v = xv[4 * q + c] + gt[c] * (y[4 * q + c] * invy * gp[c]); xv[4 * q + c] = v; s1 += v * v; }
                }
#pragma unroll
                for (int jj = 0; jj < 2; ++jj) {
                    u32x4 o; o.x = pk2(xv[8 * jj], xv[8 * jj + 1]); o.y = pk2(xv[8 * jj + 2], xv[8 * jj + 3]); o.z = pk2(xv[8 * jj + 4], xv[8 * jj + 5]); o.w = pk2(xv[8 * jj + 6], xv[8 * jj + 7]);
                    *(u32x4*)(x1row + 8 * lane + 512 * jj) = o;
                }
                s1 = wave_sum(s1);
                const float inv1 = rsqrtf(s1 * (1.0f / 1024.0f) + EPS);
#pragma unroll
                for (int jj = 0; jj < 2; ++jj) {
                    const int idx = 8 * lane + 512 * jj;
                    float hv[8];
#pragma unroll
                    for (int h4 = 0; h4 < 2; ++h4) {
                        const f32x4 g2 = *(const f32x4*)(gvec + 1024 + idx + 4 * h4), sh = *(const f32x4*)(modl + 1024 + idx + 4 * h4), sc = *(const f32x4*)(modl + 2048 + idx + 4 * h4);
#pragma unroll
                        for (int c = 0; c < 4; ++c) hv[4 * h4 + c] = xv[8 * jj + 4 * h4 + c] * inv1 * g2[c] * (1.0f + sc[c]) + sh[c];
                        *(f32x4*)(H + lr * 1028 + idx + 4 * h4) = (f32x4){hv[4 * h4], hv[4 * h4 + 1], hv[4 * h4 + 2], hv[4 * h4 + 3]};
                    }
                    u32x2 o; o.x = pk4_fp8((f32x4){hv[0], hv[1], hv[2], hv[3]} * HX2_SCALE); o.y = pk4_fp8((f32x4){hv[4], hv[5], hv[6], hv[7]} * HX2_SCALE);
                    *(u32x2*)(hx2 + row * 1024 + idx) = o;
                }
            }
            bf16x8 bl[4][4];
#define P7_BL(ks_) do { _Pragma("unroll") for (int n = 0; n < 4; ++n) bl[ks_][n] = *(const bf16x8*)(p.ws + WS_WRL + (size_t)((((wid * 4 + (ks_)) * 4 + n) * 64 + lane) * 16)); } while (0)
            P7_BL(0); P7_BL(1);
            __syncthreads();
            {
                f32x4 acc[4];
#pragma unroll
                for (int n = 0; n < 4; ++n) acc[n] = (f32x4){0.f, 0.f, 0.f, 0.f};
#pragma unroll
                for (int ks = 0; ks < 4; ++ks) {
                    if (ks == 1) { __builtin_amdgcn_sched_barrier(0); P7_BL(2); __builtin_amdgcn_sched_barrier(0); }
                    if (ks == 2) { __builtin_amdgcn_sched_barrier(0); P7_BL(3); __builtin_amdgcn_sched_barrier(0); }
                    const f32x4 h0 = *(const f32x4*)(H + fr * 1028 + 128 * wid + 32 * ks + 8 * fq), h1 = *(const f32x4*)(H + fr * 1028 + 128 * wid + 32 * ks + 8 * fq + 4);
                    const unsigned hh[4] = {pk2(h0[0], h0[1]), pk2(h0[2], h0[3]), pk2(h1[0], h1[1]), pk2(h1[2], h1[3])};
                    const unsigned ll[4] = {pk2(h0[0] - __uint_as_float(hh[0] << 16), h0[1] - __uint_as_float(hh[0] & 0xffff0000u)), pk2(h0[2] - __uint_as_float(hh[1] << 16), h0[3] - __uint_as_float(hh[1] & 0xffff0000u)),
                                            pk2(h1[0] - __uint_as_float(hh[2] << 16), h1[1] - __uint_as_float(hh[2] & 0xffff0000u)), pk2(h1[2] - __uint_as_float(hh[3] << 16), h1[3] - __uint_as_float(hh[3] & 0xffff0000u))};
                    u32x4 ahw = (u32x4){hh[0], hh[1], hh[2], hh[3]}, alw = (u32x4){ll[0], ll[1], ll[2], ll[3]};
                    asm volatile("s_nop 1" : "+v"(ahw), "+v"(alw));
                    const bf16x8 ah = __builtin_bit_cast(bf16x8, ahw), al = __builtin_bit_cast(bf16x8, alw);
#pragma unroll
                    for (int n = 0; n < 4; ++n) {
                        acc[n] = __builtin_amdgcn_mfma_f32_16x16x32_bf16(al, bh[ks][n], acc[n], 0, 0, 0);
                        acc[n] = __builtin_amdgcn_mfma_f32_16x16x32_bf16(ah, bl[ks][n], acc[n], 0, 0, 0);
                        acc[n] = __builtin_amdgcn_mfma_f32_16x16x32_bf16(ah, bh[ks][n], acc[n], 0, 0, 0);
                    }
                }
#pragma unroll
                for (int n = 0; n < 4; ++n)
#pragma unroll
                    for (int j = 0; j < 4; ++j) LP[(wid * 16 + 4 * fq + j) * 64 + 16 * n + fr] = acc[n][j];
            }
            __syncthreads();
            {
                float sg[2]; int kbv[2];
#pragma unroll
                for (int i = 0; i < 2; ++i) {
                    const int lr = 2 * wid + i;
                    float lg = 0.f;
#pragma unroll
                    for (int w8 = 0; w8 < 8; ++w8) lg += LP[(w8 * 16 + lr) * 64 + lane];
                    sg[i] = sigmoidf_(lg);
                    const float val = sg[i] + brt;
                    int kb = __float_as_int(val); kb ^= (kb >> 31) & 0x7fffffff; kb = (kb & ~63) | (63 - lane);
                    kbv[i] = kb;
                    ((int*)vls)[(wid * 2 + i) * 64 + lane] = kb;
                }
                asm volatile("s_waitcnt lgkmcnt(0)" ::: "memory");
#pragma unroll
                for (int i = 0; i < 2; ++i) {
                    const int* kl = (const int*)vls + (wid * 2 + i) * 64;
                    const int kb = kbv[i];
                    int rk = 0;
#pragma unroll
                    for (int j4 = 0; j4 < 16; ++j4) {
                        const u32x4 o = *(const u32x4*)(kl + 4 * j4);
                        rk += ((int)o.x > kb ? 1 : 0) + ((int)o.y > kb ? 1 : 0) + ((int)o.z > kb ? 1 : 0) + ((int)o.w > kb ? 1 : 0);
                    }
                    const bool sel = rk < TOPK;
                    const float ssum = wave_sum(sel ? sg[i] : 0.f);
                    const int rr = g * 16 + 2 * wid + i;
                    if (sel) { selE[rr * 8 + rk] = lane; selW[rr * 8 + rk] = sg[i] / ssum * 2.5f; rank[rr * 8 + rk] = atomicAdd(&lcnt[lane], 1); }
                }
            }
        }
        __syncthreads();
        {
            const int t2 = tidx();
            if (t2 < 64) { const int run = lcnt[t2]; ebase[t2] = run > 0 ? atomicAdd(&cursor[t2], run) : 0; }
        }
        __syncthreads();
        for (int i = tidx(); i < 1024; i += NTHREADS) {
            const int e = selE[i], pos = ebase[e] + rank[i];
            const int tokn = blk * 128 + (i >> 3);
            ltok[(size_t)e * LCAP + pos] = tokn;
            slotE[(size_t)tokn * 8 + (i & 7)] = e; slotP[(size_t)tokn * 8 + (i & 7)] = pos; slotW[(size_t)tokn * 8 + (i & 7)] = selW[i];
        }
    }
#undef P7_LOAD
#undef P7_BL
}

__device__ __forceinline__ float sigm(float x) { return __builtin_amdgcn_rcpf(1.0f + __expf(-x)); }

struct SchedDense {
    const char* A; const char* B; int nM, nN, KB;
    __device__ __forceinline__ bool next(int i, g8::Unit& u) const {
        int pm, pn; if (!g8::static_unit(i, nM, nN, pm, pn)) return false;
        u.A = A + (size_t)pm * 256 * KB; u.B = B + (size_t)pn * 256 * KB; u.x0 = pm; u.x1 = pn; u.x2 = 0; u.x3 = 0; return true;
    }
    __device__ __forceinline__ void aoffs(const g8::Unit&, const int (&)[2], const unsigned (&)[2], unsigned (&)[2][2]) const {}
};

struct EpiInProj {
    static constexpr int NST = 0;
    bf16_t *Q, *Kb, *V, *SO, *U; const float* b_in;
    __device__ __forceinline__ void operator()(const f32x4 (&acc)[2][2][4][2], const g8::Unit& u, int wr, int wc, int fr, int fq) const {
        const int pn = u.x1; const size_t row0 = (size_t)u.x0 * 256 + wr * 64 + fr;
        if (pn < 6) {
            bf16_t* base; int ld, cofs;
            if (pn == 0) { base = Q; ld = 256; cofs = 0; } else if (pn == 1) { base = Kb; ld = 256; cofs = 0; }
            else if (pn < 4) { base = V; ld = 512; cofs = (pn - 2) * 256; } else { base = SO; ld = 512; cofs = (pn - 4) * 256; }
#pragma unroll
            for (int bj = 0; bj < 2; ++bj) {
                const int c8 = bj * 128 + wc * 32 + 8 * fq;
                const f32x4 b0 = *(const f32x4*)(b_in + pn * 256 + c8), b1 = *(const f32x4*)(b_in + pn * 256 + c8 + 4);
#pragma unroll
                for (int ai = 0; ai < 2; ++ai)
#pragma unroll
                    for (int m = 0; m < 4; ++m) {
                        const size_t row = row0 + ai * 128 + m * 16;
                        f32x4 v0 = acc[ai][bj][m][0] + b0, v1 = acc[ai][bj][m][1] + b1;
                        if (pn == 1) { v0 = v0 * 0.125f; v1 = v1 * 0.125f; }
                        if (pn >= 4) {
#pragma unroll
                            for (int c = 0; c < 4; ++c) { v0[c] = sigm(v0[c]); v1[c] = sigm(v1[c]); }
                        }
                        u32x4 w; w.x = g8::cvt_pk_bf16(v0[0], v0[1]); w.y = g8::cvt_pk_bf16(v0[2], v0[3]); w.z = g8::cvt_pk_bf16(v1[0], v1[1]); w.w = g8::cvt_pk_bf16(v1[2], v1[3]);
                        *(u32x4*)(base + row * ld + cofs + c8) = w;
                    }
            }
        } else {
            const int ucol = (pn - 6) * 128 + wc * 32 + 8 * fq;
            const f32x4 a0 = *(const f32x4*)(b_in + 1552 + ucol), a1 = *(const f32x4*)(b_in + 1552 + ucol + 4);
            const f32x4 g0 = *(const f32x4*)(b_in + 2064 + ucol), g1 = *(const f32x4*)(b_in + 2064 + ucol + 4);
#pragma unroll
            for (int ai = 0; ai < 2; ++ai)
#pragma unroll
                for (int m = 0; m < 4; ++m) {
                    const size_t row = row0 + ai * 128 + m * 16;
                    const f32x4 ga0 = acc[ai][0][m][0] + a0, ga1 = acc[ai][0][m][1] + a1, gb0 = acc[ai][1][m][0] + g0, gb1 = acc[ai][1][m][1] + g1;
                    u32x4 w; w.x = g8::cvt_pk_bf16(ga0[0] * sigm(gb0[0]), ga0[1] * sigm(gb0[1])); w.y = g8::cvt_pk_bf16(ga0[2] * sigm(gb0[2]), ga0[3] * sigm(gb0[3]));
                    w.z = g8::cvt_pk_bf16(ga1[0] * sigm(gb1[0]), ga1[1] * sigm(gb1[1])); w.w = g8::cvt_pk_bf16(ga1[2] * sigm(gb1[2]), ga1[3] * sigm(gb1[3]));
                    *(u32x4*)(U + row * 512 + ucol) = w;
                }
        }
    }
};

__device__ __forceinline__ void ctx_kv_proj(const P& p, char* smem) {
    const int tid = tidx(), wid = tid >> 6, lane = tid & 63, fr = lane & 15, fq = lane >> 4, rf = wid & 3, kh = wid >> 2;
    const bf16_t* hx = (const bf16_t*)(p.ws + WS_HX) + (size_t)NT * 1024;
    const bf16_t* wt = (const bf16_t*)(p.ws + WS_WT_IN) + (size_t)256 * 1024;
    bf16_t* Kb = (bf16_t*)(p.ws + WS_K); bf16_t* V = (bf16_t*)(p.ws + WS_V);
    f32x4* red = (f32x4*)smem;
    for (int blk = blockIdx.x; blk < 256; blk += gridDim.x) {
        const int rb = blk >> 4, cb = blk & 15;
        const bf16_t* ap = hx + (size_t)(rb * 64 + rf * 16 + fr) * 1024 + kh * 512 + fq * 8;
        const bf16_t* bp = wt + (size_t)(cb * 48 + fr) * 1024 + kh * 512 + fq * 8;
        f32x4 acc[3];
#pragma unroll
        for (int n = 0; n < 3; ++n) acc[n] = (f32x4){0.f, 0.f, 0.f, 0.f};
#pragma unroll 8
        for (int ks = 0; ks < 16; ++ks) {
            const bf16x8 a = *(const bf16x8*)(ap + ks * 32);
#pragma unroll
            for (int n = 0; n < 3; ++n) { const bf16x8 b = *(const bf16x8*)(bp + (size_t)n * 16 * 1024 + ks * 32); acc[n] = __builtin_amdgcn_mfma_f32_16x16x32_bf16(b, a, acc[n], 0, 0, 0); }
        }
        __syncthreads();
        if (kh == 1) {
#pragma unroll
            for (int n = 0; n < 3; ++n) red[(rf * 3 + n) * 64 + lane] = acc[n];
        }
        __syncthreads();
        if (kh == 0) {
            const size_t row = (size_t)NT + rb * 64 + rf * 16 + fr;
#pragma unroll
            for (int n = 0; n < 3; ++n) {
                const int col = 256 + cb * 48 + n * 16 + 4 * fq;
                f32x4 v = acc[n] + red[(rf * 3 + n) * 64 + lane] + *(const f32x4*)(p.b_in + col);
                bf16_t* dst;
                if (col < 512) { v = v * 0.125f; dst = Kb + row * 256 + (col - 256); } else dst = V + row * 512 + (col - 512);
                u32x2 o; o.x = g8::cvt_pk_bf16(v[0], v[1]); o.y = g8::cvt_pk_bf16(v[2], v[3]);
                *(u32x2*)dst = o;
            }
        }
    }
}

struct MoeTab { int cnt[128]; int pt[129]; int cb[129]; };
__device__ __forceinline__ int vblock() { const int G = gridDim.x; return (G & 7) ? (int)blockIdx.x : (int)(blockIdx.x & 7) * (G >> 3) + (int)(blockIdx.x >> 3); }
struct MoeUnit { unsigned long long B; int arow, cnt, orow, pn, lbase, pad; };
constexpr int MAXU = 24;
constexpr int LDS_TAB = 131072;
constexpr int LDS_UTAB = LDS_TAB + 2048;
constexpr int LDS_TOK = LDS_UTAB + MAXU * 32;
static_assert(LDS_TOK + MAXU * 1024 <= 160 * 1024, "LDS tables overflow");

__device__ __forceinline__ void moe_prefix(const P& p, char* smem) {
    MoeTab* mt = (MoeTab*)(smem + LDS_TAB);
    const int* cursor = (const int*)(p.ws + WS_CURSOR);
    const int tid = tidx();
    __syncthreads();
    if (tid < 64) {
        const int c = cursor[tid], t = (c + 255) >> 8;
        int st = t, sc = c;
#pragma unroll
        for (int d = 1; d < 64; d <<= 1) { const int a1 = __shfl_up(st, d), a2 = __shfl_up(sc, d); if (tid >= d) { st += a1; sc += a2; } }
        mt->cnt[tid] = c; mt->pt[tid] = st - t; mt->cb[tid] = sc - c;
        const int tt = __shfl(st, 63), tc = __shfl(sc, 63);
        mt->cnt[64 + tid] = 0; mt->pt[64 + tid] = tt; mt->cb[64 + tid] = tc;
        if (tid == 0) { mt->pt[128] = tt; mt->cb[128] = tc; }
    }
    __syncthreads();
}

struct SchedMoe {
    const char* A; const MoeUnit* ut; const int* tok; int nloc, KB; bool gather;
    __device__ __forceinline__ bool next(int i, g8::Unit& u) const {
        if (i >= nloc) return false;
        const MoeUnit* q = ut + i;
        const unsigned blo = __builtin_amdgcn_readfirstlane((unsigned)(q->B & 0xffffffffull)), bhi = __builtin_amdgcn_readfirstlane((unsigned)(q->B >> 32));
        u.B = (const char*)(((unsigned long long)bhi << 32) | blo);
        u.x0 = __builtin_amdgcn_readfirstlane(q->cnt); u.x1 = __builtin_amdgcn_readfirstlane(q->pn); u.x2 = __builtin_amdgcn_readfirstlane(q->orow);
        u.x3 = i; u.A = gather ? A : A + (size_t)__builtin_amdgcn_readfirstlane(q->arow) * KB; return true;
    }
    __device__ __forceinline__ void aoffs(const g8::Unit& u, const int (&R)[2], const unsigned (&c2)[2], unsigned (&va)[2][2]) const {
#pragma unroll
        for (int h = 0; h < 2; ++h)
#pragma unroll
            for (int j = 0; j < 2; ++j) va[h][j] = (unsigned)(tok[u.x3 * 256 + h * 128 + R[j]] * KB) + c2[j];
    }
};

__device__ __forceinline__ void phase2(const P& p, char* smem) {
    ctx_kv_proj(p, smem);
    EpiInProj E; E.Q = (bf16_t*)(p.ws + WS_Q); E.Kb = (bf16_t*)(p.ws + WS_K); E.V = (bf16_t*)(p.ws + WS_V); E.SO = (bf16_t*)(p.ws + WS_SO); E.U = (bf16_t*)(p.ws + WS_U); E.b_in = p.b_in;
    {
        SchedDense S; S.A = (const char*)(p.ws + WS_HX); S.B = (const char*)(p.ws + WS_WT_IN); S.nM = NT / 256; S.nN = 4; S.KB = 2048;
        __syncthreads();
        g8::gemm<true, false, false, 127>((LAS unsigned char*)smem, 2048, S, E);
    }
    MoeUnit* ut = (MoeUnit*)(smem + LDS_UTAB); int* tok = (int*)(smem + LDS_TOK);
    const int nunits = (NT / 256) * 6;
    const int vb = vblock(), ntot = nunits > vb ? (nunits - vb + (int)gridDim.x - 1) / (int)gridDim.x : 0;
    for (int base = 0; base < ntot; base += MAXU) {
        const int nloc = (ntot - base) < MAXU ? (ntot - base) : MAXU;
        __syncthreads();
        if ((int)tidx() < nloc) {
            const int u = vb + (base + tidx()) * gridDim.x, pm = u / 6, pq = u % 6;
            MoeUnit q; q.pn = 4 + pq; q.pad = 0; q.lbase = 0; q.cnt = pm; q.arow = pm * 256; q.orow = q.arow;
            q.B = (unsigned long long)(p.ws + WS_WT_IN8 + (size_t)pq * 256 * 1024);
            ut[tidx()] = q;
        }
        __syncthreads();
        for (int idx = tidx(); idx < nloc * 256; idx += NTHREADS) tok[idx] = ut[idx >> 8].arow + (idx & 255);
        __syncthreads();
        SchedMoe S; S.A = (const char*)(p.ws + WS_HX8); S.ut = ut; S.tok = tok; S.nloc = nloc; S.KB = 1024; S.gather = true;
        g8::gemm<true, true, true, 127 - 8>((LAS unsigned char*)smem, 1024, S, E);
        __syncthreads();
    }
}

struct EpiOutProj {
    static constexpr int NST = 0;
    bf16_t* yx; const float* b_out;
    __device__ __forceinline__ void operator()(const f32x4 (&acc)[2][2][4][2], const g8::Unit& u, int wr, int wc, int fr, int fq) const {
        const size_t row0 = (size_t)u.x2 + wr * 64 + fr;
#pragma unroll
        for (int bj = 0; bj < 2; ++bj) {
            const int col = u.x1 * 256 + bj * 128 + wc * 32 + 8 * fq;
            const f32x4 b0 = *(const f32x4*)(b_out + col), b1 = *(const f32x4*)(b_out + col + 4);
#pragma unroll
            for (int ai = 0; ai < 2; ++ai)
#pragma unroll
                for (int m = 0; m < 4; ++m) {
                    const f32x4 v0 = acc[ai][bj][m][0] + b0, v1 = acc[ai][bj][m][1] + b1;
                    u32x4 w; w.x = g8::cvt_pk_bf16(v0[0], v0[1]); w.y = g8::cvt_pk_bf16(v0[2], v0[3]); w.z = g8::cvt_pk_bf16(v1[0], v1[1]); w.w = g8::cvt_pk_bf16(v1[2], v1[3]);
                    *(u32x4*)(yx + (row0 + ai * 128 + m * 16) * 1024 + col) = w;
                }
        }
    }
};

__device__ __forceinline__ void phase6(const P& p, char* smem) {
    MoeUnit* ut = (MoeUnit*)(smem + LDS_UTAB); int* tok = (int*)(smem + LDS_TOK);
    const int nunits = (NT / 256) * 4;
    const int vb = vblock(), ntot = nunits > vb ? (nunits - vb + (int)gridDim.x - 1) / (int)gridDim.x : 0;
    for (int base = 0; base < ntot; base += MAXU) {
        const int nloc = (ntot - base) < MAXU ? (ntot - base) : MAXU;
        __syncthreads();
        if ((int)tidx() < nloc) {
            const int u = vb + (base + tidx()) * gridDim.x;
            MoeUnit q; q.pn = u & 3; q.pad = 0; q.lbase = 0; q.cnt = 256; q.arow = (u >> 2) * 256; q.orow = q.arow;
            q.B = (unsigned long long)(p.ws + WS_WT_OUT + (size_t)q.pn * 256 * 1024);
            ut[tidx()] = q;
        }
        __syncthreads();
        for (int idx = tidx(); idx < nloc * 256; idx += NTHREADS) tok[idx] = ut[idx >> 8].arow + (idx & 255);
        __syncthreads();
        SchedMoe S; S.A = (const char*)(p.ws + WS_MIX); S.ut = ut; S.tok = tok; S.nloc = nloc; S.KB = 1024; S.gather = true;
        EpiOutProj E; E.yx = (bf16_t*)(p.ws + WS_YX); E.b_out = p.b_out;
        g8::gemm<true, true, true, 127 - 10>((LAS unsigned char*)smem, 1024, S, E);
        __syncthreads();
    }
}

struct EpiGateUp {
    static constexpr int NST = 8;
    unsigned char* act;
    __device__ __forceinline__ void operator()(const f32x4 (&acc)[2][2][4][2], const g8::Unit& u, int wr, int wc, int fr, int fq) const {
        unsigned char* base = act + (size_t)u.x2 * 256 + u.x1 * 128 + wc * 32 + 8 * fq;
#pragma unroll
        for (int ai = 0; ai < 2; ++ai)
#pragma unroll
            for (int m = 0; m < 4; ++m) {
                const int r = ai * 128 + wr * 64 + m * 16 + fr;
                const f32x4 g0 = acc[ai][0][m][0], g1 = acc[ai][0][m][1], u0 = acc[ai][1][m][0], u1 = acc[ai][1][m][1];
                f32x4 a0, a1;
#pragma unroll
                for (int c = 0; c < 4; ++c) { a0[c] = g0[c] * sigm(g0[c]) * u0[c]; a1[c] = g1[c] * sigm(g1[c]) * u1[c]; }
                u32x2 w; w.x = pk4_fp8(a0); w.y = pk4_fp8(a1);
                *(u32x2*)(base + r * 256) = w;
            }
    }
};

struct EpiDown {
    static constexpr int NST = 8;
    unsigned char* ye;
    __device__ __forceinline__ void operator()(const f32x4 (&acc)[2][2][4][2], const g8::Unit& u, int wr, int wc, int fr, int fq) const {
#pragma unroll
        for (int ai = 0; ai < 2; ++ai)
#pragma unroll
            for (int m = 0; m < 4; ++m) {
                const int r = ai * 128 + wr * 64 + m * 16 + fr;
                if (r < u.x0) {
                    u32x4 w; w.x = pk4_fp8(acc[ai][0][m][0]); w.y = pk4_fp8(acc[ai][0][m][1]); w.z = pk4_fp8(acc[ai][1][m][0]); w.w = pk4_fp8(acc[ai][1][m][1]);
                    *(u32x4*)(ye + (size_t)(u.x2 + r) * 1024 + ((u.x1 * 4 + wc) * 4 + fq) * 16) = w;
                }
            }
    }
};

__device__ __forceinline__ void phase9a(const P& p, char* smem) {
    moe_prefix(p, smem);
    const MoeTab* mt = (const MoeTab*)(smem + LDS_TAB);
    MoeUnit* ut = (MoeUnit*)(smem + LDS_UTAB); int* tok = (int*)(smem + LDS_TOK);
    const int* ltok = (const int*)(p.ws + WS_LTOK);
    const int TT = mt->pt[128], nunits = (TT + NT / 256) * 2;
    const int vb = vblock(), ntot = nunits > vb ? (nunits - vb + (int)gridDim.x - 1) / (int)gridDim.x : 0;
    for (int base = 0; base < ntot; base += MAXU) {
        const int nloc = (ntot - base) < MAXU ? (ntot - base) : MAXU;
        __syncthreads();
        if ((int)tidx() < nloc) {
            const int u = vb + (base + tidx()) * gridDim.x, mtile = u >> 1, pn = u & 1;
            MoeUnit q; q.pn = pn; q.pad = 0; q.arow = 0;
            if (mtile < TT) {
                int l = 0; { int hi = 63; while (l < hi) { const int mid = (l + hi) >> 1; if (mt->pt[mid + 1] > mtile) hi = mid; else l = mid + 1; } }
                const int ti = mtile - mt->pt[l], rem = mt->cnt[l] - ti * 256;
                q.cnt = rem < 256 ? rem : 256; q.orow = mtile * 256; q.lbase = l * LCAP + ti * 256;
                q.B = (unsigned long long)(p.ws + WS_WT_GU + ((size_t)(l & 63) * 512 + (size_t)pn * 256) * 1024);
            } else {
                const int s = mtile - TT;
                q.cnt = 256; q.orow = mtile * 256; q.lbase = -1 - s;
                q.B = (unsigned long long)(p.ws + WS_WT_GU + ((size_t)64 * 512 + (size_t)pn * 256) * 1024);
            }
            ut[tidx()] = q;
        }
        __syncthreads();
        for (int idx = tidx(); idx < nloc * 256; idx += NTHREADS) {
            const int i = idx >> 8, r = idx & 255; const int lb = ut[i].lbase, c = ut[i].cnt;
            tok[idx] = lb >= 0 ? ltok[lb + (r < c ? r : c - 1)] : (-1 - lb) * 256 + r;
        }
        __syncthreads();
        SchedMoe S; S.A = (const char*)(p.ws + WS_HX); S.ut = ut; S.tok = tok; S.nloc = nloc; S.KB = 1024; S.gather = true;
        EpiGateUp E; E.act = (unsigned char*)(p.ws + WS_ACT);
        g8::gemm<true, true, true, 127 - 8>((LAS unsigned char*)smem, 1024, S, E);
        __syncthreads();
    }
}

__device__ __forceinline__ void phase9b(const P& p, char* smem) {
    moe_prefix(p, smem);
    const MoeTab* mt = (const MoeTab*)(smem + LDS_TAB);
    MoeUnit* ut = (MoeUnit*)(smem + LDS_UTAB); int* tok = (int*)(smem + LDS_TOK);
    const int TT = mt->pt[128], nunits = (TT + NT / 256) * 4;
    const int vb = vblock(), ntot = nunits > vb ? (nunits - vb + (int)gridDim.x - 1) / (int)gridDim.x : 0;
    for (int base = 0; base < ntot; base += MAXU) {
        const int nloc = (ntot - base) < MAXU ? (ntot - base) : MAXU;
        __syncthreads();
        if ((int)tidx() < nloc) {
            const int u = vb + (base + tidx()) * gridDim.x, tl = u >> 2, pn = u & 3;
            MoeUnit q; q.pn = pn; q.pad = 0; q.lbase = 0;
            if (tl < TT) {
                int l = 0; { int hi = 63; while (l < hi) { const int mid = (l + hi) >> 1; if (mt->pt[mid + 1] > tl) hi = mid; else l = mid + 1; } }
                const int ti = tl - mt->pt[l], rem = mt->cnt[l] - ti * 256;
                q.cnt = 256; q.arow = tl * 256; q.orow = q.arow; (void)rem;
                q.B = (unsigned long long)(p.ws + WS_WT_D + ((size_t)(l & 63) * 1024 + (size_t)pn * 256) * 256);
            } else {
                const int sidx = tl - TT;
                q.cnt = 256; q.arow = tl * 256; q.orow = q.arow; (void)sidx;
                q.B = (unsigned long long)(p.ws + WS_WT_D + ((size_t)64 * 1024 + (size_t)pn * 256) * 256);
            }
            ut[tidx()] = q;
        }
        __syncthreads();
        for (int idx = tidx(); idx < nloc * 256; idx += NTHREADS) tok[idx] = ut[idx >> 8].arow + (idx & 255);
        __syncthreads();
        SchedMoe S; S.A = (const char*)(p.ws + WS_ACT); S.ut = ut; S.tok = tok; S.nloc = nloc; S.KB = 256; S.gather = true;
        EpiDown E; E.ye = (unsigned char*)(p.ws + WS_YE);
        int kb = 256; asm volatile("" : "+s"(kb));
        S.KB = kb;
        g8::gemm<true, true, true, 127>((LAS unsigned char*)smem, kb, S, E);
        __syncthreads();
    }
}

__device__ __forceinline__ void unpack_fp8x8(const u32x2 v, float (&f)[8]) {
    typedef float f2 __attribute__((ext_vector_type(2)));
    const f2 a = __builtin_amdgcn_cvt_pk_f32_fp8((int)v.x, false), b = __builtin_amdgcn_cvt_pk_f32_fp8((int)v.x, true);
    const f2 c = __builtin_amdgcn_cvt_pk_f32_fp8((int)v.y, false), d = __builtin_amdgcn_cvt_pk_f32_fp8((int)v.y, true);
    f[0] = a[0]; f[1] = a[1]; f[2] = b[0]; f[3] = b[1]; f[4] = c[0]; f[5] = c[1]; f[6] = d[0]; f[7] = d[1];
}
__device__ __forceinline__ void phase10(const P& p, char* smem) {
    moe_prefix(p, smem);
    const MoeTab* mt = (const MoeTab*)(smem + LDS_TAB);
    const int tid = tidx(), wid = tid >> 6, lane = tid & 63;
    float* modl = (float*)smem;
    const float* modp = (const float*)(p.ws + WS_MODP);
    {
        float t[8];
#pragma unroll
        for (int j = 0; j < 8; ++j) { const int i = tid + j * NTHREADS; t[j] = modval(modp, i >> 10, 5120 + (i & 1023)); }
#pragma unroll
        for (int j = 0; j < 8; ++j) modl[tid + j * NTHREADS] = t[j];
    }
    float* gl = modl + 4096;
    { const float a0 = p.g_post_ffn[tid], a1 = p.g_post_ffn[tid + NTHREADS]; gl[tid] = a0; gl[tid + NTHREADS] = a1; }
    __syncthreads();
    const unsigned char* ye = (const unsigned char*)(p.ws + WS_YE);
    const int* slotE = (const int*)(p.ws + WS_SLOTE); const int* slotP = (const int*)(p.ws + WS_SLOTP); const float* slotW = (const float*)(p.ws + WS_SLOTW);
    const int c0 = (lane >> 4) * 256 + ((lane >> 2) & 3) * 32 + (lane & 3) * 8;
    const int tstep = gridDim.x * 8;
    int sE = 0, sP = 0; float sW = 0.f;
    int nrow = 0; float nw = 0.f; u32x4 nrv[9], nxw[2];
#define P10_SLOTS(t_) do { if ((t_) < NT && lane < 8) { sE = slotE[(t_) * 8 + lane]; sP = slotP[(t_) * 8 + lane]; sW = slotW[(t_) * 8 + lane]; } } while (0)
#define P10_ROWS(t_) do { if ((t_) < NT) { nrow = lane < 8 ? mt->pt[sE] * 256 + sP : 0; nw = sW * (1.0f / YE_SCALE); \
        nrv[8] = *(const u32x4*)(ye + ((size_t)mt->pt[128] * 256 + (t_)) * 1024 + 16 * lane); \
        { const bf16_t* x1r_ = (const bf16_t*)(p.ws + WS_X1B) + (size_t)(t_) * 1024; nxw[0] = *(const u32x4*)(x1r_ + c0); nxw[1] = *(const u32x4*)(x1r_ + c0 + 128); } \
        _Pragma("unroll") for (int k = 0; k < 8; ++k) { const int row_ = __shfl(nrow, k); nrv[k] = *(const u32x4*)(ye + (size_t)row_ * 1024 + 16 * lane); } } } while (0)
    { const int t0 = blockIdx.x * 8 + wid; P10_SLOTS(t0); P10_ROWS(t0); P10_SLOTS(t0 + tstep); }
    for (int tokn = blockIdx.x * 8 + wid; tokn < NT; tokn += tstep) {
        u32x4 rv[9]; const float myw = nw; const u32x4 xw0 = nxw[0], xw1 = nxw[1];
#pragma unroll
        for (int k = 0; k < 9; ++k) rv[k] = nrv[k];
        P10_ROWS(tokn + tstep);
        P10_SLOTS(tokn + 2 * tstep);
        float a[16];
        {
            float f0[8], f1[8]; unpack_fp8x8((u32x2){rv[8].x, rv[8].y}, f0); unpack_fp8x8((u32x2){rv[8].z, rv[8].w}, f1);
#pragma unroll
            for (int i = 0; i < 8; ++i) { a[i] = f0[i] * (1.0f / YE_SCALE); a[8 + i] = f1[i] * (1.0f / YE_SCALE); }
        }
#pragma unroll
        for (int k = 0; k < 8; ++k) {
            const float wk = __shfl(myw, k);
            float f0[8], f1[8]; unpack_fp8x8((u32x2){rv[k].x, rv[k].y}, f0); unpack_fp8x8((u32x2){rv[k].z, rv[k].w}, f1);
#pragma unroll
            for (int i = 0; i < 8; ++i) { a[i] += wk * f0[i]; a[8 + i] += wk * f1[i]; }
        }
        float ss = 0.f;
#pragma unroll
        for (int i = 0; i < 16; ++i) ss += a[i] * a[i];
        ss = wave_sum(ss);
        const float inv = rsqrtf(ss * (1.0f / 1024.0f) + EPS);
        const float* gt = modl + (tokn / T) * 1024;
        float* orow = p.out + (size_t)tokn * 1024;
#pragma unroll
        for (int hh = 0; hh < 2; ++hh) {
            const u32x4 xw = hh ? xw1 : xw0;
            const unsigned wv[4] = {xw.x, xw.y, xw.z, xw.w};
#pragma unroll
            for (int q2 = 0; q2 < 2; ++q2) {
                const int idx = c0 + hh * 128 + q2 * 4, q = hh * 2 + q2;
                const f32x4 g = *(const f32x4*)(gl + idx), gg = *(const f32x4*)(gt + idx);
                f32x4 o;
                o[0] = __uint_as_float(wv[2 * q2] << 16); o[1] = __uint_as_float(wv[2 * q2] & 0xffff0000u); o[2] = __uint_as_float(wv[2 * q2 + 1] << 16); o[3] = __uint_as_float(wv[2 * q2 + 1] & 0xffff0000u);
#pragma unroll
                for (int c = 0; c < 4; ++c) o[c] += gg[c] * (a[q * 4 + c] * inv * g[c]);
                *(f32x4*)(orow + idx) = o;
            }
        }
    }
#undef P10_SLOTS
#undef P10_ROWS
}

#define XB_TMO      128
#define XB_XCNT(j)  (256  + 64 * (j))
#define XB_XSUB(j)  (1280 + 64 * (j))
#define XB_XGEN(j)  (2304 + 64 * (j))
#define XB_TOP      3328
#define XB_TOPGEN   3392
#define XCD_BAR_WORDS 3456
#define XB_SPIN_CAP (1u << 18)
__device__ __forceinline__ unsigned xb_ld(unsigned* p)              { return __hip_atomic_load(p, __ATOMIC_RELAXED, __HIP_MEMORY_SCOPE_AGENT); }
__device__ __forceinline__ unsigned xb_add(unsigned* p, unsigned v) { return __hip_atomic_fetch_add(p, v, __ATOMIC_RELAXED, __HIP_MEMORY_SCOPE_AGENT); }
__device__ __forceinline__ unsigned xb_xcc_id() { return (unsigned)__builtin_amdgcn_s_getreg((3 << 11) | 20) & 0xFu; }
#define XB_SPIN(cond, bar) do { unsigned _sp = 0; while (cond) { __builtin_amdgcn_s_sleep(1); \
    if ((++_sp & 255u) == 0u) { if (xb_ld(&(bar)[XB_TMO])) break; if (_sp > XB_SPIN_CAP) { atomicAdd(&(bar)[XB_TMO], 1u); break; } } } } while (0)
struct XcdBarrier { unsigned* bar; unsigned x; volatile LAS unsigned* st; };
__device__ __forceinline__ XcdBarrier xcd_barrier_post(unsigned* bar, volatile LAS unsigned* st) {
    XcdBarrier b; b.bar = bar; b.x = xb_xcc_id(); b.st = st;
    if (tidx() == 0) (void)xb_add(&bar[XB_XCNT(b.x)], 1u);
    return b;
}
__device__ __forceinline__ void xcd_barrier_complete(unsigned* bar, unsigned x, unsigned& nloc, unsigned& nx) {
    const unsigned G = gridDim.x * gridDim.y * gridDim.z;
    unsigned sum, cnt, mine, sp = 0u;
    for (;;) {
        sum = 0u; cnt = 0u; mine = 0u;
#pragma unroll
        for (unsigned j = 0; j < 16; ++j) { const unsigned c = xb_ld(&bar[XB_XCNT(j)]); sum += c; cnt += (c > 0u) ? 1u : 0u; mine = (j == x) ? c : mine; }
        if (sum == G) break;
        __builtin_amdgcn_s_sleep(1);
        if ((++sp & 255u) == 0u) { if (xb_ld(&bar[XB_TMO])) break; if (sp > XB_SPIN_CAP) { atomicAdd(&bar[XB_TMO], 1u); break; } }
    }
    nloc = mine > 0u ? mine : 1u; nx = cnt > 0u ? cnt : 1u;
}
__device__ __forceinline__ void xcd_barrier(const XcdBarrier& b) {
    asm volatile("s_waitcnt vmcnt(0)" ::: "memory");
    __syncthreads();
    if (tidx() == 0) {
        unsigned* bar = b.bar;
        __builtin_amdgcn_s_waitcnt(0);
        unsigned nloc = b.st[0], nx = b.st[1];
        if (nloc == 0u) { xcd_barrier_complete(bar, b.x, nloc, nx); b.st[0] = nloc; b.st[1] = nx; }
        const unsigned old = xb_add(&bar[XB_XSUB(b.x)], 1u);
        const unsigned gen = old / nloc;
        if (old + 1u == (gen + 1u) * nloc) {
            __builtin_amdgcn_fence(__ATOMIC_RELEASE, "agent");
            asm volatile("s_waitcnt vmcnt(0)" ::: "memory");
            const unsigned og = xb_add(&bar[XB_TOP], 1u);
            const unsigned tg = og / nx;
            if (og + 1u == (tg + 1u) * nx) xb_add(&bar[XB_TOPGEN], 1u);
            else XB_SPIN(xb_ld(&bar[XB_TOPGEN]) == tg, bar);
            __builtin_amdgcn_fence(__ATOMIC_ACQUIRE, "agent");
            xb_add(&bar[XB_XGEN(b.x)], 1u);
            asm volatile("s_waitcnt vmcnt(0)" ::: "memory");
        } else {
            XB_SPIN(xb_ld(&bar[XB_XGEN(b.x)]) == gen, bar);
            __builtin_amdgcn_fence(__ATOMIC_ACQUIRE, "agent");
            asm volatile("s_waitcnt vmcnt(0)" ::: "memory");
        }
    }
    __syncthreads();
}

constexpr int LDS_BYTES = 160 * 1024;
__global__ void __launch_bounds__(NTHREADS) k_mega(P p) {
    extern __shared__ __attribute__((aligned(16))) char smem[];
    cg::grid_group grid = cg::this_grid();
    volatile LAS unsigned* xbst = (volatile LAS unsigned*)(smem + 160 * 1024 - 64);
    if (tidx() == 0) { xbst[0] = 0u; xbst[1] = 0u; }
    __syncthreads();
    const XcdBarrier xb = xcd_barrier_post((unsigned*)(p.ws + WS_BAR), xbst);
#define RUN(bit, call) do { call; xcd_barrier(xb); if (DUP_MASK & (1 << (bit))) { call; xcd_barrier(xb); } } while (0)
    phase0(p, smem);
    if (p.ws == nullptr) grid.sync();
    if (DUP_MASK & 1) phase0(p, smem);
    RUN(1, phase1(p, smem));
    RUN(2, phase2(p, smem));
    RUN(3, phase3(p, smem));
    RUN(4, phase4(p, smem));
    RUN(5, phase5(p, smem));
    RUN(6, phase6(p, smem));
    phase7(p, smem); xcd_barrier(xb);
    if (DUP_MASK & 128) { if (blockIdx.x == 0 && tidx() < 128) ((int*)(p.ws + WS_CURSOR))[tidx()] = 0; xcd_barrier(xb); phase7(p, smem); xcd_barrier(xb); }
    RUN(8, phase9a(p, smem));
    RUN(9, phase9b(p, smem));
    phase10(p, smem);
#undef RUN
}

extern "C" void kernel_launch(void* const* d_in, const int* in_sizes, int n_in, void* d_out, int out_size, void* d_ws, size_t ws_size, hipStream_t stream) {
    if (n_in != 28 || ws_size < WS_END) { fprintf(stderr, "kernel_launch: unexpected inputs (%d) or workspace (%zu < %zu)\n", n_in, ws_size, (size_t)WS_END); return; }
    static int grid_blocks = 0;
    if (!grid_blocks) {
        int dev = 0, cus = 0, per_cu = 0;
        (void)hipGetDevice(&dev);
        (void)hipDeviceGetAttribute(&cus, hipDeviceAttributeMultiprocessorCount, dev);
        (void)hipFuncSetAttribute((const void*)k_mega, hipFuncAttributeMaxDynamicSharedMemorySize, LDS_BYTES);
        (void)hipOccupancyMaxActiveBlocksPerMultiprocessor(&per_cu, (const void*)k_mega, NTHREADS, LDS_BYTES);
        if (per_cu < 1) { fprintf(stderr, "kernel_launch: occupancy query returned %d\n", per_cu); per_cu = 1; }
        if (per_cu > 1) per_cu = 1;
        grid_blocks = cus * per_cu;
    }
    P p{};
    const float** f = (const float**)&p;
    for (int i = 0; i < 28; ++i) f[i] = (const float*)d_in[i];
    p.out = (float*)d_out; p.ws = (unsigned char*)d_ws;
    (void)hipMemsetAsync((char*)d_ws + WS_BAR, 0, (XB_ADAFLAG + 16) * 4, stream);
    void* args[] = {&p};
    hipError_t e = hipLaunchCooperativeKernel((const void*)k_mega, dim3(grid_blocks), dim3(NTHREADS), args, LDS_BYTES, stream);
    if (e != hipSuccess) fprintf(stderr, "cooperative launch failed: %s (grid %d)\n", hipGetErrorString(e), grid_blocks);
}
```

```cpp
#include <hip/hip_runtime.h>
#include <hip/hip_cooperative_groups.h>
#include <cstdio>
#include <cstdint>

#ifndef DUP_MASK
#define DUP_MASK 0
#endif
#ifndef N_LAUNCH_MODE
#define N_LAUNCH_MODE 0
#endif

namespace cg = cooperative_groups;

typedef unsigned short bf16_t;
typedef short bf16x8 __attribute__((ext_vector_type(8)));
typedef float f32x4 __attribute__((ext_vector_type(4)));
typedef unsigned u32x2 __attribute__((ext_vector_type(2)));
typedef float f32x2_t __attribute__((ext_vector_type(2)));
typedef unsigned u32x4 __attribute__((ext_vector_type(4)));
#define LAS __attribute__((address_space(3)))

constexpr int D = 1024, NB = 4, T = 8192, NT = NB * T, CTXL = 256, CT = NB * CTXL, NR = NT + CT;
constexpr int DIN = 2576, NH = 4, DV = 128, DK = 64, NE = 64, TOPK = 8, DE = 256;
constexpr int NCH = 66;
constexpr float EPS = 1e-6f;
constexpr int NTHREADS = 512;

constexpr size_t al256(size_t x) { return (x + 255) & ~(size_t)255; }
constexpr int HT = NT / 2;
constexpr int LCAP = NT;
constexpr size_t WS_WT_D = 0;
constexpr size_t WS_MODP = WS_WT_D + (size_t)65 * 1024 * 256 * 2;
constexpr size_t WS_LTOK = WS_MODP + (size_t)8 * 5 * 6144 * 4;
constexpr size_t WS_SLOTE = WS_LTOK + (size_t)64 * LCAP * 4;
constexpr size_t WS_SLOTP = WS_SLOTE + (size_t)NT * 8 * 4;
constexpr size_t WS_SLOTW = WS_SLOTP + (size_t)NT * 8 * 4;
constexpr size_t WS_CURSOR = WS_SLOTW + (size_t)NT * 8 * 4;
constexpr size_t WS_WRH = WS_CURSOR + 1024;
constexpr size_t WS_WRL = WS_WRH + 131072;
constexpr size_t WS_BAR = WS_WRL + 131072;
constexpr size_t WS_GP = WS_BAR + 16384;
constexpr size_t WS_Z1 = al256(WS_GP + (size_t)NR * 16 * 4);
constexpr size_t WS_WT_IN = WS_Z1;
constexpr size_t WS_WT_IN8 = WS_WT_IN + (size_t)1024 * 1024 * 2;
constexpr size_t WS_WT_OUT = WS_WT_IN + (size_t)2560 * 1024 * 2;
constexpr size_t WS_WT_GU = WS_WT_OUT + (size_t)1024 * 1024 * 2;
constexpr size_t WS_HX = WS_WT_GU + (size_t)65 * 512 * 1024 * 2;
constexpr size_t WS_RA = WS_HX + (size_t)NR * 1024 * 2;
constexpr size_t WS_Q = WS_RA;
constexpr size_t WS_K = WS_Q + (size_t)NR * 256 * 2;
constexpr size_t WS_V = WS_K + (size_t)NR * 256 * 2;
constexpr size_t WS_SO = WS_V + (size_t)NR * 512 * 2;
constexpr size_t WS_U = WS_SO + (size_t)NR * 512 * 2;
constexpr size_t WS_RA_END = WS_U + (size_t)NR * 512 * 2;
constexpr size_t WS_YX = WS_RA;
constexpr size_t WS_RB = WS_RA_END;
constexpr size_t WS_CLOC = WS_RB;
constexpr size_t WS_HX8 = WS_CLOC + (size_t)32 * NCH * 8192 * 2;
constexpr size_t WS_NLOC = WS_CLOC + (size_t)32 * NCH * 8192 * 4;
constexpr size_t WS_SCAL = WS_NLOC + (size_t)32 * NCH * 64 * 4;
constexpr size_t WS_CPREV = al256(WS_SCAL + (size_t)32 * NCH * 2 * 4);
constexpr size_t WS_NPREV = WS_CPREV + (size_t)32 * 64 * 8192 * 2;
constexpr size_t WS_MPREV = WS_NPREV + (size_t)32 * 64 * 64 * 4;
constexpr size_t WS_MIX = al256(WS_MPREV + (size_t)32 * 64 * 4);
constexpr size_t WS_RB_END = WS_MIX + (size_t)NT * 1024 * 2;
constexpr int MAXTILES = 64 + NT * 8 / 256 + NT / 256;
constexpr size_t WS_YE = WS_Z1;
constexpr size_t WS_ACT = WS_YE + (size_t)MAXTILES * 256 * 1024;
constexpr size_t WS_ACT_END = WS_ACT + (size_t)MAXTILES * 256 * 256;
constexpr size_t WS_X1B = al256(WS_ACT_END);
constexpr size_t WS_X1B_END = WS_X1B + (size_t)NT * 1024 * 2;
constexpr size_t WS_END = WS_X1B_END > WS_RB_END ? WS_X1B_END : WS_RB_END;
static_assert(WS_ACT >= WS_RA_END, "act must not overlap hx2 / gate-up weights / yx");
static_assert((size_t)NT * 1024 * 4 <= WS_RA_END - WS_RA, "yx alias overflow");
static_assert(WS_END <= (size_t)512 * 1024 * 1024, "workspace too large");

struct P {
    const float *x, *c, *ctx, *c_ctx, *w_ada, *b_ada, *g_pre_mix, *g_post_mix, *g_pre_ffn, *g_post_ffn;
    const float *w_in, *b_in, *b_gate, *norm_g, *conv_w, *conv_b, *ln_g, *ln_b, *w_out, *b_out;
    const float *w_router, *b_router, *we_gate, *we_up, *we_down, *ws_gate, *ws_up, *ws_down;
    float* out;
    unsigned char* ws;
};

__device__ __forceinline__ int tidx() { int t = threadIdx.x; asm volatile("" : "+v"(t)); return t; }
__device__ __forceinline__ unsigned hw_pk_bf16(float lo, float hi) { unsigned r; asm("s_nop 0\n\tv_cvt_pk_bf16_f32 %0, %1, %2" : "=v"(r) : "v"(lo), "v"(hi)); return r; }
__device__ __forceinline__ bf16_t f2bf(float f) { return (bf16_t)(hw_pk_bf16(f, f) & 0xffffu); }
__device__ __forceinline__ float bf2f(bf16_t b) { return __uint_as_float(((unsigned)b) << 16); }
__device__ __forceinline__ unsigned pk2(float lo, float hi) { return hw_pk_bf16(lo, hi); }
__device__ __forceinline__ unsigned pk2_sw(float lo, float hi) { unsigned a = __float_as_uint(lo), b = __float_as_uint(hi); a += 0x7FFFu + ((a >> 16) & 1u); b += 0x7FFFu + ((b >> 16) & 1u); return (a >> 16) | (b & 0xffff0000u); }
__device__ __forceinline__ unsigned pk4_fp8(const f32x4 v) {
    const float a = __builtin_amdgcn_fmed3f(v[0], -448.f, 448.f), b = __builtin_amdgcn_fmed3f(v[1], -448.f, 448.f);
    const float c = __builtin_amdgcn_fmed3f(v[2], -448.f, 448.f), d = __builtin_amdgcn_fmed3f(v[3], -448.f, 448.f);
    int w = __builtin_amdgcn_cvt_pk_fp8_f32(a, b, 0, false);
    w = __builtin_amdgcn_cvt_pk_fp8_f32(c, d, w, true);
    return (unsigned)w;
}
template <int CTRL, int RMASK> __device__ __forceinline__ float dpp_get(float oldv, float v) {
    return __int_as_float(__builtin_amdgcn_update_dpp(__float_as_int(oldv), __float_as_int(v), CTRL, RMASK, 0xf, false));
}
__device__ __forceinline__ float fq_sum(float v) {
    const auto a = __builtin_amdgcn_permlane32_swap(__float_as_uint(v), __float_as_uint(v), false, false);
    const float s = __uint_as_float(a[0]) + __uint_as_float(a[1]);
    const auto b = __builtin_amdgcn_permlane16_swap(__float_as_uint(s), __float_as_uint(s), false, false);
    return __uint_as_float(b[0]) + __uint_as_float(b[1]);
}
__device__ __forceinline__ float wave_sum(float v) {
    v += dpp_get<0xB1, 0xf>(0.f, v);
    v += dpp_get<0x4E, 0xf>(0.f, v);
    v += dpp_get<0x141, 0xf>(0.f, v);
    v += dpp_get<0x140, 0xf>(0.f, v);
    v += dpp_get<0x142, 0xa>(0.f, v);
    v += dpp_get<0x143, 0xc>(0.f, v);
    return __int_as_float(__builtin_amdgcn_readlane(__float_as_int(v), 63));
}
__device__ __forceinline__ float wave_max(float v) {
    v = fmaxf(v, dpp_get<0xB1, 0xf>(v, v));
    v = fmaxf(v, dpp_get<0x4E, 0xf>(v, v));
    v = fmaxf(v, dpp_get<0x141, 0xf>(v, v));
    v = fmaxf(v, dpp_get<0x140, 0xf>(v, v));
    v = fmaxf(v, dpp_get<0x142, 0xa>(v, v));
    v = fmaxf(v, dpp_get<0x143, 0xc>(v, v));
    return __int_as_float(__builtin_amdgcn_readlane(__float_as_int(v), 63));
}
__device__ __forceinline__ float sigmoidf_(float x) { return 1.0f / (1.0f + __expf(-x)); }
__device__ __forceinline__ float siluf_(float x) { return x / (1.0f + __expf(-x)); }
__device__ __forceinline__ float silu_fast(float x) { return x * __builtin_amdgcn_rcpf(1.0f + __expf(-x)); }
__device__ __forceinline__ float logsigmoidf_(float x) { return fminf(x, 0.0f) - log1pf(__expf(-fabsf(x))); }
__device__ __forceinline__ float modval(const float* modp, int r, int idx) { return modp[(size_t)r * 6144 + idx]; }
__device__ __forceinline__ void glds16(const void* g, char* l) {
    __builtin_amdgcn_global_load_lds((const __attribute__((address_space(1))) unsigned*)g, (LAS unsigned*)l, 16, 0, 0);
}

template <bool FWD> __device__ __forceinline__ float masked_sum128(const float* a, int t) {
    float s = 0.f;
#pragma unroll 8
    for (int j4 = 0; j4 < 32; ++j4) {
        const f32x4 v = *(const f32x4*)(a + 4 * j4); const int j = 4 * j4;
        if (FWD) s += ((j <= t ? v[0] : 0.f) + (j + 1 <= t ? v[1] : 0.f)) + ((j + 2 <= t ? v[2] : 0.f) + (j + 3 <= t ? v[3] : 0.f));
        else     s += ((j >= t ? v[0] : 0.f) + (j + 1 >= t ? v[1] : 0.f)) + ((j + 2 >= t ? v[2] : 0.f) + (j + 3 >= t ? v[3] : 0.f));
    }
    return s;
}
template <bool FWD> __device__ __forceinline__ float masked_max128(const float* a, int t) {
    float s = -INFINITY;
#pragma unroll 8
    for (int j4 = 0; j4 < 32; ++j4) {
        const f32x4 v = *(const f32x4*)(a + 4 * j4); const int j = 4 * j4;
        if (FWD) s = fmaxf(fmaxf(s, fmaxf(j <= t ? v[0] : -INFINITY, j + 1 <= t ? v[1] : -INFINITY)), fmaxf(j + 2 <= t ? v[2] : -INFINITY, j + 3 <= t ? v[3] : -INFINITY));
        else     s = fmaxf(fmaxf(s, fmaxf(j >= t ? v[0] : -INFINITY, j + 1 >= t ? v[1] : -INFINITY)), fmaxf(j + 2 >= t ? v[2] : -INFINITY, j + 3 >= t ? v[3] : -INFINITY));
    }
    return s;
}
__device__ __forceinline__ float reduce16(const float (&g)[16], int lane) {
    float h8[8], h4[4], h2[2];
    const bool b5 = lane & 32, b4 = lane & 16, b3 = lane & 8, b2 = lane & 4;
#pragma unroll
    for (int i = 0; i < 8; ++i) { const auto x = __builtin_amdgcn_permlane32_swap(__float_as_uint(g[i]), __float_as_uint(g[i + 8]), false, false); h8[i] = __uint_as_float(x[0]) + __uint_as_float(x[1]); }
#pragma unroll
    for (int i = 0; i < 4; ++i) { const auto x = __builtin_amdgcn_permlane16_swap(__float_as_uint(h8[i]), __float_as_uint(h8[i + 4]), false, false); h4[i] = __uint_as_float(x[0]) + __uint_as_float(x[1]); }
#pragma unroll
    for (int i = 0; i < 2; ++i) { const float keep = b3 ? h4[i + 2] : h4[i], send = b3 ? h4[i] : h4[i + 2]; h2[i] = keep + dpp_get<0x128, 0xf>(0.f, send); }
    float r = (b2 ? h2[1] : h2[0]) + __shfl_xor(b2 ? h2[0] : h2[1], 4);
    r += dpp_get<0x4E, 0xf>(0.f, r); r += dpp_get<0xB1, 0xf>(0.f, r);
    (void)b5; (void)b4;
    return r;
}

template <int CTRL, int RMASK> __device__ __forceinline__ float dpp_get_bc(float oldv, float v) {
    return __int_as_float(__builtin_amdgcn_update_dpp(__float_as_int(oldv), __float_as_int(v), CTRL, RMASK, 0xf, false));
}
__device__ __forceinline__ float wscan_up_add(float v, int lane) {
    (void)lane;
    v += dpp_get_bc<0x111, 0xf>(0.f, v);
    v += dpp_get_bc<0x112, 0xf>(0.f, v);
    v += dpp_get_bc<0x114, 0xf>(0.f, v);
    v += dpp_get_bc<0x118, 0xf>(0.f, v);
    v += dpp_get_bc<0x142, 0xa>(0.f, v);
    v += dpp_get_bc<0x143, 0xc>(0.f, v);
    return v;
}
__device__ __forceinline__ float wscan_up_max(float v, int lane) {
    (void)lane;
    v = fmaxf(v, dpp_get_bc<0x111, 0xf>(v, v));
    v = fmaxf(v, dpp_get_bc<0x112, 0xf>(v, v));
    v = fmaxf(v, dpp_get_bc<0x114, 0xf>(v, v));
    v = fmaxf(v, dpp_get_bc<0x118, 0xf>(v, v));
    v = fmaxf(v, dpp_get_bc<0x142, 0xa>(v, v));
    v = fmaxf(v, dpp_get_bc<0x143, 0xc>(v, v));
    return v;
}
__device__ __forceinline__ float wscan_down_add(float v, int lane) {
    v = __shfl(v, 63 - lane); v = wscan_up_add(v, lane); return __shfl(v, 63 - lane);
}
__device__ __forceinline__ float wscan_down_max(float v, int lane) {
    v = __shfl(v, 63 - lane); v = wscan_up_max(v, lane); return __shfl(v, 63 - lane);
}
__device__ __forceinline__ int seq_row0(int s, int cid) { return cid < 2 ? NT + s * CTXL + cid * 128 : s * T + (cid - 2) * 128; }

namespace g8 {
constexpr int BM = 256, BK = 64, HALF = 128, HTB = HALF * BK * 2, STAGE_BYTES = 8 * HTB;
__device__ __forceinline__ int lds_byte(int r, int c) { const int st = (r >> 4) * 2 + (c >> 5), rr = r & 15, cc = c & 31, ob = rr * 64 + cc * 2; return st * 1024 + (ob ^ (((ob >> 9) & 1) << 5)); }
__device__ __forceinline__ void stage_rc(int b, int& R, int& C) { const int st = b / 1024, sb = b % 1024, swz = sb ^ (((sb >> 9) & 1) << 5); R = (st >> 1) * 16 + swz / 64; C = (st & 1) * 32 + (swz % 64) / 2; }
__device__ __forceinline__ int perm32(int rho) { const int n = rho >> 4, i = rho & 15; return 8 * (i >> 2) + 4 * n + (i & 3); }
__device__ __forceinline__ unsigned cvt_pk_bf16(float lo, float hi) { unsigned r; asm volatile("s_nop 0\n\tv_cvt_pk_bf16_f32 %0, %1, %2" : "=v"(r) : "v"(lo), "v"(hi)); return r; }

struct Unit { const char* A; const char* B; int x0, x1, x2, x3; };

typedef int v8i_t __attribute__((ext_vector_type(8)));
template <bool PERM, bool GATHER, bool FP8, int SCB, class Sched, class Epi>
__device__ __forceinline__ void gemm(LAS unsigned char* lds, const int KB, const Sched& S, const Epi& E) {
    const int tid = tidx(), wid = __builtin_amdgcn_readfirstlane(tid >> 6), lane = tid & 63, wr = wid >> 2, wc = wid & 3, fr = lane & 15, fq = lane >> 4;
    const int nt = KB / 128;
    int R[2]; unsigned c2[2], voffB[2], vb[2];
#pragma unroll
    for (int i = 0; i < 2; ++i) { int C; stage_rc(tid * 16 + i * 8192, R[i], C); const int Rb = PERM ? ((R[i] & ~31) + perm32(R[i] & 31)) : R[i]; voffB[i] = (unsigned)(Rb * KB + C * 2); vb[i] = (unsigned)(R[i] * KB + C * 2); c2[i] = (unsigned)C * 2u; }
    const size_t kstep = (size_t)(BK * 2);
    const size_t hstep = (size_t)HALF * KB;
    const unsigned ldsw = (unsigned)wid * 1024u;
    const int ca0 = FP8 ? (fq >> 1) * 32 + (fq & 1) * 16 : fq * 8, ca1 = FP8 ? ca0 + 8 : 32 + fq * 8;
    const int pa0 = lds_byte(wr * 64 + fr, ca0), pa1 = lds_byte(wr * 64 + fr, ca1), pb0 = lds_byte(wc * 32 + fr, ca0), pb1 = lds_byte(wc * 32 + fr, ca1);
#define G8_SA(b, h) (((b) * 2 + (h)) * HTB)
#define G8_SB(b, h) ((4 + (b) * 2 + (h)) * HTB)
#define G8_STAGE(bufoff, gbase, voff) do { _Pragma("unroll") for (int _i = 0; _i < 2; ++_i) \
        __builtin_amdgcn_global_load_lds((const __attribute__((address_space(1))) unsigned*)((const char*)(gbase) + (voff)[_i]), (LAS unsigned*)(lds + (bufoff) + ldsw + _i * 8192), 16, 0, 0); } while (0)
#define G8_LDA(dst, b, h) do { _Pragma("unroll") for (int m = 0; m < 4; ++m) _Pragma("unroll") for (int k = 0; k < 2; ++k) dst[m][k] = *(const LAS bf16x8*)(lds + G8_SA(b, h) + (k ? pa1 : pa0) + m * 2048); } while (0)
#define G8_LDB(dst, b, h) do { _Pragma("unroll") for (int n = 0; n < 2; ++n) _Pragma("unroll") for (int k = 0; k < 2; ++k) dst[n][k] = *(const LAS bf16x8*)(lds + G8_SB(b, h) + (k ? pb1 : pb0) + n * 2048); } while (0)
#define G8_CAT(x) __builtin_shufflevector(__builtin_bit_cast(u32x4, (x)[0]), __builtin_bit_cast(u32x4, (x)[1]), 0, 1, 2, 3, 4, 5, 6, 7)
#define G8_MMA(ai, bj, At, Bt) do { __builtin_amdgcn_s_setprio(1); _Pragma("unroll") for (int m = 0; m < 4; ++m) _Pragma("unroll") for (int n = 0; n < 2; ++n) { \
        if (FP8) acc[ai][bj][m][n] = __builtin_amdgcn_mfma_scale_f32_16x16x128_f8f6f4(__builtin_bit_cast(v8i_t, G8_CAT(Bt[n])), __builtin_bit_cast(v8i_t, G8_CAT(At[m])), acc[ai][bj][m][n], 0, 0, 0, 0x7F7F7F7F, 0, SCB * 0x01010101); \
        else { _Pragma("unroll") for (int k = 0; k < 2; ++k) acc[ai][bj][m][n] = __builtin_amdgcn_mfma_f32_16x16x32_bf16(Bt[n][k], At[m][k], acc[ai][bj][m][n], 0, 0, 0); } } \
        __builtin_amdgcn_s_setprio(0); } while (0)
#define G8_WAIT_V(n) asm volatile("s_waitcnt vmcnt(" #n ")" ::: "memory")
#define G8_WAIT_L(n) asm volatile("s_waitcnt lgkmcnt(" #n ")" ::: "memory")
#define G8_BAR __builtin_amdgcn_s_barrier()
#define G8_SCHED __builtin_amdgcn_sched_barrier(0)
    Unit cur, nxt; int ui = 0;
    if (!S.next(0, cur)) return;
    f32x4 acc[2][2][4][2];
#define G8_ZERO_ACC() do { _Pragma("unroll") for (int a = 0; a < 2; ++a) _Pragma("unroll") for (int b = 0; b < 2; ++b) _Pragma("unroll") for (int m = 0; m < 4; ++m) _Pragma("unroll") for (int n = 0; n < 2; ++n) { \
        f32x2_t z0_, z1_; asm volatile("v_mov_b64 %0, 0" : "=v"(z0_)); asm volatile("v_mov_b64 %0, 0" : "=v"(z1_)); acc[a][b][m][n] = __builtin_shufflevector(z0_, z1_, 0, 1, 2, 3); } } while (0)
    G8_ZERO_ACC();
    bf16x8 At[4][2], B0[2][2], B1[2][2];
    unsigned va[2][2];
    if (GATHER) S.aoffs(cur, R, c2, va);
    else { va[0][0] = vb[0]; va[0][1] = vb[1]; va[1][0] = vb[0]; va[1][1] = vb[1]; }
    const size_t ah = GATHER ? (size_t)0 : hstep;
    const char* cA = cur.A; const char* cB = cur.B;
    G8_STAGE(G8_SB(0, 0), cB, voffB); G8_STAGE(G8_SA(0, 0), cA, va[0]); G8_STAGE(G8_SB(0, 1), cB + hstep, voffB); G8_STAGE(G8_SA(0, 1), cA + ah, va[1]);
    if (wr == 1) G8_BAR;
    G8_WAIT_V(4); G8_BAR;
    G8_STAGE(G8_SB(1, 0), cB + kstep, voffB); G8_STAGE(G8_SA(1, 0), cA + kstep, va[0]); G8_STAGE(G8_SB(1, 1), cB + hstep + kstep, voffB);
    G8_WAIT_V(6); G8_BAR;
    for (;;) {
        const bool has_next = S.next(ui + 1, nxt);
        const char* nA = has_next ? nxt.A : cA; const char* nB = has_next ? nxt.B : cB;
#pragma unroll 1
        for (int t = 0; t < nt; t += 2) {
            const bool last = (t == nt - 2);
            const char* a1 = cA + (size_t)(t + 1) * kstep;
            G8_LDB(B0, 0, 0); G8_SCHED; G8_LDA(At, 0, 0); G8_STAGE(G8_SA(1, 1), a1 + ah, va[1]);
            G8_WAIT_L(8); G8_BAR; G8_WAIT_L(0); G8_MMA(0, 0, At, B0); G8_BAR; G8_SCHED;
            if (GATHER) { if (last && has_next) S.aoffs(nxt, R, c2, va); }
            const char* a2 = last ? nA : cA + (size_t)(t + 2) * kstep; const char* b2 = last ? nB : cB + (size_t)(t + 2) * kstep;
            const char* a3 = a2 + kstep; const char* b3 = b2 + kstep;
            G8_SCHED;
            G8_LDB(B1, 0, 1); G8_STAGE(G8_SB(0, 0), b2, voffB);
            G8_BAR; G8_WAIT_L(0); G8_MMA(0, 1, At, B1); G8_BAR;
            G8_LDA(At, 0, 1); G8_STAGE(G8_SA(0, 0), a2, va[0]);
            G8_BAR; G8_WAIT_L(0); G8_MMA(1, 0, At, B0); G8_BAR; G8_SCHED;
            G8_STAGE(G8_SB(0, 1), b2 + hstep, voffB);
            G8_WAIT_V(6); G8_BAR; G8_MMA(1, 1, At, B1); G8_BAR;
            G8_LDB(B0, 1, 0); G8_SCHED; G8_LDA(At, 1, 0); G8_STAGE(G8_SA(0, 1), a2 + ah, va[1]);
            G8_WAIT_L(8); G8_BAR; G8_WAIT_L(0); G8_MMA(0, 0, At, B0); G8_BAR; G8_SCHED;
            G8_LDB(B1, 1, 1); G8_STAGE(G8_SB(1, 0), b3, voffB);
            G8_BAR; G8_WAIT_L(0); G8_MMA(0, 1, At, B1); G8_BAR;
            G8_LDA(At, 1, 1); G8_STAGE(G8_SA(1, 0), a3, va[0]);
            G8_BAR; G8_WAIT_L(0); G8_MMA(1, 0, At, B0); G8_BAR; G8_SCHED;
            G8_STAGE(G8_SB(1, 1), b3 + hstep, voffB);
            G8_WAIT_V(6); G8_BAR; G8_MMA(1, 1, At, B1); G8_BAR;
        }
        E(acc, cur, wr, wc, fr, fq);
        if (!has_next) break;
        G8_ZERO_ACC();
        cur = nxt; cA = nA; cB = nB; ++ui;
    }
    G8_WAIT_V(0);
    if (wr == 0) G8_BAR;
    G8_BAR;
#undef G8_ZERO_ACC
#undef G8_SA
#undef G8_SB
#undef G8_STAGE
#undef G8_LDA
#undef G8_LDB
#undef G8_MMA
#undef G8_CAT
#undef G8_WAIT_V
#undef G8_WAIT_L
#undef G8_BAR
#undef G8_SCHED
}

__device__ __forceinline__ bool static_unit(int i, int nM, int nN, int& pm, int& pn) {
    const int nwg = nM * nN, G = gridDim.x;
    const long L = (long)i * G + blockIdx.x; if (L >= nwg) return false;
    int wgid = (int)L; { const int q = nwg / 8, r = nwg % 8, xcd = wgid % 8, off = wgid / 8; wgid = (xcd < r ? xcd * (q + 1) : r * (q + 1) + (xcd - r) * q) + off; }
    const int nig = 8 * nN, gid = wgid / nig, fm = gid * 8, gsz = (nM - fm) < 8 ? (nM - fm) : 8;
    pm = fm + ((wgid % nig) % gsz); pn = (wgid % nig) / gsz; return true;
}
}

constexpr int CVT_T0 = 640, CVT_T1 = CVT_T0 + 256, CVT_T2 = CVT_T1 + 65 * 128, CVT_T3 = CVT_T2 + 65 * 64;
constexpr int ADA_ITEMS = 96;
constexpr float HX2_SCALE = 4.0f, WGU_SCALE = 64.0f;   static_assert(HX2_SCALE * WGU_SCALE == 256.0f, "the gate/up GEMM's MFMA block scale is 2^-8");
constexpr float YE_SCALE = 16.0f;
constexpr float HX8_SCALE = 4.0f, WIN8_SCALE = 64.0f;   static_assert(HX8_SCALE * WIN8_SCALE == 256.0f, "the fp8 in-projection's MFMA block scale is 2^-8");
constexpr float MIX_SCALE = 16.0f, WOUT_SCALE = 64.0f;   static_assert(MIX_SCALE * WOUT_SCALE == 1024.0f, "the out-projection's MFMA block scale is 2^-10");
constexpr float ACT_SCALE = 1.0f, WD_SCALE = YE_SCALE / ACT_SCALE;

__device__ __forceinline__ void ada_item(const P& p, int it, char* smem) {
    const int tid = tidx(), lane = tid & 63, kg = tid >> 6, cq = lane & 15, rg = lane >> 4;
    float* sc = (float*)smem;
    float* red = (float*)(smem + 20480);
    __syncthreads();
    {
        float t[10];
#pragma unroll
        for (int j = 0; j < 10; ++j) { const int i = tid + j * NTHREADS, r = i >> 10, k = i & 1023; t[j] = r < 4 ? p.c[r * 1024 + k] : p.c_ctx[k]; }
#pragma unroll
        for (int j = 0; j < 10; ++j) sc[tid + j * NTHREADS] = siluf_(t[j]);
    }
    __syncthreads();
    f32x4 a[5];
#pragma unroll
    for (int r = 0; r < 5; ++r) a[r] = (f32x4){0.f, 0.f, 0.f, 0.f};
    const float* w = p.w_ada + (size_t)(kg * 128 + rg) * 6144 + it * 64 + 4 * cq;
    const float* s0 = sc + kg * 128 + rg;
#pragma unroll 16
    for (int i = 0; i < 32; ++i) {
        const f32x4 wv = __builtin_nontemporal_load((const f32x4*)(w + (size_t)(4 * i) * 6144));
#pragma unroll
        for (int r = 0; r < 5; ++r) a[r] += s0[r * 1024 + 4 * i] * wv;
    }
#pragma unroll
    for (int r = 0; r < 5; ++r)
#pragma unroll
        for (int c = 0; c < 4; ++c) a[r][c] = fq_sum(a[r][c]);
    if (rg == 0) {
#pragma unroll
        for (int r = 0; r < 5; ++r) *(f32x4*)(red + kg * 320 + r * 64 + 4 * cq) = a[r];
    }
    __syncthreads();
    if (tid < 320) {
        const int r = tid >> 6, cc = it * 64 + (tid & 63);
        float v = p.b_ada[cc];
#pragma unroll
        for (int g = 0; g < 8; ++g) v += red[g * 320 + tid];
        ((float*)(p.ws + WS_MODP))[(size_t)r * 6144 + cc] = v;
    }
}

struct CvtTile { int job, e, k0, n0; };
__device__ __forceinline__ CvtTile cvt_decode(int t) {
    CvtTile c; c.e = 0; int kt, nt;
    if (t < CVT_T0) { kt = t / 40; nt = t % 40; c.job = nt >= 16 ? 4 : 0; }
    else if (t < CVT_T1) { c.job = 1; t -= CVT_T0; kt = t / 16; nt = t % 16; }
    else if (t < CVT_T2) { c.job = 2; t -= CVT_T1; c.e = t / 128; t %= 128; kt = t / 8; nt = t % 8; }
    else { c.job = 3; t -= CVT_T2; c.e = t / 64; t %= 64; kt = t / 16; nt = t % 16; }
    c.k0 = kt * 64; c.n0 = nt * 64; return c;
}
__device__ __forceinline__ const float* cvt_src(const P& p, const CvtTile& c, int k, int n) {
    if (c.job == 0 || c.job == 4) {
        if (n < 1536) return p.w_in + (size_t)k * DIN + n;
        const int m = n - 1536, g = m >> 8, wi = m & 255; return p.w_in + (size_t)k * DIN + (wi < 128 ? 1552 + g * 128 + wi : 2064 + g * 128 + wi - 128);
    } else if (c.job == 1) return p.w_out + (size_t)k * 1024 + n;
    else if (c.job == 2) {
        const int g = n >> 8, wi = n & 255;
        const float* gb = c.e < 64 ? p.we_gate + (size_t)c.e * 1024 * 256 : p.ws_gate;
        const float* ub = c.e < 64 ? p.we_up + (size_t)c.e * 1024 * 256 : p.ws_up;
        return wi < 128 ? gb + (size_t)k * 256 + g * 128 + wi : ub + (size_t)k * 256 + g * 128 + wi - 128;
    }
    const float* db = c.e < 64 ? p.we_down + (size_t)c.e * 256 * 1024 : p.ws_down; return db + (size_t)k * 1024 + n;
}
__device__ __forceinline__ bf16_t* cvt_dst(const P& p, const CvtTile& c, int n, int k) {
    if (c.job == 0) return (bf16_t*)(p.ws + WS_WT_IN) + (size_t)n * 1024 + k;
    if (c.job == 1) return (bf16_t*)(p.ws + WS_WT_OUT) + (size_t)n * 1024 + k;
    if (c.job == 2) return (bf16_t*)(p.ws + WS_WT_GU) + (size_t)c.e * 512 * 1024 + (size_t)n * 1024 + k;
    return (bf16_t*)(p.ws + WS_WT_D) + (size_t)c.e * 1024 * 256 + (size_t)n * 256 + k;
}
__device__ __forceinline__ void cvt_load(const P& p, int t4, f32x4 (&v)[8]) {
    const int tid = tidx();
    if (t4 * 4 >= CVT_T0 || (t4 * 4) % 40 >= 16) {
        const int q2 = tid >> 8, kq = (tid >> 4) & 15, n4 = (tid & 15) * 4;
#pragma unroll
        for (int rnd = 0; rnd < 2; ++rnd) {
            const CvtTile c = cvt_decode(t4 * 4 + q2 + 2 * rnd);
#pragma unroll
            for (int r = 0; r < 4; ++r) v[rnd * 4 + r] = __builtin_nontemporal_load((const f32x4*)cvt_src(p, c, c.k0 + 4 * kq + r, c.n0 + n4));
        }
    } else {
        const int kp = tid >> 4, n4 = (tid & 15) * 4;
#pragma unroll
        for (int q = 0; q < 4; ++q) {
            const CvtTile c = cvt_decode(t4 * 4 + q);
            v[2 * q] = __builtin_nontemporal_load((const f32x4*)cvt_src(p, c, c.k0 + 2 * kp, c.n0 + n4));
            v[2 * q + 1] = __builtin_nontemporal_load((const f32x4*)cvt_src(p, c, c.k0 + 2 * kp + 1, c.n0 + n4));
        }
    }
}
__device__ __forceinline__ void cvt_store(const P& p, int t4, const f32x4 (&v)[8], char* smem) {
    const int tid = tidx();
    unsigned* tile = (unsigned*)smem;
    if (t4 * 4 >= CVT_T0 || (t4 * 4) % 40 >= 16) {
        const int q2 = tid >> 8, kq = (tid >> 4) & 15, n4 = (tid & 15) * 4;
        CvtTile c[2];
#pragma unroll
        for (int rnd = 0; rnd < 2; ++rnd) {
            c[rnd] = cvt_decode(t4 * 4 + q2 + 2 * rnd);
#pragma unroll
            for (int cc = 0; cc < 4; ++cc)
                tile[(q2 + 2 * rnd) * 1088 + (n4 + cc) * 17 + kq] = pk4_fp8((f32x4){v[rnd * 4][cc], v[rnd * 4 + 1][cc], v[rnd * 4 + 2][cc], v[rnd * 4 + 3][cc]} * (c[rnd].job == 2 ? WGU_SCALE : (c[rnd].job == 3 ? WD_SCALE : (c[rnd].job == 4 ? WIN8_SCALE : WOUT_SCALE))));
        }
        __syncthreads();
        const int nn = (tid >> 2) & 63, part = tid & 3;
#pragma unroll
        for (int rnd = 0; rnd < 2; ++rnd) {
            const unsigned* src = tile + (q2 + 2 * rnd) * 1088 + nn * 17 + part * 4;
            u32x4 w; w.x = src[0]; w.y = src[1]; w.z = src[2]; w.w = src[3];
            unsigned char* dst = c[rnd].job == 2 ? (unsigned char*)(p.ws + WS_WT_GU) + (size_t)c[rnd].e * 512 * 1024 + (size_t)(c[rnd].n0 + nn) * 1024 + c[rnd].k0 + part * 16
                               : c[rnd].job == 3 ? (unsigned char*)(p.ws + WS_WT_D) + (size_t)c[rnd].e * 1024 * 256 + (size_t)(c[rnd].n0 + nn) * 256 + c[rnd].k0 + part * 16
                               : c[rnd].job == 4 ? (unsigned char*)(p.ws + WS_WT_IN8) + (size_t)(c[rnd].n0 + nn - 1024) * 1024 + c[rnd].k0 + part * 16
                                                 : (unsigned char*)(p.ws + WS_WT_OUT) + (size_t)(c[rnd].n0 + nn) * 1024 + c[rnd].k0 + part * 16;
            *(u32x4*)dst = w;
        }
    } else {
        const int kp = tid >> 4, n4 = (tid & 15) * 4;
#pragma unroll
        for (int q = 0; q < 4; ++q)
#pragma unroll
            for (int cc = 0; cc < 4; ++cc) tile[q * 2112 + (n4 + cc) * 33 + kp] = pk2(v[2 * q][cc], v[2 * q + 1][cc]);
        __syncthreads();
        const int nn = tid >> 3, kw = (tid & 7) * 4;
#pragma unroll
        for (int q = 0; q < 4; ++q) {
            const CvtTile c = cvt_decode(t4 * 4 + q);
            u32x4 w; w.x = tile[q * 2112 + nn * 33 + kw]; w.y = tile[q * 2112 + nn * 33 + kw + 1]; w.z = tile[q * 2112 + nn * 33 + kw + 2]; w.w = tile[q * 2112 + nn * 33 + kw + 3];
            *(u32x4*)cvt_dst(p, c, c.n0 + nn, c.k0 + 2 * kw) = w;
        }
    }
}

__device__ __forceinline__ void wr_split_item(const P& p, int it) {
    const int idx = it * NTHREADS + tidx(), lane = idx & 63, n = (idx >> 6) & 3, ks = (idx >> 8) & 3, w = idx >> 10, fr = lane & 15, fq = lane >> 4;
    float v[8], lo[8]; unsigned hi[4];
#pragma unroll
    for (int j = 0; j < 8; ++j) v[j] = p.w_router[(size_t)(128 * w + 32 * ks + 8 * fq + j) * 64 + 16 * n + fr];
#pragma unroll
    for (int j = 0; j < 4; ++j) { hi[j] = pk2(v[2 * j], v[2 * j + 1]); lo[2 * j] = v[2 * j] - __uint_as_float(hi[j] << 16); lo[2 * j + 1] = v[2 * j + 1] - __uint_as_float(hi[j] & 0xffff0000u); }
    *(u32x4*)(p.ws + WS_WRH + (size_t)idx * 16) = (u32x4){hi[0], hi[1], hi[2], hi[3]};
    *(u32x4*)(p.ws + WS_WRL + (size_t)idx * 16) = (u32x4){pk2(lo[0], lo[1]), pk2(lo[2], lo[3]), pk2(lo[4], lo[5]), pk2(lo[6], lo[7])};
}

constexpr int XB_ADAFLAG = 3520;
__device__ __forceinline__ void ada_signal(const P& p) {
    asm volatile("s_waitcnt vmcnt(0)" ::: "memory");
    __syncthreads();
    if (tidx() == 0) { __builtin_amdgcn_fence(__ATOMIC_RELEASE, "agent"); __hip_atomic_fetch_add((unsigned*)(p.ws + WS_BAR) + XB_ADAFLAG, 1u, __ATOMIC_RELAXED, __HIP_MEMORY_SCOPE_AGENT); }
}
__device__ __forceinline__ void ada_wait(const P& p) {
    if (tidx() == 0) {
        unsigned* f = (unsigned*)(p.ws + WS_BAR) + XB_ADAFLAG; unsigned* tmo = (unsigned*)(p.ws + WS_BAR) + 128; unsigned sp = 0;
        while (__hip_atomic_load(f, __ATOMIC_RELAXED, __HIP_MEMORY_SCOPE_AGENT) < (unsigned)ADA_ITEMS) {
            __builtin_amdgcn_s_sleep(2);
            if ((++sp & 255u) == 0u) { if (__hip_atomic_load(tmo, __ATOMIC_RELAXED, __HIP_MEMORY_SCOPE_AGENT)) break; if (sp > (1u << 18)) { atomicAdd(tmo, 1u); break; } }
        }
        __builtin_amdgcn_fence(__ATOMIC_ACQUIRE, "agent");
    }
    __syncthreads();
}
__device__ __forceinline__ void phase0(const P& p, char* smem) {
    if (blockIdx.x == 0 && tidx() < 128) ((int*)(p.ws + WS_CURSOR))[tidx()] = 0;
    const int G = (int)gridDim.x, bid = (int)blockIdx.x;
    for (int it = G - 1 - bid; it < 16; it += G) wr_split_item(p, it);
    for (int it = bid; it < ADA_ITEMS; it += G) { ada_item(p, it, smem); ada_signal(p); }
    const int S = CVT_T3 / 4, nA = G > ADA_ITEMS ? ADA_ITEMS : 0;
    int R = (S - 2 * (G - nA) + G - 1) / G; if (R < 0) R = 0;
    const int base2 = R * G, G2 = G - nA, b2 = bid - nA;
#define P0_STEP(k_) ((k_) < R ? (k_) * G + bid : (b2 >= 0 ? base2 + b2 + ((k_) - R) * G2 : S))
    f32x4 va[8], vb[8], vc[8];
    int k = 0, s0 = P0_STEP(0), s1 = P0_STEP(1), s2 = P0_STEP(2);
    if (s0 < S) cvt_load(p, s0, va);
    if (s1 < S) cvt_load(p, s1, vb);
    if (s2 < S) cvt_load(p, s2, vc);
#define P0_ONE(V_, sv_, kk_) { f32x4 c[8]; _Pragma("unroll") for (int i = 0; i < 8; ++i) c[i] = V_[i]; const int sn_ = P0_STEP(kk_); \
        __syncthreads(); if (sn_ < S) cvt_load(p, sn_, V_); cvt_store(p, sv_, c, smem); sv_ = sn_; }
    while (s0 < S) {
        P0_ONE(va, s0, k + 3);
        if (s1 >= S) break;
        P0_ONE(vb, s1, k + 4);
        if (s2 >= S) break;
        P0_ONE(vc, s2, k + 5);
        k += 3;
    }
#undef P0_ONE
#undef P0_STEP
}

__device__ __forceinline__ void phase1(const P& p, char* smem) {
    const int tid = tidx(), wid = tid >> 6, lane = tid & 63;
    float* modl = (float*)smem;
    float* wgT = (float*)(smem + 40960);
    const float* modp = (const float*)(p.ws + WS_MODP);
    f32x4 nv[2][4];
#define P1_LOAD(r0_) do { _Pragma("unroll") for (int q = 0; q < 2; ++q) { const int row_ = (r0_) + q; const float* xr_ = row_ < NT ? p.x + (size_t)row_ * 1024 : p.ctx + (size_t)(row_ - NT) * 1024; \
        _Pragma("unroll") for (int j = 0; j < 4; ++j) nv[q][j] = __builtin_nontemporal_load((const f32x4*)(xr_ + 4 * lane + 256 * j)); } } while (0)
    if ((blockIdx.x * 8 + wid) * 2 < NR) P1_LOAD((blockIdx.x * 8 + wid) * 2);
    ada_wait(p);
    {
        float t0[20], t1[32];
#pragma unroll
        for (int j = 0; j < 20; ++j) { const int i = tid + j * NTHREADS; t0[j] = modval(modp, i >> 11, i & 2047); }
#pragma unroll
        for (int j = 0; j < 32; ++j) { const int i = tid + j * NTHREADS; t1[j] = p.w_in[(size_t)(i >> 4) * DIN + 1536 + (i & 15)]; }
#pragma unroll
        for (int j = 0; j < 20; ++j) modl[tid + j * NTHREADS] = t0[j];
#pragma unroll
        for (int j = 0; j < 32; ++j) { const int i = tid + j * NTHREADS; wgT[(i & 15) * 1024 + (i >> 4)] = t1[j]; }
    }
    float* gl = (float*)(smem + 40960 + 65536);
    { const float a0 = p.g_pre_mix[tid], a1 = p.g_pre_mix[tid + NTHREADS]; gl[tid] = a0; gl[tid + NTHREADS] = a1; }
    const int gi = ((lane >> 5) & 1) * 8 + ((lane >> 4) & 1) * 4 + ((lane >> 3) & 1) * 2 + ((lane >> 2) & 1);
    const float bb = p.b_in[1536 + gi] + p.b_gate[gi];
    __syncthreads();
    bf16_t* hx = (bf16_t*)(p.ws + WS_HX);
    float* gp = (float*)(p.ws + WS_GP);
    for (int row0 = (blockIdx.x * 8 + wid) * 2; row0 < NR; row0 += gridDim.x * 16) {
        f32x4 v[2][4]; float ss[2]; int rr[2];
#pragma unroll
        for (int q = 0; q < 2; ++q) {
            rr[q] = (row0 + q) < NT ? (row0 + q) / T : 4; ss[q] = 0.f;
#pragma unroll
            for (int j = 0; j < 4; ++j) { v[q][j] = nv[q][j]; ss[q] += v[q][j][0] * v[q][j][0] + v[q][j][1] * v[q][j][1] + v[q][j][2] * v[q][j][2] + v[q][j][3] * v[q][j][3]; }
        }
        { const int nx = row0 + gridDim.x * 16; if (nx < NR) P1_LOAD(nx); }
        ss[0] = wave_sum(ss[0]); ss[1] = wave_sum(ss[1]);
#pragma unroll
        for (int q = 0; q < 2; ++q) {
            const int row = row0 + q;
            const float inv = rsqrtf(ss[q] * (1.0f / 1024.0f) + EPS);
            const float* sh = modl + rr[q] * 2048; const float* scl = sh + 1024;
#pragma unroll
            for (int j = 0; j < 4; ++j) {
                const int idx = 4 * lane + 256 * j;
                const f32x4 g = *(const f32x4*)(gl + idx), s1 = *(const f32x4*)(sh + idx), s2 = *(const f32x4*)(scl + idx);
#pragma unroll
                for (int c = 0; c < 4; ++c) v[q][j][c] = v[q][j][c] * inv * g[c] * (1.0f + s2[c]) + s1[c];
                u32x2 o; o.x = pk2(v[q][j][0], v[q][j][1]); o.y = pk2(v[q][j][2], v[q][j][3]);
                *(u32x2*)(hx + (size_t)row * 1024 + idx) = o;
                if (row < NT) *(unsigned*)(p.ws + WS_HX8 + (size_t)row * 1024 + idx) = pk4_fp8(v[q][j] * HX8_SCALE);
            }
        }
        float ga[2][16];
#pragma unroll
        for (int jg = 0; jg < 16; ++jg) {
            f32x4 s0 = (f32x4){0.f, 0.f, 0.f, 0.f}, s1 = s0;
#pragma unroll
            for (int j = 0; j < 4; ++j) {
                const f32x4 w = *(const f32x4*)(wgT + jg * 1024 + 4 * lane + 256 * j);
                s0 = __builtin_elementwise_fma(v[0][j], w, s0); s1 = __builtin_elementwise_fma(v[1][j], w, s1);
            }
            ga[0][jg] = (s0[0] + s0[1]) + (s0[2] + s0[3]); ga[1][jg] = (s1[0] + s1[1]) + (s1[2] + s1[3]);
            if ((jg & 3) == 3) __builtin_amdgcn_sched_barrier(0);
        }
        const float r0 = reduce16(ga[0], lane), r1 = reduce16(ga[1], lane);
        if ((lane & 3) == 0) {
            gp[(size_t)row0 * 16 + gi] = r0 + bb; gp[(size_t)(row0 + 1) * 16 + gi] = r1 + bb;
        }
    }
#undef P1_LOAD
}

__device__ __forceinline__ void phase3(const P& p, char* smem) {
    const int tid = tidx(), wid = tid >> 6, lane = tid & 63, fr = lane & 15, fq = lane >> 4;
    char* KT = smem;
    char* KTWf = smem + 17408;
    char* KTWb = smem + 2 * 17408;
    char* VT = smem + 3 * 17408;
    float* sc = (float*)(smem + 3 * 17408 + 34816);
    float *li_f = sc, *lf_f = sc + 128, *li_b = sc + 256, *lf_b = sc + 384, *bfa = sc + 512, *rba = sc + 640, *wf = sc + 768, *wb = sc + 896, *red = sc + 1024;
    const bf16_t* Kb = (const bf16_t*)(p.ws + WS_K); const bf16_t* V = (const bf16_t*)(p.ws + WS_V);
    const float* gp = (const float*)(p.ws + WS_GP);
    bf16_t* Cloc = (bf16_t*)(p.ws + WS_CLOC); float* Nloc = (float*)(p.ws + WS_NLOC); float* Scal = (float*)(p.ws + WS_SCAL);
    const int nitems = NB * NH * NCH;
    u32x4 rk[2], rv[4]; float rg[4];
#define P3_LOAD(it_) do { const int s_ = (it_) / (NH * NCH), h_ = ((it_) / NCH) % NH, r0_ = seq_row0(s_, (it_) % NCH); const int pr_ = tid >> 2; \
        const bf16_t* ks_ = Kb + (size_t)(r0_ + pr_) * 256 + h_ * 64 + (tid & 3) * 16; rk[0] = *(const u32x4*)ks_; rk[1] = *(const u32x4*)(ks_ + 8); \
        const bf16_t* vs_ = V + (size_t)(r0_ + pr_) * 512 + h_ * 128 + (tid & 3) * 32; _Pragma("unroll") for (int q = 0; q < 4; ++q) rv[q] = *(const u32x4*)(vs_ + 8 * q); \
        if (tid < 128) { const f32x4* g_ = (const f32x4*)(gp + (size_t)(r0_ + tid) * 16); const f32x4 g0 = g_[0], g1 = g_[1], g2 = g_[2], g3 = g_[3]; rg[0] = g0[h_]; rg[1] = g1[h_]; rg[2] = g2[h_]; rg[3] = g3[h_]; } } while (0)
    if ((int)blockIdx.x < nitems) P3_LOAD(blockIdx.x);
    for (int it = blockIdx.x; it < nitems; it += gridDim.x) {
        const int s = it / (NH * NCH), h = (it / NCH) % NH, cid = it % NCH;
        __syncthreads();
        {
            const int pr = tid >> 2, kc = (tid & 3) * 16, vc = (tid & 3) * 32;
            const unsigned w[8] = {rk[0].x, rk[0].y, rk[0].z, rk[0].w, rk[1].x, rk[1].y, rk[1].z, rk[1].w};
#pragma unroll
            for (int i = 0; i < 8; ++i) { *(bf16_t*)(KT + (kc + 2 * i) * 272 + pr * 2) = (bf16_t)(w[i] & 0xffff); *(bf16_t*)(KT + (kc + 2 * i + 1) * 272 + pr * 2) = (bf16_t)(w[i] >> 16); }
#pragma unroll
            for (int q = 0; q < 4; ++q) {
                const unsigned wv[4] = {rv[q].x, rv[q].y, rv[q].z, rv[q].w};
#pragma unroll
                for (int i = 0; i < 4; ++i) { *(bf16_t*)(VT + (vc + 8 * q + 2 * i) * 272 + pr * 2) = (bf16_t)(wv[i] & 0xffff); *(bf16_t*)(VT + (vc + 8 * q + 2 * i + 1) * 272 + pr * 2) = (bf16_t)(wv[i] >> 16); }
            }
            if (tid < 128) { li_f[tid] = rg[0]; lf_f[tid] = logsigmoidf_(rg[1]); li_b[tid] = rg[2]; lf_b[tid] = logsigmoidf_(rg[3]); }
        }
        { const int nx = it + gridDim.x; if (nx < nitems) P3_LOAD(nx); }
        __syncthreads();
        if (wid == 0) {
            const float x0 = lf_f[2 * lane], x1 = lf_f[2 * lane + 1];
            const float sc_ = wscan_up_add(x0 + x1, lane);
            const float btot = __shfl(sc_, 63);
            const float g0 = btot - (sc_ - x1) + li_f[2 * lane], g1 = btot - sc_ + li_f[2 * lane + 1];
            const float mx = wave_max(fmaxf(g0, g1));
            *(f32x2_t*)(wf + 2 * lane) = (f32x2_t){__expf(g0 - mx), __expf(g1 - mx)};
            if (lane == 0) { red[0] = mx; bfa[127] = btot; }
        } else if (wid == 1) {
            const float x0 = lf_b[2 * lane], x1 = lf_b[2 * lane + 1];
            const float sc_ = wscan_down_add(x0 + x1, lane);
            const float btot = __shfl(sc_, 0);
            const float g0 = btot - sc_ + li_b[2 * lane], g1 = btot - (sc_ - x0) + li_b[2 * lane + 1];
            const float mx = wave_max(fmaxf(g0, g1));
            *(f32x2_t*)(wb + 2 * lane) = (f32x2_t){__expf(g0 - mx), __expf(g1 - mx)};
            if (lane == 0) { red[1] = mx; rba[0] = btot; }
        }
        __syncthreads();
        const int chain_f = (s * NH + h) * 2, chain_b = chain_f + 1;
#pragma unroll
        for (int rep = 0; rep < 2; ++rep) {
            const int i = tid + rep * NTHREADS, k = i >> 4, p8 = i & 15;
            const u32x4 kv = *(const u32x4*)(KT + k * 272 + p8 * 16);
            const f32x4 f0 = *(const f32x4*)(wf + 8 * p8), f1 = *(const f32x4*)(wf + 8 * p8 + 4), b0 = *(const f32x4*)(wb + 8 * p8), b1 = *(const f32x4*)(wb + 8 * p8 + 4);
            const float e[8] = {__uint_as_float(kv.x << 16), __uint_as_float(kv.x & 0xffff0000u), __uint_as_float(kv.y << 16), __uint_as_float(kv.y & 0xffff0000u),
                                __uint_as_float(kv.z << 16), __uint_as_float(kv.z & 0xffff0000u), __uint_as_float(kv.w << 16), __uint_as_float(kv.w & 0xffff0000u)};
            u32x4 of, ob;
            of.x = g8::cvt_pk_bf16(e[0] * f0[0], e[1] * f0[1]); of.y = g8::cvt_pk_bf16(e[2] * f0[2], e[3] * f0[3]); of.z = g8::cvt_pk_bf16(e[4] * f1[0], e[5] * f1[1]); of.w = g8::cvt_pk_bf16(e[6] * f1[2], e[7] * f1[3]);
            ob.x = g8::cvt_pk_bf16(e[0] * b0[0], e[1] * b0[1]); ob.y = g8::cvt_pk_bf16(e[2] * b0[2], e[3] * b0[3]); ob.z = g8::cvt_pk_bf16(e[4] * b1[0], e[5] * b1[1]); ob.w = g8::cvt_pk_bf16(e[6] * b1[2], e[7] * b1[3]);
            *(u32x4*)(KTWf + k * 272 + p8 * 16) = of; *(u32x4*)(KTWb + k * 272 + p8 * 16) = ob;
            float nf = ((e[0] * f0[0] + e[1] * f0[1]) + (e[2] * f0[2] + e[3] * f0[3])) + ((e[4] * f1[0] + e[5] * f1[1]) + (e[6] * f1[2] + e[7] * f1[3]));
            float nb = ((e[0] * b0[0] + e[1] * b0[1]) + (e[2] * b0[2] + e[3] * b0[3])) + ((e[4] * b1[0] + e[5] * b1[1]) + (e[6] * b1[2] + e[7] * b1[3]));
            nf += dpp_get<0xB1, 0xf>(0.f, nf); nb += dpp_get<0xB1, 0xf>(0.f, nb);
            nf += dpp_get<0x4E, 0xf>(0.f, nf); nb += dpp_get<0x4E, 0xf>(0.f, nb);
            nf += dpp_get<0x141, 0xf>(0.f, nf); nb += dpp_get<0x141, 0xf>(0.f, nb);
            nf += dpp_get<0x140, 0xf>(0.f, nf); nb += dpp_get<0x140, 0xf>(0.f, nb);
            if (p8 == 0) { Nloc[((size_t)chain_f * NCH + cid) * 64 + k] = nf; Nloc[((size_t)chain_b * NCH + cid) * 64 + k] = nb; }
        }
        if (tid == 0) {
            Scal[((size_t)chain_f * NCH + cid) * 2 + 0] = red[0]; Scal[((size_t)chain_f * NCH + cid) * 2 + 1] = bfa[127];
            Scal[((size_t)chain_b * NCH + cid) * 2 + 0] = red[1]; Scal[((size_t)chain_b * NCH + cid) * 2 + 1] = rba[0];
        }
        __syncthreads();
#pragma unroll
        for (int dir = 0; dir < 2; ++dir) {
            const char* KW = dir ? KTWb : KTWf;
            f32x4 acc[4];
#pragma unroll
            for (int n = 0; n < 4; ++n) acc[n] = (f32x4){0.f, 0.f, 0.f, 0.f};
#pragma unroll
            for (int ks = 0; ks < 4; ++ks) {
                const bf16x8 a = *(const bf16x8*)(VT + (16 * wid + fr) * 272 + (32 * ks + 8 * fq) * 2);
#pragma unroll
                for (int n = 0; n < 4; ++n) { const bf16x8 b = *(const bf16x8*)(KW + (16 * n + fr) * 272 + (32 * ks + 8 * fq) * 2); acc[n] = __builtin_amdgcn_mfma_f32_16x16x32_bf16(b, a, acc[n], 0, 0, 0); }
            }
            bf16_t* dst = Cloc + ((size_t)(chain_f + dir) * NCH + cid) * 8192 + (16 * wid + fr) * 64;
#pragma unroll
            for (int n = 0; n < 4; ++n) { u32x2 o; o.x = pk2_sw(acc[n][0], acc[n][1]); o.y = pk2_sw(acc[n][2], acc[n][3]); *(u32x2*)(dst + 16 * n + 4 * fq) = o; }
        }
    }
#undef P3_LOAD
}

__device__ __forceinline__ void phase4(const P& p, char* smem) {
    const int tid = tidx();
    const bf16_t* Cloc = (const bf16_t*)(p.ws + WS_CLOC); const float* Nloc = (const float*)(p.ws + WS_NLOC); const float* Scal = (const float*)(p.ws + WS_SCAL);
    bf16_t* Cprev = (bf16_t*)(p.ws + WS_CPREV); float* Nprev = (float*)(p.ws + WS_NPREV); float* Mprev = (float*)(p.ws + WS_MPREV);
    float* sl = (float*)smem;
    for (int it = blockIdx.x; it < 32 * 8; it += gridDim.x) {
        const int chain = it >> 3, slice = it & 7, dir = chain & 1;
        __syncthreads();
        for (int i = tid; i < NCH * 2; i += NTHREADS) sl[i] = Scal[(size_t)chain * NCH * 2 + i];
        __syncthreads();
        const int e0 = slice * 1024 + tid * 2;
        float c0 = 0.f, c1 = 0.f, nn = 0.f, m = 0.f;
        const bool do_n = (slice == 0 && tid < 64);
        float l0[2][11], l1[2][11], ln[2][11];
#define SCAN_LOAD(buf, st0_) do { _Pragma("unroll") for (int i = 0; i < 11; ++i) { \
            const int st = (st0_) + i, cid = dir == 0 ? st : (st < 2 ? 1 - st : NCH + 1 - st); \
            const unsigned v = *(const unsigned*)(Cloc + ((size_t)chain * NCH + cid) * 8192 + e0); l0[buf][i] = __uint_as_float(v << 16); l1[buf][i] = __uint_as_float(v & 0xffff0000u); \
            ln[buf][i] = do_n ? Nloc[((size_t)chain * NCH + cid) * 64 + tid] : 0.f; } } while (0)
#define SCAN_STEP(buf, st0_) do { _Pragma("unroll") for (int i = 0; i < 11; ++i) { \
            const int st = (st0_) + i, cid = dir == 0 ? st : (st < 2 ? 1 - st : NCH + 1 - st); \
            if (cid >= 2) { const size_t o = (size_t)chain * 64 + (cid - 2); *(unsigned*)(Cprev + o * 8192 + e0) = pk2(c0, c1); if (do_n) Nprev[o * 64 + tid] = nn; if (slice == 0 && tid == 0) Mprev[o] = m; } \
            const float ml = sl[cid * 2 + 0], bt = sl[cid * 2 + 1]; \
            const float mnew = fmaxf(bt + m, ml), a = __expf(bt + m - mnew), e = __expf(ml - mnew); \
            c0 = a * c0 + e * l0[buf][i]; c1 = a * c1 + e * l1[buf][i]; nn = a * nn + e * ln[buf][i]; m = mnew; } } while (0)
        SCAN_LOAD(0, 0);
#pragma unroll 1
        for (int st0 = 0; st0 < NCH; st0 += 22) {
            SCAN_LOAD(1, st0 + 11);
            SCAN_STEP(0, st0);
            if (st0 + 22 < NCH) SCAN_LOAD(0, st0 + 22);
            SCAN_STEP(1, st0 + 11);
        }
#undef SCAN_LOAD
#undef SCAN_STEP
    }
}

struct MlstmRegs { u32x4 q[2], k[2], cf[2], cb[2], v[4]; float g[4]; float np, mpf, mpb; };
__device__ __forceinline__ void mlstm_load(const P& p, int it, MlstmRegs& R) {
    const int tid = tidx();
    const int b = it >> 8, h = (it >> 6) & 3, c = it & 63, row0 = b * T + c * 128;
    const bf16_t* Q = (const bf16_t*)(p.ws + WS_Q); const bf16_t* Kb = (const bf16_t*)(p.ws + WS_K); const bf16_t* V = (const bf16_t*)(p.ws + WS_V);
    const float* gp = (const float*)(p.ws + WS_GP);
    const bf16_t* Cprev = (const bf16_t*)(p.ws + WS_CPREV); const float* Nprev = (const float*)(p.ws + WS_NPREV); const float* Mprev = (const float*)(p.ws + WS_MPREV);
    const int chain_f = (b * NH + h) * 2;
    const size_t of = (size_t)chain_f * 64 + c, ob = (size_t)(chain_f + 1) * 64 + c;
    const int pr = tid >> 2, kc = (tid & 3) * 16, vc = (tid & 3) * 32;
    const bf16_t* qs = Q + (size_t)(row0 + pr) * 256 + h * 64 + kc; const bf16_t* ks = Kb + (size_t)(row0 + pr) * 256 + h * 64 + kc;
    const bf16_t* cfs = Cprev + of * 8192 + pr * 64 + kc; const bf16_t* cbs = Cprev + ob * 8192 + pr * 64 + kc;
    const bf16_t* vs = V + (size_t)(row0 + pr) * 512 + h * 128 + vc;
    R.q[0] = *(const u32x4*)qs; R.q[1] = *(const u32x4*)(qs + 8); R.k[0] = *(const u32x4*)ks; R.k[1] = *(const u32x4*)(ks + 8);
    R.cf[0] = *(const u32x4*)cfs; R.cf[1] = *(const u32x4*)(cfs + 8); R.cb[0] = *(const u32x4*)cbs; R.cb[1] = *(const u32x4*)(cbs + 8);
#pragma unroll
    for (int q = 0; q < 4; ++q) R.v[q] = *(const u32x4*)(vs + 8 * q);
    if (tid < 128) { const f32x4* g = (const f32x4*)(gp + (size_t)(row0 + tid) * 16); const f32x4 g0 = g[0], g1 = g[1], g2 = g[2], g3 = g[3]; R.g[0] = g0[h]; R.g[1] = g1[h]; R.g[2] = g2[h]; R.g[3] = g3[h]; }
    else if (tid < 192) R.np = Nprev[of * 64 + tid - 128];
    else if (tid < 256) R.np = Nprev[ob * 64 + tid - 192];
    R.mpf = Mprev[of]; R.mpb = Mprev[ob];
}
__device__ __forceinline__ void mlstm_item(const P& p, int it, char* smem, const MlstmRegs& R) {
    const int tid = tidx(), wid = tid >> 6, lane = tid & 63, fr = lane & 15, fq = lane >> 4;
    const int b = it >> 8, h = (it >> 6) & 3, c = it & 63;
    const int row0 = b * T + c * 128;
    char* Qs = smem;
    char* Ks = smem + 18432;
    char* Cf = smem + 2 * 18432;
    char* Cb = smem + 3 * 18432;
    char* VT = smem + 4 * 18432;
    char* Ps = VT + 34816;
    float* sc = (float*)(Ps + 34816);
    float *li_f = sc, *lf_f = sc + 128, *li_b = sc + 256, *lf_b = sc + 384, *beta_f = sc + 768, *beta_b = sc + 896,
          *alpha_f = sc + 1024, *alpha_b = sc + 1152, *eint_f = sc + 1280, *eint_b = sc + 1408, *emm_f = sc + 1536, *emm_b = sc + 1664, *nq_f = sc + 1792, *nq_b = sc + 1920,
          *cfa = sc + 2048, *cba = sc + 2176, *npf = sc + 2304, *npb = sc + 2368;
    const bf16_t* SO = (const bf16_t*)(p.ws + WS_SO);
    unsigned char* mix = (unsigned char*)(p.ws + WS_MIX);
    {
        const int pr = tid >> 2, kc = (tid & 3) * 16, vc = (tid & 3) * 32;
        *(u32x4*)(Qs + pr * 144 + kc * 2) = R.q[0]; *(u32x4*)(Qs + pr * 144 + kc * 2 + 16) = R.q[1];
        *(u32x4*)(Ks + pr * 144 + kc * 2) = R.k[0]; *(u32x4*)(Ks + pr * 144 + kc * 2 + 16) = R.k[1];
        *(u32x4*)(Cf + pr * 144 + kc * 2) = R.cf[0]; *(u32x4*)(Cf + pr * 144 + kc * 2 + 16) = R.cf[1];
        *(u32x4*)(Cb + pr * 144 + kc * 2) = R.cb[0]; *(u32x4*)(Cb + pr * 144 + kc * 2 + 16) = R.cb[1];
#pragma unroll
        for (int q = 0; q < 4; ++q) {
            const unsigned w[4] = {R.v[q].x, R.v[q].y, R.v[q].z, R.v[q].w};
#pragma unroll
            for (int i = 0; i < 4; ++i) { *(bf16_t*)(VT + (vc + 8 * q + 2 * i) * 272 + pr * 2) = (bf16_t)(w[i] & 0xffff); *(bf16_t*)(VT + (vc + 8 * q + 2 * i + 1) * 272 + pr * 2) = (bf16_t)(w[i] >> 16); }
        }
        if (tid < 128) { li_f[tid] = R.g[0]; lf_f[tid] = logsigmoidf_(R.g[1]); li_b[tid] = R.g[2]; lf_b[tid] = logsigmoidf_(R.g[3]); }
        else if (tid < 192) npf[tid - 128] = R.np;
        else if (tid < 256) npb[tid - 192] = R.np;
    }
    const float mpf = R.mpf, mpb = R.mpb;
    __syncthreads();
    if (wid == 0) {
        const float x0 = lf_f[2 * lane], x1 = lf_f[2 * lane + 1];
        const float sc_ = wscan_up_add(x0 + x1, lane);
        const float b0 = sc_ - x1, b1 = sc_;
        const float be0 = li_f[2 * lane] - b0, be1 = li_f[2 * lane + 1] - b1;
        const float msc = wscan_up_max(fmaxf(be0, be1), lane);
        float ex = __shfl_up(msc, 1); if (lane == 0) ex = -INFINITY;
        const float pm0 = fmaxf(ex, be0), pm1 = msc;
        const float a0 = b0 + mpf, a1 = b1 + mpf, m0 = fmaxf(a0, b0 + pm0), m1 = fmaxf(a1, b1 + pm1);
        *(f32x2_t*)(beta_f + 2 * lane) = (f32x2_t){be0, be1};
        *(f32x2_t*)(alpha_f + 2 * lane) = (f32x2_t){b0 - m0, b1 - m1};
        *(f32x2_t*)(eint_f + 2 * lane) = (f32x2_t){__expf(a0 - m0), __expf(a1 - m1)};
        *(f32x2_t*)(emm_f + 2 * lane) = (f32x2_t){__expf(-m0), __expf(-m1)};
    } else if (wid == 1) {
        const float x0 = lf_b[2 * lane], x1 = lf_b[2 * lane + 1];
        const float sc_ = wscan_down_add(x0 + x1, lane);
        const float b0 = sc_, b1 = sc_ - x0;
        const float be0 = li_b[2 * lane] - b0, be1 = li_b[2 * lane + 1] - b1;
        const float msc = wscan_down_max(fmaxf(be0, be1), lane);
        float ex = __shfl_down(msc, 1); if (lane == 63) ex = -INFINITY;
        const float pm1 = fmaxf(ex, be1), pm0 = msc;
        const float a0 = b0 + mpb, a1 = b1 + mpb, m0 = fmaxf(a0, b0 + pm0), m1 = fmaxf(a1, b1 + pm1);
        *(f32x2_t*)(beta_b + 2 * lane) = (f32x2_t){be0, be1};
        *(f32x2_t*)(alpha_b + 2 * lane) = (f32x2_t){b0 - m0, b1 - m1};
        *(f32x2_t*)(eint_b + 2 * lane) = (f32x2_t){__expf(a0 - m0), __expf(a1 - m1)};
        *(f32x2_t*)(emm_b + 2 * lane) = (f32x2_t){__expf(-m0), __expf(-m1)};
    } else if (wid < 4) {
        const int t = tid - 128; float a = 0.f, bsum = 0.f;
#pragma unroll
        for (int k8 = 0; k8 < 8; ++k8) {
            const u32x4 qv = *(const u32x4*)(Qs + t * 144 + k8 * 16);
            const float q[8] = {__uint_as_float(qv.x << 16), __uint_as_float(qv.x & 0xffff0000u), __uint_as_float(qv.y << 16), __uint_as_float(qv.y & 0xffff0000u),
                                __uint_as_float(qv.z << 16), __uint_as_float(qv.z & 0xffff0000u), __uint_as_float(qv.w << 16), __uint_as_float(qv.w & 0xffff0000u)};
#pragma unroll
            for (int c = 0; c < 8; ++c) { a += npf[8 * k8 + c] * q[c]; bsum += npb[8 * k8 + c] * q[c]; }
        }
        nq_f[t] = a; nq_b[t] = bsum;
    }
    __syncthreads();
    {
        f32x4 acc[8];
#pragma unroll
        for (int n = 0; n < 8; ++n) acc[n] = (f32x4){0.f, 0.f, 0.f, 0.f};
#pragma unroll
        for (int ks = 0; ks < 2; ++ks) {
            const bf16x8 a = *(const bf16x8*)(Qs + (16 * wid + fr) * 144 + (32 * ks + 8 * fq) * 2);
#pragma unroll
            for (int n = 0; n < 8; ++n) { const bf16x8 bb = *(const bf16x8*)(Ks + (16 * n + fr) * 144 + (32 * ks + 8 * fq) * 2); acc[n] = __builtin_amdgcn_mfma_f32_16x16x32_bf16(bb, a, acc[n], 0, 0, 0); }
        }
        const int t = 16 * wid + fr;
        const float af = alpha_f[t], ab = alpha_b[t];
        float rsf = 0.f, rsb = 0.f;
        f32x4 sf[8], sb[8];
        const int widu = __builtin_amdgcn_readfirstlane(wid);
#pragma unroll
        for (int n = 0; n < 8; ++n) {
            sf[n] = (f32x4){0.f, 0.f, 0.f, 0.f}; sb[n] = sf[n];
            if (n <= widu) {
                const f32x4 bf4 = *(const f32x4*)(beta_f + 16 * n + 4 * fq);
#pragma unroll
                for (int j = 0; j < 4; ++j) { const int s = 16 * n + 4 * fq + j; const float vf = s <= t ? acc[n][j] * __expf(af + bf4[j]) : 0.f; sf[n][j] = vf; rsf += vf; }
            }
            if (n >= widu) {
                const f32x4 bb4 = *(const f32x4*)(beta_b + 16 * n + 4 * fq);
#pragma unroll
                for (int j = 0; j < 4; ++j) { const int s = 16 * n + 4 * fq + j; const float vb = s >= t ? acc[n][j] * __expf(ab + bb4[j]) : 0.f; sb[n][j] = vb; rsb += vb; }
            }
        }
        rsf = fq_sum(rsf); rsb = fq_sum(rsb);
        const float denf = rsf + eint_f[t] * nq_f[t], denb = rsb + eint_b[t] * nq_b[t];
        const float rf = 1.0f / fmaxf(fabsf(denf), emm_f[t]), rb = 1.0f / fmaxf(fabsf(denb), emm_b[t]);
        if (fq == 0) { cfa[t] = eint_f[t] * rf; cba[t] = eint_b[t] * rb; }
#pragma unroll
        for (int n = 0; n < 8; ++n) {
            const f32x4 pv = rf * sf[n] + rb * sb[n];
            u32x2 o; o.x = g8::cvt_pk_bf16(pv[0], pv[1]); o.y = g8::cvt_pk_bf16(pv[2], pv[3]);
            *(u32x2*)(Ps + t * 272 + (16 * n + 4 * fq) * 2) = o;
        }
    }
    __syncthreads();
    {
        f32x4 aP[8], aT[8];
        const int t = 16 * wid + fr;
        const float cf = cfa[t], cb = cba[t];
        u32x2 sov[8];
#pragma unroll
        for (int n = 0; n < 8; ++n) sov[n] = *(const u32x2*)(SO + ((size_t)row0 + t) * 512 + h * 128 + 16 * n + 4 * fq);
#pragma unroll
        for (int n = 0; n < 8; ++n) aT[n] = (f32x4){0.f, 0.f, 0.f, 0.f};
#pragma unroll
        for (int ks = 0; ks < 2; ++ks) {
            const bf16x8 a = *(const bf16x8*)(Qs + (16 * wid + fr) * 144 + (32 * ks + 8 * fq) * 2);
#pragma unroll
            for (int n = 0; n < 8; ++n) { const bf16x8 b1 = *(const bf16x8*)(Cf + (16 * n + fr) * 144 + (32 * ks + 8 * fq) * 2); aT[n] = __builtin_amdgcn_mfma_f32_16x16x32_bf16(b1, a, aT[n], 0, 0, 0); }
        }
#pragma unroll
        for (int n = 0; n < 8; ++n) { aP[n] = cf * aT[n]; aT[n] = (f32x4){0.f, 0.f, 0.f, 0.f}; }
#pragma unroll
        for (int ks = 0; ks < 2; ++ks) {
            const bf16x8 a = *(const bf16x8*)(Qs + (16 * wid + fr) * 144 + (32 * ks + 8 * fq) * 2);
#pragma unroll
            for (int n = 0; n < 8; ++n) { const bf16x8 b2 = *(const bf16x8*)(Cb + (16 * n + fr) * 144 + (32 * ks + 8 * fq) * 2); aT[n] = __builtin_amdgcn_mfma_f32_16x16x32_bf16(b2, a, aT[n], 0, 0, 0); }
        }
#pragma unroll
        for (int n = 0; n < 8; ++n) aP[n] = aP[n] + cb * aT[n];
#pragma unroll 1
        for (int ks = 0; ks < 4; ++ks) {
            const bf16x8 a = *(const bf16x8*)(Ps + (16 * wid + fr) * 272 + (32 * ks + 8 * fq) * 2);
#pragma unroll
            for (int n = 0; n < 8; ++n) { const bf16x8 bb = *(const bf16x8*)(VT + (16 * n + fr) * 272 + (32 * ks + 8 * fq) * 2); aP[n] = __builtin_amdgcn_mfma_f32_16x16x32_bf16(bb, a, aP[n], 0, 0, 0); }
        }
        float ss = 0.f;
#pragma unroll
        for (int n = 0; n < 8; ++n) ss += aP[n][0] * aP[n][0] + aP[n][1] * aP[n][1] + aP[n][2] * aP[n][2] + aP[n][3] * aP[n][3];
        ss = fq_sum(ss);
        const float inv = rsqrtf(ss * (1.0f / 128.0f) + EPS);
        const size_t row = (size_t)row0 + t;
#pragma unroll
        for (int n = 0; n < 8; ++n) {
            const int v = 16 * n + 4 * fq;
            const f32x4 g = *(const f32x4*)((const float*)(smem + 153600) + h * 128 + v);
            const u32x2 so = sov[n];
            const float s0 = __uint_as_float(so.x << 16), s1 = __uint_as_float(so.x & 0xffff0000u), s2 = __uint_as_float(so.y << 16), s3 = __uint_as_float(so.y & 0xffff0000u);
            *(unsigned*)(mix + row * 1024 + h * 128 + v) = pk4_fp8((f32x4){aP[n][0] * inv * g[0] * s0, aP[n][1] * inv * g[1] * s1, aP[n][2] * inv * g[2] * s2, aP[n][3] * inv * g[3] * s3} * MIX_SCALE);
        }
    }
}

__device__ __forceinline__ void conv_load(const P& p, int it, u32x4 (&U8)[8]) {
    const bf16_t* U = (const bf16_t*)(p.ws + WS_U) + (size_t)it * 64 * 512;
    const int tid = tidx();
#pragma unroll
    for (int i = 0; i < 8; ++i) U8[i] = *(const u32x4*)(U + (size_t)(tid + 512 * i) * 8);
}
__device__ __forceinline__ void conv_stage(char* smem, const u32x4 (&U8)[8]) {
    const int tid = tidx();
    char* ul = smem + 1024 + 15 * 1024;
#pragma unroll
    for (int i = 0; i < 8; ++i) *(u32x4*)(ul + (size_t)(tid + 512 * i) * 16) = U8[i];
}
__device__ __forceinline__ void conv_item(const P& p, int it, char* smem, const f32x2_t (&w2)[16], const f32x2_t (&w2b)[16], const float cb, const float lg, const float lb) {
    const int tid = tidx(), lane = tid & 63;
    const int row0 = it * 64;
    unsigned char* mix = (unsigned char*)(p.ws + WS_MIX);
    float* stat = (float*)smem;
    const bf16_t* up = (const bf16_t*)(smem + 1024);
    bf16_t* yl = (bf16_t*)(smem + 1024 + 94 * 1024);
    const int ch = tid;
    __syncthreads();
#pragma unroll 1
    for (int g = 0; g < 4; ++g) {
        f32x2_t ua[23];
#pragma unroll
        for (int k = 0; k < 23; ++k) {
            const float e0 = bf2f(up[(16 * g + 2 * k) * 512 + ch]), e1 = bf2f(up[(16 * g + 2 * k + 1) * 512 + ch]);
            ua[k][0] = e0; ua[k][1] = e1;
        }
#pragma unroll
        for (int e = 0; e < 8; ++e) {
            f32x2_t a0 = (f32x2_t){cb, 0.f}, a1 = a0;
#pragma unroll
            for (int k = 0; k < 16; ++k) { a0 = __builtin_elementwise_fma(w2[k], ua[e + k], a0); a1 = __builtin_elementwise_fma(w2b[k], ua[e + k], a1); }
            yl[(16 * g + 2 * e) * 512 + ch] = f2bf(a0[0] + a0[1]);
            yl[(16 * g + 2 * e + 1) * 512 + ch] = f2bf(a1[0] + a1[1]);
        }
    }
    __syncthreads();
    {
        const int pp = tid >> 3, sub = tid & 7;
        float s1 = 0.f, s2 = 0.f;
#pragma unroll
        for (int i = 0; i < 8; ++i) {
            const u32x4 v = *(const u32x4*)(yl + pp * 512 + sub * 64 + 8 * ((i + lane) & 7));
            const unsigned wv[4] = {v.x, v.y, v.z, v.w};
#pragma unroll
            for (int c = 0; c < 4; ++c) { const float lo = __uint_as_float(wv[c] << 16), hi = __uint_as_float(wv[c] & 0xffff0000u); s1 += lo + hi; s2 += lo * lo + hi * hi; }
        }
        s1 += dpp_get<0xB1, 0xf>(0.f, s1); s2 += dpp_get<0xB1, 0xf>(0.f, s2); s1 += dpp_get<0x4E, 0xf>(0.f, s1); s2 += dpp_get<0x4E, 0xf>(0.f, s2);
        s1 += dpp_get<0x141, 0xf>(0.f, s1); s2 += dpp_get<0x141, 0xf>(0.f, s2);
        if (sub == 0) { const float mu = s1 * (1.0f / 512.0f), var = fmaxf(s2 * (1.0f / 512.0f) - mu * mu, 0.f); stat[pp * 2] = mu; stat[pp * 2 + 1] = rsqrtf(var + EPS); }
    }
    __syncthreads();
#pragma unroll 8
    for (int pp = 0; pp < 64; ++pp) {
        const float z = (bf2f(yl[pp * 512 + ch]) - stat[pp * 2]) * stat[pp * 2 + 1] * lg + lb;
        yl[pp * 512 + ch] = f2bf(silu_fast(z));
    }
    __syncthreads();
#pragma unroll
    for (int i = 0; i < 4; ++i) {
        const int q = tid + 512 * i, pp = q >> 5, c16 = (q & 31) * 16;
        const u32x4 a = *(const u32x4*)(yl + pp * 512 + c16), b = *(const u32x4*)(yl + pp * 512 + c16 + 8);
        const unsigned w[8] = {a.x, a.y, a.z, a.w, b.x, b.y, b.z, b.w};
        u32x4 o;
        o.x = pk4_fp8((f32x4){__uint_as_float(w[0] << 16), __uint_as_float(w[0] & 0xffff0000u), __uint_as_float(w[1] << 16), __uint_as_float(w[1] & 0xffff0000u)} * MIX_SCALE);
        o.y = pk4_fp8((f32x4){__uint_as_float(w[2] << 16), __uint_as_float(w[2] & 0xffff0000u), __uint_as_float(w[3] << 16), __uint_as_float(w[3] & 0xffff0000u)} * MIX_SCALE);
        o.z = pk4_fp8((f32x4){__uint_as_float(w[4] << 16), __uint_as_float(w[4] & 0xffff0000u), __uint_as_float(w[5] << 16), __uint_as_float(w[5] & 0xffff0000u)} * MIX_SCALE);
        o.w = pk4_fp8((f32x4){__uint_as_float(w[6] << 16), __uint_as_float(w[6] & 0xffff0000u), __uint_as_float(w[7] << 16), __uint_as_float(w[7] & 0xffff0000u)} * MIX_SCALE);
        *(u32x4*)(mix + (size_t)(row0 + pp) * 1024 + 512 + c16) = o;
    }
}

__device__ __forceinline__ void phase5(const P& p, char* smem) {
    {
        MlstmRegs R;
        int it = blockIdx.x;
        if (it < 1024) mlstm_load(p, it, R);
        { float* ng = (float*)(smem + 153600); const int t = tidx(); if (t < NH * 128) ng[t] = p.norm_g[t]; }
        for (; it < 1024; it += gridDim.x) {
            __syncthreads();
            const MlstmRegs C = R;
            const int nx = it + gridDim.x;
            if (nx < 1024) mlstm_load(p, nx, R);
            mlstm_item(p, it, smem, C);
        }
    }
    {
        u32x4 U8[8];
        int it = blockIdx.x;
        const int ch = tidx();
        f32x2_t w2[16];
#pragma unroll
        for (int k = 0; k < 16; ++k) { w2[k][0] = p.conv_w[(2 * k) * 512 + ch]; w2[k][1] = (2 * k + 1 < 31) ? p.conv_w[(2 * k + 1) * 512 + ch] : 0.f; }
        f32x2_t w2b[16];
#pragma unroll
        for (int k = 0; k < 16; ++k) { w2b[k][0] = k > 0 ? p.conv_w[(2 * k - 1) * 512 + ch] : 0.f; w2b[k][1] = p.conv_w[(2 * k) * 512 + ch]; }
        const float cb = p.conv_b[ch], lg = p.ln_g[ch], lb = p.ln_b[ch];
        if (it < 512) conv_load(p, it, U8);
        __syncthreads();
#pragma unroll
        for (int i = 0; i < 15; ++i) { ((bf16_t*)(smem + 1024))[i * 512 + ch] = 0; ((bf16_t*)(smem + 1024 + 79 * 1024))[i * 512 + ch] = 0; }
        for (; it < 512; it += gridDim.x) {
            __syncthreads();
            conv_stage(smem, U8);
            const int nx = it + gridDim.x;
            if (nx < 512) conv_load(p, nx, U8);
            conv_item(p, it, smem, w2, w2b, cb, lg, lb);
        }
    }
}

__device__ __forceinline__ void phase7(const P& p, char* smem) {
    const int tid = tidx(), wid = tid >> 6, lane = tid & 63, fr = lane & 15, fq = lane >> 4;
    float* H = (float*)smem;
    float* LP = (float*)(smem + 65792);
    float* modl = (float*)(smem + 65792 + 32768);
    int* selE = (int*)(smem + 65792 + 32768 + 12288);
    float* selW = (float*)(smem + 65792 + 32768 + 12288 + 4096);
    int* rank = (int*)(smem + 65792 + 32768 + 12288 + 8192);
    int* ebase = (int*)(smem + 65792 + 32768 + 12288 + 12288);
    int* segcnt = ebase + 64;
    int* lcnt = segcnt;
    float* vls = (float*)(segcnt + 512);
    float* gvec = (float*)(smem + 131072);
    const float* modp = (const float*)(p.ws + WS_MODP);
    const bf16_t* yx = (const bf16_t*)(p.ws + WS_YX);
    unsigned char* hx2 = (unsigned char*)(p.ws + WS_HX);
    int* cursor = (int*)(p.ws + WS_CURSOR);
    int* ltok = (int*)(p.ws + WS_LTOK);
    int* slotE = (int*)(p.ws + WS_SLOTE); int* slotP = (int*)(p.ws + WS_SLOTP); float* slotW = (float*)(p.ws + WS_SLOTW);
    bf16x8 bh[4][4];
#pragma unroll
    for (int ks = 0; ks < 4; ++ks)
#pragma unroll
        for (int n = 0; n < 4; ++n) bh[ks][n] = *(const bf16x8*)(p.ws + WS_WRH + (size_t)((((wid * 4 + ks) * 4 + n) * 64 + lane) * 16));
    const float brt = p.b_router[lane];
    u32x4 nyw[2]; f32x4 nxa[2], nxb[2];
#define P7_LOAD(row_) do { const bf16_t* yr_ = yx + (size_t)(row_) * 1024; const float* xr_ = p.x + (size_t)(row_) * 1024; _Pragma("unroll") for (int jj = 0; jj < 2; ++jj) { \
        const int idx_ = 8 * lane + 512 * jj; nyw[jj] = __builtin_nontemporal_load((const u32x4*)(yr_ + idx_)); nxa[jj] = __builtin_nontemporal_load((const f32x4*)(xr_ + idx_)); nxb[jj] = __builtin_nontemporal_load((const f32x4*)(xr_ + idx_ + 4)); } } while (0)
    if ((int)blockIdx.x < NT / 128) P7_LOAD((size_t)blockIdx.x * 128 + 2 * wid);
    { const float a0 = p.g_post_mix[tid], a1 = p.g_post_mix[tid + NTHREADS], a2 = p.g_pre_ffn[tid], a3 = p.g_pre_ffn[tid + NTHREADS]; gvec[tid] = a0; gvec[tid + NTHREADS] = a1; gvec[1024 + tid] = a2; gvec[1024 + tid + NTHREADS] = a3; }
    for (int blk = blockIdx.x; blk < NT / 128; blk += gridDim.x) {
        const int b = (blk * 128) / T;
        __syncthreads();
        if (tidx() < 64) lcnt[tidx()] = 0;
        {
            const int t0 = tidx(); float t[6];
#pragma unroll
            for (int j = 0; j < 6; ++j) { const int i = t0 + j * NTHREADS, which = i >> 10, idx = i & 1023; t[j] = modval(modp, b, (which == 0 ? 2048 : (which == 1 ? 3072 : 4096)) + idx); }
#pragma unroll
            for (int j = 0; j < 6; ++j) modl[t0 + j * NTHREADS] = t[j];
        }
        __syncthreads();
        for (int g = 0; g < 8; ++g) {
#pragma unroll 1
            for (int i = 0; i < 2; ++i) {
                const int lr = 2 * wid + i; const size_t row = (size_t)blk * 128 + g * 16 + lr;
                bf16_t* x1row = (bf16_t*)(p.ws + WS_X1B) + row * 1024;
                float y[16], xv[16]; float ss = 0.f;
#pragma unroll
                for (int jj = 0; jj < 2; ++jj) {
                    const unsigned w[4] = {nyw[jj].x, nyw[jj].y, nyw[jj].z, nyw[jj].w};
#pragma unroll
                    for (int c = 0; c < 4; ++c) { y[8 * jj + 2 * c] = __uint_as_float(w[c] << 16); y[8 * jj + 2 * c + 1] = __uint_as_float(w[c] & 0xffff0000u); xv[8 * jj + c] = nxa[jj][c]; xv[8 * jj + 4 + c] = nxb[jj][c]; }
                }
                {
                    const bool more = !(g == 7 && i == 1) || (blk + (int)gridDim.x < NT / 128);
                    const size_t nrow = i == 0 ? row + 1 : (g < 7 ? row + 15 : (size_t)(blk + gridDim.x) * 128 + 2 * wid);
                    if (more) P7_LOAD(nrow);
                }
#pragma unroll
                for (int c = 0; c < 16; ++c) ss += y[c] * y[c];
                ss = wave_sum(ss);
                const float invy = rsqrtf(ss * (1.0f / 1024.0f) + EPS);
                float s1 = 0.f;
#pragma unroll
                for (int q = 0; q < 4; ++q) {
                    const int idx = 8 * lane + 512 * (q >> 1) + 4 * (q & 1);
                    const f32x4 gt = *(const f32x4*)(modl + idx), gp = *(const f32x4*)(gvec + idx);
#pragma unroll
                    for (int c = 0; c < 4; ++c) { const float v = xv[4 * q + c] + gt[c] * (y[4 * q + c] * invy * gp[c]); xv[4 * q + c] = v; s1 += v * v; }
                }
#pragma unroll
                for (int jj = 0; jj < 2; ++jj) {
                    u32x4 o; o.x = pk2(xv[8 * jj], xv[8 * jj + 1]); o.y = pk2(xv[8 * jj + 2], xv[8 * jj + 3]); o.z = pk2(xv[8 * jj + 4], xv[8 * jj + 5]); o.w = pk2(xv[8 * jj + 6], xv[8 * jj + 7]);
                    *(u32x4*)(x1row + 8 * lane + 512 * jj) = o;
                }
                s1 = wave_sum(s1);
                const float inv1 = rsqrtf(s1 * (1.0f / 1024.0f) + EPS);
#pragma unroll
                for (int jj = 0; jj < 2; ++jj) {
                    const int idx = 8 * lane + 512 * jj;
                    float hv[8];
#pragma unroll
                    for (int h4 = 0; h4 < 2; ++h4) {
                        const f32x4 g2 = *(const f32x4*)(gvec + 1024 + idx + 4 * h4), sh = *(const f32x4*)(modl + 1024 + idx + 4 * h4), sc = *(const f32x4*)(modl + 2048 + idx + 4 * h4);
#pragma unroll
                        for (int c = 0; c < 4; ++c) hv[4 * h4 + c] = xv[8 * jj + 4 * h4 + c] * inv1 * g2[c] * (1.0f + sc[c]) + sh[c];
                        *(f32x4*)(H + lr * 1028 + idx + 4 * h4) = (f32x4){hv[4 * h4], hv[4 * h4 + 1], hv[4 * h4 + 2], hv[4 * h4 + 3]};
                    }
                    u32x2 o; o.x = pk4_fp8((f32x4){hv[0], hv[1], hv[2], hv[3]} * HX2_SCALE); o.y = pk4_fp8((f32x4){hv[4], hv[5], hv[6], hv[7]} * HX2_SCALE);
                    *(u32x2*)(hx2 + row * 1024 + idx) = o;
                }
            }
            bf16x8 bl[4][4];
#define P7_BL(ks_) do { _Pragma("unroll") for (int n = 0; n < 4; ++n) bl[ks_][n] = *(const bf16x8*)(p.ws + WS_WRL + (size_t)((((wid * 4 + (ks_)) * 4 + n) * 64 + lane) * 16)); } while (0)
            P7_BL(0); P7_BL(1);
            __syncthreads();
            {
                f32x4 acc[4];
#pragma unroll
                for (int n = 0; n < 4; ++n) acc[n] = (f32x4){0.f, 0.f, 0.f, 0.f};
#pragma unroll
                for (int ks = 0; ks < 4; ++ks) {
                    if (ks == 1) { __builtin_amdgcn_sched_barrier(0); P7_BL(2); __builtin_amdgcn_sched_barrier(0); }
                    if (ks == 2) { __builtin_amdgcn_sched_barrier(0); P7_BL(3); __builtin_amdgcn_sched_barrier(0); }
                    const f32x4 h0 = *(const f32x4*)(H + fr * 1028 + 128 * wid + 32 * ks + 8 * fq), h1 = *(const f32x4*)(H + fr * 1028 + 128 * wid + 32 * ks + 8 * fq + 4);
                    const unsigned hh[4] = {pk2(h0[0], h0[1]), pk2(h0[2], h0[3]), pk2(h1[0], h1[1]), pk2(h1[2], h1[3])};
                    const unsigned ll[4] = {pk2(h0[0] - __uint_as_float(hh[0] << 16), h0[1] - __uint_as_float(hh[0] & 0xffff0000u)), pk2(h0[2] - __uint_as_float(hh[1] << 16), h0[3] - __uint_as_float(hh[1] & 0xffff0000u)),
                                            pk2(h1[0] - __uint_as_float(hh[2] << 16), h1[1] - __uint_as_float(hh[2] & 0xffff0000u)), pk2(h1[2] - __uint_as_float(hh[3] << 16), h1[3] - __uint_as_float(hh[3] & 0xffff0000u))};
                    u32x4 ahw = (u32x4){hh[0], hh[1], hh[2], hh[3]}, alw = (u32x4){ll[0], ll[1], ll[2], ll[3]};
                    asm volatile("s_nop 1" : "+v"(ahw), "+v"(alw));
                    const bf16x8 ah = __builtin_bit_cast(bf16x8, ahw), al = __builtin_bit_cast(bf16x8, alw);
#pragma unroll
                    for (int n = 0; n < 4; ++n) {
                        acc[n] = __builtin_amdgcn_mfma_f32_16x16x32_bf16(al, bh[ks][n], acc[n], 0, 0, 0);
                        acc[n] = __builtin_amdgcn_mfma_f32_16x16x32_bf16(ah, bl[ks][n], acc[n], 0, 0, 0);
                        acc[n] = __builtin_amdgcn_mfma_f32_16x16x32_bf16(ah, bh[ks][n], acc[n], 0, 0, 0);
                    }
                }
#pragma unroll
                for (int n = 0; n < 4; ++n)
#pragma unroll
                    for (int j = 0; j < 4; ++j) LP[(wid * 16 + 4 * fq + j) * 64 + 16 * n + fr] = acc[n][j];
            }
            __syncthreads();
            {
                float sg[2]; int kbv[2];
#pragma unroll
                for (int i = 0; i < 2; ++i) {
                    const int lr = 2 * wid + i;
                    float lg = 0.f;
#pragma unroll
                    for (int w8 = 0; w8 < 8; ++w8) lg += LP[(w8 * 16 + lr) * 64 + lane];
                    sg[i] = sigmoidf_(lg);
                    const float val = sg[i] + brt;
                    int kb = __float_as_int(val); kb ^= (kb >> 31) & 0x7fffffff; kb = (kb & ~63) | (63 - lane);
                    kbv[i] = kb;
                    ((int*)vls)[(wid * 2 + i) * 64 + lane] = kb;
                }
                asm volatile("s_waitcnt lgkmcnt(0)" ::: "memory");
#pragma unroll
                for (int i = 0; i < 2; ++i) {
                    const int* kl = (const int*)vls + (wid * 2 + i) * 64;
                    const int kb = kbv[i];
                    int rk = 0;
#pragma unroll
                    for (int j4 = 0; j4 < 16; ++j4) {
                        const u32x4 o = *(const u32x4*)(kl + 4 * j4);
                        rk += ((int)o.x > kb ? 1 : 0) + ((int)o.y > kb ? 1 : 0) + ((int)o.z > kb ? 1 : 0) + ((int)o.w > kb ? 1 : 0);
                    }
                    const bool sel = rk < TOPK;
                    const float ssum = wave_sum(sel ? sg[i] : 0.f);
                    const int rr = g * 16 + 2 * wid + i;
                    if (sel) { selE[rr * 8 + rk] = lane; selW[rr * 8 + rk] = sg[i] / ssum * 2.5f; rank[rr * 8 + rk] = atomicAdd(&lcnt[lane], 1); }
                }
            }
        }
        __syncthreads();
        {
            const int t2 = tidx();
            if (t2 < 64) { const int run = lcnt[t2]; ebase[t2] = run > 0 ? atomicAdd(&cursor[t2], run) : 0; }
        }
        __syncthreads();
        for (int i = tidx(); i < 1024; i += NTHREADS) {
            const int e = selE[i], pos = ebase[e] + rank[i];
            const int tokn = blk * 128 + (i >> 3);
            ltok[(size_t)e * LCAP + pos] = tokn;
            slotE[(size_t)tokn * 8 + (i & 7)] = e; slotP[(size_t)tokn * 8 + (i & 7)] = pos; slotW[(size_t)tokn * 8 + (i & 7)] = selW[i];
        }
    }
#undef P7_LOAD
#undef P7_BL
}

__device__ __forceinline__ float sigm(float x) { return __builtin_amdgcn_rcpf(1.0f + __expf(-x)); }

struct SchedDense {
    const char* A; const char* B; int nM, nN, KB;
    __device__ __forceinline__ bool next(int i, g8::Unit& u) const {
        int pm, pn; if (!g8::static_unit(i, nM, nN, pm, pn)) return false;
        u.A = A + (size_t)pm * 256 * KB; u.B = B + (size_t)pn * 256 * KB; u.x0 = pm; u.x1 = pn; u.x2 = 0; u.x3 = 0; return true;
    }
    __device__ __forceinline__ void aoffs(const g8::Unit&, const int (&)[2], const unsigned (&)[2], unsigned (&)[2][2]) const {}
};

struct EpiInProj {
    static constexpr int NST = 0;
    bf16_t *Q, *Kb, *V, *SO, *U; const float* b_in;
    __device__ __forceinline__ void operator()(const f32x4 (&acc)[2][2][4][2], const g8::Unit& u, int wr, int wc, int fr, int fq) const {
        const int pn = u.x1; const size_t row0 = (size_t)u.x0 * 256 + wr * 64 + fr;
        if (pn < 6) {
            bf16_t* base; int ld, cofs;
            if (pn == 0) { base = Q; ld = 256; cofs = 0; } else if (pn == 1) { base = Kb; ld = 256; cofs = 0; }
            else if (pn < 4) { base = V; ld = 512; cofs = (pn - 2) * 256; } else { base = SO; ld = 512; cofs = (pn - 4) * 256; }
#pragma unroll
            for (int bj = 0; bj < 2; ++bj) {
                const int c8 = bj * 128 + wc * 32 + 8 * fq;
                const f32x4 b0 = *(const f32x4*)(b_in + pn * 256 + c8), b1 = *(const f32x4*)(b_in + pn * 256 + c8 + 4);
#pragma unroll
                for (int ai = 0; ai < 2; ++ai)
#pragma unroll
                    for (int m = 0; m < 4; ++m) {
                        const size_t row = row0 + ai * 128 + m * 16;
                        f32x4 v0 = acc[ai][bj][m][0] + b0, v1 = acc[ai][bj][m][1] + b1;
                        if (pn == 1) { v0 = v0 * 0.125f; v1 = v1 * 0.125f; }
                        if (pn >= 4) {
#pragma unroll
                            for (int c = 0; c < 4; ++c) { v0[c] = sigm(v0[c]); v1[c] = sigm(v1[c]); }
                        }
                        u32x4 w; w.x = g8::cvt_pk_bf16(v0[0], v0[1]); w.y = g8::cvt_pk_bf16(v0[2], v0[3]); w.z = g8::cvt_pk_bf16(v1[0], v1[1]); w.w = g8::cvt_pk_bf16(v1[2], v1[3]);
                        *(u32x4*)(base + row * ld + cofs + c8) = w;
                    }
            }
        } else {
            const int ucol = (pn - 6) * 128 + wc * 32 + 8 * fq;
            const f32x4 a0 = *(const f32x4*)(b_in + 1552 + ucol), a1 = *(const f32x4*)(b_in + 1552 + ucol + 4);
            const f32x4 g0 = *(const f32x4*)(b_in + 2064 + ucol), g1 = *(const f32x4*)(b_in + 2064 + ucol + 4);
#pragma unroll
            for (int ai = 0; ai < 2; ++ai)
#pragma unroll
                for (int m = 0; m < 4; ++m) {
                    const size_t row = row0 + ai * 128 + m * 16;
                    const f32x4 ga0 = acc[ai][0][m][0] + a0, ga1 = acc[ai][0][m][1] + a1, gb0 = acc[ai][1][m][0] + g0, gb1 = acc[ai][1][m][1] + g1;
                    u32x4 w; w.x = g8::cvt_pk_bf16(ga0[0] * sigm(gb0[0]), ga0[1] * sigm(gb0[1])); w.y = g8::cvt_pk_bf16(ga0[2] * sigm(gb0[2]), ga0[3] * sigm(gb0[3]));
                    w.z = g8::cvt_pk_bf16(ga1[0] * sigm(gb1[0]), ga1[1] * sigm(gb1[1])); w.w = g8::cvt_pk_bf16(ga1[2] * sigm(gb1[2]), ga1[3] * sigm(gb1[3]));
                    *(u32x4*)(U + row * 512 + ucol) = w;
                }
        }
    }
};

__device__ __forceinline__ void ctx_kv_proj(const P& p, char* smem) {
    const int tid = tidx(), wid = tid >> 6, lane = tid & 63, fr = lane & 15, fq = lane >> 4, rf = wid & 3, kh = wid >> 2;
    const bf16_t* hx = (const bf16_t*)(p.ws + WS_HX) + (size_t)NT * 1024;
    const bf16_t* wt = (const bf16_t*)(p.ws + WS_WT_IN) + (size_t)256 * 1024;
    bf16_t* Kb = (bf16_t*)(p.ws + WS_K); bf16_t* V = (bf16_t*)(p.ws + WS_V);
    f32x4* red = (f32x4*)smem;
    for (int blk = blockIdx.x; blk < 256; blk += gridDim.x) {
        const int rb = blk >> 4, cb = blk & 15;
        const bf16_t* ap = hx + (size_t)(rb * 64 + rf * 16 + fr) * 1024 + kh * 512 + fq * 8;
        const bf16_t* bp = wt + (size_t)(cb * 48 + fr) * 1024 + kh * 512 + fq * 8;
        f32x4 acc[3];
#pragma unroll
        for (int n = 0; n < 3; ++n) acc[n] = (f32x4){0.f, 0.f, 0.f, 0.f};
#pragma unroll 8
        for (int ks = 0; ks < 16; ++ks) {
            const bf16x8 a = *(const bf16x8*)(ap + ks * 32);
#pragma unroll
            for (int n = 0; n < 3; ++n) { const bf16x8 b = *(const bf16x8*)(bp + (size_t)n * 16 * 1024 + ks * 32); acc[n] = __builtin_amdgcn_mfma_f32_16x16x32_bf16(b, a, acc[n], 0, 0, 0); }
        }
        __syncthreads();
        if (kh == 1) {
#pragma unroll
            for (int n = 0; n < 3; ++n) red[(rf * 3 + n) * 64 + lane] = acc[n];
        }
        __syncthreads();
        if (kh == 0) {
            const size_t row = (size_t)NT + rb * 64 + rf * 16 + fr;
#pragma unroll
            for (int n = 0; n < 3; ++n) {
                const int col = 256 + cb * 48 + n * 16 + 4 * fq;
                f32x4 v = acc[n] + red[(rf * 3 + n) * 64 + lane] + *(const f32x4*)(p.b_in + col);
                bf16_t* dst;
                if (col < 512) { v = v * 0.125f; dst = Kb + row * 256 + (col - 256); } else dst = V + row * 512 + (col - 512);
                u32x2 o; o.x = g8::cvt_pk_bf16(v[0], v[1]); o.y = g8::cvt_pk_bf16(v[2], v[3]);
                *(u32x2*)dst = o;
            }
        }
    }
}

struct MoeTab { int cnt[128]; int pt[129]; int cb[129]; };
__device__ __forceinline__ int vblock() { const int G = gridDim.x; return (G & 7) ? (int)blockIdx.x : (int)(blockIdx.x & 7) * (G >> 3) + (int)(blockIdx.x >> 3); }
struct MoeUnit { unsigned long long B; int arow, cnt, orow, pn, lbase, pad; };
constexpr int MAXU = 24;
constexpr int LDS_TAB = 131072;
constexpr int LDS_UTAB = LDS_TAB + 2048;
constexpr int LDS_TOK = LDS_UTAB + MAXU * 32;
static_assert(LDS_TOK + MAXU * 1024 <= 160 * 1024, "LDS tables overflow");

__device__ __forceinline__ void moe_prefix(const P& p, char* smem) {
    MoeTab* mt = (MoeTab*)(smem + LDS_TAB);
    const int* cursor = (const int*)(p.ws + WS_CURSOR);
    const int tid = tidx();
    __syncthreads();
    if (tid < 64) {
        const int c = cursor[tid], t = (c + 255) >> 8;
        int st = t, sc = c;
#pragma unroll
        for (int d = 1; d < 64; d <<= 1) { const int a1 = __shfl_up(st, d), a2 = __shfl_up(sc, d); if (tid >= d) { st += a1; sc += a2; } }
        mt->cnt[tid] = c; mt->pt[tid] = st - t; mt->cb[tid] = sc - c;
        const int tt = __shfl(st, 63), tc = __shfl(sc, 63);
        mt->cnt[64 + tid] = 0; mt->pt[64 + tid] = tt; mt->cb[64 + tid] = tc;
        if (tid == 0) { mt->pt[128] = tt; mt->cb[128] = tc; }
    }
    __syncthreads();
}

struct SchedMoe {
    const char* A; const MoeUnit* ut; const int* tok; int nloc, KB; bool gather;
    __device__ __forceinline__ bool next(int i, g8::Unit& u) const {
        if (i >= nloc) return false;
        const MoeUnit* q = ut + i;
        const unsigned blo = __builtin_amdgcn_readfirstlane((unsigned)(q->B & 0xffffffffull)), bhi = __builtin_amdgcn_readfirstlane((unsigned)(q->B >> 32));
        u.B = (const char*)(((unsigned long long)bhi << 32) | blo);
        u.x0 = __builtin_amdgcn_readfirstlane(q->cnt); u.x1 = __builtin_amdgcn_readfirstlane(q->pn); u.x2 = __builtin_amdgcn_readfirstlane(q->orow);
        u.x3 = i; u.A = gather ? A : A + (size_t)__builtin_amdgcn_readfirstlane(q->arow) * KB; return true;
    }
    __device__ __forceinline__ void aoffs(const g8::Unit& u, const int (&R)[2], const unsigned (&c2)[2], unsigned (&va)[2][2]) const {
#pragma unroll
        for (int h = 0; h < 2; ++h)
#pragma unroll
            for (int j = 0; j < 2; ++j) va[h][j] = (unsigned)(tok[u.x3 * 256 + h * 128 + R[j]] * KB) + c2[j];
    }
};

__device__ __forceinline__ void phase2(const P& p, char* smem) {
    ctx_kv_proj(p, smem);
    EpiInProj E; E.Q = (bf16_t*)(p.ws + WS_Q); E.Kb = (bf16_t*)(p.ws + WS_K); E.V = (bf16_t*)(p.ws + WS_V); E.SO = (bf16_t*)(p.ws + WS_SO); E.U = (bf16_t*)(p.ws + WS_U); E.b_in = p.b_in;
    {
        SchedDense S; S.A = (const char*)(p.ws + WS_HX); S.B = (const char*)(p.ws + WS_WT_IN); S.nM = NT / 256; S.nN = 4; S.KB = 2048;
        __syncthreads();
        g8::gemm<true, false, false, 127>((LAS unsigned char*)smem, 2048, S, E);
    }
    MoeUnit* ut = (MoeUnit*)(smem + LDS_UTAB); int* tok = (int*)(smem + LDS_TOK);
    const int nunits = (NT / 256) * 6;
    const int vb = vblock(), ntot = nunits > vb ? (nunits - vb + (int)gridDim.x - 1) / (int)gridDim.x : 0;
    for (int base = 0; base < ntot; base += MAXU) {
        const int nloc = (ntot - base) < MAXU ? (ntot - base) : MAXU;
        __syncthreads();
        if ((int)tidx() < nloc) {
            const int u = vb + (base + tidx()) * gridDim.x, pm = u / 6, pq = u % 6;
            MoeUnit q; q.pn = 4 + pq; q.pad = 0; q.lbase = 0; q.cnt = pm; q.arow = pm * 256; q.orow = q.arow;
            q.B = (unsigned long long)(p.ws + WS_WT_IN8 + (size_t)pq * 256 * 1024);
            ut[tidx()] = q;
        }
        __syncthreads();
        for (int idx = tidx(); idx < nloc * 256; idx += NTHREADS) tok[idx] = ut[idx >> 8].arow + (idx & 255);
        __syncthreads();
        SchedMoe S; S.A = (const char*)(p.ws + WS_HX8); S.ut = ut; S.tok = tok; S.nloc = nloc; S.KB = 1024; S.gather = true;
        g8::gemm<true, true, true, 127 - 8>((LAS unsigned char*)smem, 1024, S, E);
        __syncthreads();
    }
}

struct EpiOutProj {
    static constexpr int NST = 0;
    bf16_t* yx; const float* b_out;
    __device__ __forceinline__ void operator()(const f32x4 (&acc)[2][2][4][2], const g8::Unit& u, int wr, int wc, int fr, int fq) const {
        const size_t row0 = (size_t)u.x2 + wr * 64 + fr;
#pragma unroll
        for (int bj = 0; bj < 2; ++bj) {
            const int col = u.x1 * 256 + bj * 128 + wc * 32 + 8 * fq;
            const f32x4 b0 = *(const f32x4*)(b_out + col), b1 = *(const f32x4*)(b_out + col + 4);
#pragma unroll
            for (int ai = 0; ai < 2; ++ai)
#pragma unroll
                for (int m = 0; m < 4; ++m) {
                    const f32x4 v0 = acc[ai][bj][m][0] + b0, v1 = acc[ai][bj][m][1] + b1;
                    u32x4 w; w.x = g8::cvt_pk_bf16(v0[0], v0[1]); w.y = g8::cvt_pk_bf16(v0[2], v0[3]); w.z = g8::cvt_pk_bf16(v1[0], v1[1]); w.w = g8::cvt_pk_bf16(v1[2], v1[3]);
                    *(u32x4*)(yx + (row0 + ai * 128 + m * 16) * 1024 + col) = w;
                }
        }
    }
};

__device__ __forceinline__ void phase6(const P& p, char* smem) {
    MoeUnit* ut = (MoeUnit*)(smem + LDS_UTAB); int* tok = (int*)(smem + LDS_TOK);
    const int nunits = (NT / 256) * 4;
    const int vb = vblock(), ntot = nunits > vb ? (nunits - vb + (int)gridDim.x - 1) / (int)gridDim.x : 0;
    for (int base = 0; base < ntot; base += MAXU) {
        const int nloc = (ntot - base) < MAXU ? (ntot - base) : MAXU;
        __syncthreads();
        if ((int)tidx() < nloc) {
            const int u = vb + (base + tidx()) * gridDim.x;
            MoeUnit q; q.pn = u & 3; q.pad = 0; q.lbase = 0; q.cnt = 256; q.arow = (u >> 2) * 256; q.orow = q.arow;
            q.B = (unsigned long long)(p.ws + WS_WT_OUT + (size_t)q.pn * 256 * 1024);
            ut[tidx()] = q;
        }
        __syncthreads();
        for (int idx = tidx(); idx < nloc * 256; idx += NTHREADS) tok[idx] = ut[idx >> 8].arow + (idx & 255);
        __syncthreads();
        SchedMoe S; S.A = (const char*)(p.ws + WS_MIX); S.ut = ut; S.tok = tok; S.nloc = nloc; S.KB = 1024; S.gather = true;
        EpiOutProj E; E.yx = (bf16_t*)(p.ws + WS_YX); E.b_out = p.b_out;
        g8::gemm<true, true, true, 127 - 10>((LAS unsigned char*)smem, 1024, S, E);
        __syncthreads();
    }
}

struct EpiGateUp {
    static constexpr int NST = 8;
    unsigned char* act;
    __device__ __forceinline__ void operator()(const f32x4 (&acc)[2][2][4][2], const g8::Unit& u, int wr, int wc, int fr, int fq) const {
        unsigned char* base = act + (size_t)u.x2 * 256 + u.x1 * 128 + wc * 32 + 8 * fq;
#pragma unroll
        for (int ai = 0; ai < 2; ++ai)
#pragma unroll
            for (int m = 0; m < 4; ++m) {
                const int r = ai * 128 + wr * 64 + m * 16 + fr;
                const f32x4 g0 = acc[ai][0][m][0], g1 = acc[ai][0][m][1], u0 = acc[ai][1][m][0], u1 = acc[ai][1][m][1];
                f32x4 a0, a1;
#pragma unroll
                for (int c = 0; c < 4; ++c) { a0[c] = g0[c] * sigm(g0[c]) * u0[c]; a1[c] = g1[c] * sigm(g1[c]) * u1[c]; }
                u32x2 w; w.x = pk4_fp8(a0); w.y = pk4_fp8(a1);
                *(u32x2*)(base + r * 256) = w;
            }
    }
};

struct EpiDown {
    static constexpr int NST = 8;
    unsigned char* ye;
    __device__ __forceinline__ void operator()(const f32x4 (&acc)[2][2][4][2], const g8::Unit& u, int wr, int wc, int fr, int fq) const {
#pragma unroll
        for (int ai = 0; ai < 2; ++ai)
#pragma unroll
            for (int m = 0; m < 4; ++m) {
                const int r = ai * 128 + wr * 64 + m * 16 + fr;
                if (r < u.x0) {
                    u32x4 w; w.x = pk4_fp8(acc[ai][0][m][0]); w.y = pk4_fp8(acc[ai][0][m][1]); w.z = pk4_fp8(acc[ai][1][m][0]); w.w = pk4_fp8(acc[ai][1][m][1]);
                    *(u32x4*)(ye + (size_t)(u.x2 + r) * 1024 + ((u.x1 * 4 + wc) * 4 + fq) * 16) = w;
                }
            }
    }
};

__device__ __forceinline__ void phase9a(const P& p, char* smem) {
    moe_prefix(p, smem);
    const MoeTab* mt = (const MoeTab*)(smem + LDS_TAB);
    MoeUnit* ut = (MoeUnit*)(smem + LDS_UTAB); int* tok = (int*)(smem + LDS_TOK);
    const int* ltok = (const int*)(p.ws + WS_LTOK);
    const int TT = mt->pt[128], nunits = (TT + NT / 256) * 2;
    const int vb = vblock(), ntot = nunits > vb ? (nunits - vb + (int)gridDim.x - 1) / (int)gridDim.x : 0;
    for (int base = 0; base < ntot; base += MAXU) {
        const int nloc = (ntot - base) < MAXU ? (ntot - base) : MAXU;
        __syncthreads();
        if ((int)tidx() < nloc) {
            const int u = vb + (base + tidx()) * gridDim.x, mtile = u >> 1, pn = u & 1;
            MoeUnit q; q.pn = pn; q.pad = 0; q.arow = 0;
            if (mtile < TT) {
                int l = 0; { int hi = 63; while (l < hi) { const int mid = (l + hi) >> 1; if (mt->pt[mid + 1] > mtile) hi = mid; else l = mid + 1; } }
                const int ti = mtile - mt->pt[l], rem = mt->cnt[l] - ti * 256;
                q.cnt = rem < 256 ? rem : 256; q.orow = mtile * 256; q.lbase = l * LCAP + ti * 256;
                q.B = (unsigned long long)(p.ws + WS_WT_GU + ((size_t)(l & 63) * 512 + (size_t)pn * 256) * 1024);
            } else {
                const int s = mtile - TT;
                q.cnt = 256; q.orow = mtile * 256; q.lbase = -1 - s;
                q.B = (unsigned long long)(p.ws + WS_WT_GU + ((size_t)64 * 512 + (size_t)pn * 256) * 1024);
            }
            ut[tidx()] = q;
        }
        __syncthreads();
        for (int idx = tidx(); idx < nloc * 256; idx += NTHREADS) {
            const int i = idx >> 8, r = idx & 255; const int lb = ut[i].lbase, c = ut[i].cnt;
            tok[idx] = lb >= 0 ? ltok[lb + (r < c ? r : c - 1)] : (-1 - lb) * 256 + r;
        }
        __syncthreads();
        SchedMoe S; S.A = (const char*)(p.ws + WS_HX); S.ut = ut; S.tok = tok; S.nloc = nloc; S.KB = 1024; S.gather = true;
        EpiGateUp E; E.act = (unsigned char*)(p.ws + WS_ACT);
        g8::gemm<true, true, true, 127 - 8>((LAS unsigned char*)smem, 1024, S, E);
        __syncthreads();
    }
}

__device__ __forceinline__ void phase9b(const P& p, char* smem) {
    moe_prefix(p, smem);
    const MoeTab* mt = (const MoeTab*)(smem + LDS_TAB);
    MoeUnit* ut = (MoeUnit*)(smem + LDS_UTAB); int* tok = (int*)(smem + LDS_TOK);
    const int TT = mt->pt[128], nunits = (TT + NT / 256) * 4;
    const int vb = vblock(), ntot = nunits > vb ? (nunits - vb + (int)gridDim.x - 1) / (int)gridDim.x : 0;
    for (int base = 0; base < ntot; base += MAXU) {
        const int nloc = (ntot - base) < MAXU ? (ntot - base) : MAXU;
        __syncthreads();
        if ((int)tidx() < nloc) {
            const int u = vb + (base + tidx()) * gridDim.x, tl = u >> 2, pn = u & 3;
            MoeUnit q; q.pn = pn; q.pad = 0; q.lbase = 0;
            if (tl < TT) {
                int l = 0; { int hi = 63; while (l < hi) { const int mid = (l + hi) >> 1; if (mt->pt[mid + 1] > tl) hi = mid; else l = mid + 1; } }
                const int ti = tl - mt->pt[l], rem = mt->cnt[l] - ti * 256;
                q.cnt = 256; q.arow = tl * 256; q.orow = q.arow; (void)rem;
                q.B = (unsigned long long)(p.ws + WS_WT_D + ((size_t)(l & 63) * 1024 + (size_t)pn * 256) * 256);
            } else {
                const int sidx = tl - TT;
                q.cnt = 256; q.arow = tl * 256; q.orow = q.arow; (void)sidx;
                q.B = (unsigned long long)(p.ws + WS_WT_D + ((size_t)64 * 1024 + (size_t)pn * 256) * 256);
            }
            ut[tidx()] = q;
        }
        __syncthreads();
        for (int idx = tidx(); idx < nloc * 256; idx += NTHREADS) tok[idx] = ut[idx >> 8].arow + (idx & 255);
        __syncthreads();
        SchedMoe S; S.A = (const char*)(p.ws + WS_ACT); S.ut = ut; S.tok = tok; S.nloc = nloc; S.KB = 256; S.gather = true;
        EpiDown E; E.ye = (unsigned char*)(p.ws + WS_YE);
        int kb = 256; asm volatile("" : "+s"(kb));
        S.KB = kb;
        g8::gemm<true, true, true, 127>((LAS unsigned char*)smem, kb, S, E);
        __syncthreads();
    }
}

__device__ __forceinline__ void unpack_fp8x8(const u32x2 v, float (&f)[8]) {
    typedef float f2 __attribute__((ext_vector_type(2)));
    const f2 a = __builtin_amdgcn_cvt_pk_f32_fp8((int)v.x, false), b = __builtin_amdgcn_cvt_pk_f32_fp8((int)v.x, true);
    const f2 c = __builtin_amdgcn_cvt_pk_f32_fp8((int)v.y, false), d = __builtin_amdgcn_cvt_pk_f32_fp8((int)v.y, true);
    f[0] = a[0]; f[1] = a[1]; f[2] = b[0]; f[3] = b[1]; f[4] = c[0]; f[5] = c[1]; f[6] = d[0]; f[7] = d[1];
}
__device__ __forceinline__ void phase10(const P& p, char* smem) {
    moe_prefix(p, smem);
    const MoeTab* mt = (const MoeTab*)(smem + LDS_TAB);
    const int tid = tidx(), wid = tid >> 6, lane = tid & 63;
    float* modl = (float*)smem;
    const float* modp = (const float*)(p.ws + WS_MODP);
    {
        float t[8];
#pragma unroll
        for (int j = 0; j < 8; ++j) { const int i = tid + j * NTHREADS; t[j] = modval(modp, i >> 10, 5120 + (i & 1023)); }
#pragma unroll
        for (int j = 0; j < 8; ++j) modl[tid + j * NTHREADS] = t[j];
    }
    float* gl = modl + 4096;
    { const float a0 = p.g_post_ffn[tid], a1 = p.g_post_ffn[tid + NTHREADS]; gl[tid] = a0; gl[tid + NTHREADS] = a1; }
    __syncthreads();
    const unsigned char* ye = (const unsigned char*)(p.ws + WS_YE);
    const int* slotE = (const int*)(p.ws + WS_SLOTE); const int* slotP = (const int*)(p.ws + WS_SLOTP); const float* slotW = (const float*)(p.ws + WS_SLOTW);
    const int c0 = (lane >> 4) * 256 + ((lane >> 2) & 3) * 32 + (lane & 3) * 8;
    const int tstep = gridDim.x * 8;
    int sE = 0, sP = 0; float sW = 0.f;
    int nrow = 0; float nw = 0.f; u32x4 nrv[9], nxw[2];
#define P10_SLOTS(t_) do { if ((t_) < NT && lane < 8) { sE = slotE[(t_) * 8 + lane]; sP = slotP[(t_) * 8 + lane]; sW = slotW[(t_) * 8 + lane]; } } while (0)
#define P10_ROWS(t_) do { if ((t_) < NT) { nrow = lane < 8 ? mt->pt[sE] * 256 + sP : 0; nw = sW * (1.0f / YE_SCALE); \
        nrv[8] = __builtin_nontemporal_load((const u32x4*)(ye + ((size_t)mt->pt[128] * 256 + (t_)) * 1024 + 16 * lane)); \
        { const bf16_t* x1r_ = (const bf16_t*)(p.ws + WS_X1B) + (size_t)(t_) * 1024; nxw[0] = *(const u32x4*)(x1r_ + c0); nxw[1] = *(const u32x4*)(x1r_ + c0 + 128); } \
        _Pragma("unroll") for (int k = 0; k < 8; ++k) { const int row_ = __shfl(nrow, k); nrv[k] = __builtin_nontemporal_load((const u32x4*)(ye + (size_t)row_ * 1024 + 16 * lane)); } } } while (0)
    { const int t0 = blockIdx.x * 8 + wid; P10_SLOTS(t0); P10_ROWS(t0); P10_SLOTS(t0 + tstep); }
    for (int tokn = blockIdx.x * 8 + wid; tokn < NT; tokn += tstep) {
        u32x4 rv[9]; const float myw = nw; const u32x4 xw0 = nxw[0], xw1 = nxw[1];
#pragma unroll
        for (int k = 0; k < 9; ++k) rv[k] = nrv[k];
        P10_ROWS(tokn + tstep);
        P10_SLOTS(tokn + 2 * tstep);
        float a[16];
        {
            float f0[8], f1[8]; unpack_fp8x8((u32x2){rv[8].x, rv[8].y}, f0); unpack_fp8x8((u32x2){rv[8].z, rv[8].w}, f1);
#pragma unroll
            for (int i = 0; i < 8; ++i) { a[i] = f0[i] * (1.0f / YE_SCALE); a[8 + i] = f1[i] * (1.0f / YE_SCALE); }
        }
#pragma unroll
        for (int k = 0; k < 8; ++k) {
            const float wk = __shfl(myw, k);
            float f0[8], f1[8]; unpack_fp8x8((u32x2){rv[k].x, rv[k].y}, f0); unpack_fp8x8((u32x2){rv[k].z, rv[k].w}, f1);
#pragma unroll
            for (int i = 0; i < 8; ++i) { a[i] += wk * f0[i]; a[8 + i] += wk * f1[i]; }
        }
        float ss = 0.f;
#pragma unroll
        for (int i = 0; i < 16; ++i) ss += a[i] * a[i];
        ss = wave_sum(ss);
        const float inv = rsqrtf(ss * (1.0f / 1024.0f) + EPS);
        const float* gt = modl + (tokn / T) * 1024;
        float* orow = p.out + (size_t)tokn * 1024;
#pragma unroll
        for (int hh = 0; hh < 2; ++hh) {
            const u32x4 xw = hh ? xw1 : xw0;
            const unsigned wv[4] = {xw.x, xw.y, xw.z, xw.w};
#pragma unroll
            for (int q2 = 0; q2 < 2; ++q2) {
                const int idx = c0 + hh * 128 + q2 * 4, q = hh * 2 + q2;
                const f32x4 g = *(const f32x4*)(gl + idx), gg = *(const f32x4*)(gt + idx);
                f32x4 o;
                o[0] = __uint_as_float(wv[2 * q2] << 16); o[1] = __uint_as_float(wv[2 * q2] & 0xffff0000u); o[2] = __uint_as_float(wv[2 * q2 + 1] << 16); o[3] = __uint_as_float(wv[2 * q2 + 1] & 0xffff0000u);
#pragma unroll
                for (int c = 0; c < 4; ++c) o[c] += gg[c] * (a[q * 4 + c] * inv * g[c]);
                *(f32x4*)(orow + idx) = o;
            }
        }
    }
#undef P10_SLOTS
#undef P10_ROWS
}

#define XB_TMO      128
#define XB_XCNT(j)  (256  + 64 * (j))
#define XB_XSUB(j)  (1280 + 64 * (j))
#define XB_XGEN(j)  (2304 + 64 * (j))
#define XB_TOP      3328
#define XB_TOPGEN   3392
#define XCD_BAR_WORDS 3456
#define XB_SPIN_CAP (1u << 18)
__device__ __forceinline__ unsigned xb_ld(unsigned* p)              { return __hip_atomic_load(p, __ATOMIC_RELAXED, __HIP_MEMORY_SCOPE_AGENT); }
__device__ __forceinline__ unsigned xb_add(unsigned* p, unsigned v) { return __hip_atomic_fetch_add(p, v, __ATOMIC_RELAXED, __HIP_MEMORY_SCOPE_AGENT); }
__device__ __forceinline__ unsigned xb_xcc_id() { return (unsigned)__builtin_amdgcn_s_getreg((3 << 11) | 20) & 0xFu; }
#define XB_SPIN(cond, bar) do { unsigned _sp = 0; while (cond) { __builtin_amdgcn_s_sleep(1); \
    if ((++_sp & 255u) == 0u) { if (xb_ld(&(bar)[XB_TMO])) break; if (_sp > XB_SPIN_CAP) { atomicAdd(&(bar)[XB_TMO], 1u); break; } } } } while (0)
struct XcdBarrier { unsigned* bar; unsigned x; volatile LAS unsigned* st; };
__device__ __forceinline__ XcdBarrier xcd_barrier_post(unsigned* bar, volatile LAS unsigned* st) {
    XcdBarrier b; b.bar = bar; b.x = xb_xcc_id(); b.st = st;
    if (tidx() == 0) (void)xb_add(&bar[XB_XCNT(b.x)], 1u);
    return b;
}
__device__ __forceinline__ void xcd_barrier_complete(unsigned* bar, unsigned x, unsigned& nloc, unsigned& nx) {
    const unsigned G = gridDim.x * gridDim.y * gridDim.z;
    unsigned sum, cnt, mine, sp = 0u;
    for (;;) {
        sum = 0u; cnt = 0u; mine = 0u;
#pragma unroll
        for (unsigned j = 0; j < 16; ++j) { const unsigned c = xb_ld(&bar[XB_XCNT(j)]); sum += c; cnt += (c > 0u) ? 1u : 0u; mine = (j == x) ? c : mine; }
        if (sum == G) break;
        __builtin_amdgcn_s_sleep(1);
        if ((++sp & 255u) == 0u) { if (xb_ld(&bar[XB_TMO])) break; if (sp > XB_SPIN_CAP) { atomicAdd(&bar[XB_TMO], 1u); break; } }
    }
    nloc = mine > 0u ? mine : 1u; nx = cnt > 0u ? cnt : 1u;
}
__device__ __forceinline__ void xcd_barrier(const XcdBarrier& b) {
    asm volatile("s_waitcnt vmcnt(0)" ::: "memory");
    __syncthreads();
    if (tidx() == 0) {
        unsigned* bar = b.bar;
        __builtin_amdgcn_s_waitcnt(0);
        unsigned nloc = b.st[0], nx = b.st[1];
        if (nloc == 0u) { xcd_barrier_complete(bar, b.x, nloc, nx); b.st[0] = nloc; b.st[1] = nx; }
        const unsigned old = xb_add(&bar[XB_XSUB(b.x)], 1u);
        const unsigned gen = old / nloc;
        if (old + 1u == (gen + 1u) * nloc) {
            __builtin_amdgcn_fence(__ATOMIC_RELEASE, "agent");
            asm volatile("s_waitcnt vmcnt(0)" ::: "memory");
            const unsigned og = xb_add(&bar[XB_TOP], 1u);
            const unsigned tg = og / nx;
            if (og + 1u == (tg + 1u) * nx) xb_add(&bar[XB_TOPGEN], 1u);
            else XB_SPIN(xb_ld(&bar[XB_TOPGEN]) == tg, bar);
            __builtin_amdgcn_fence(__ATOMIC_ACQUIRE, "agent");
            xb_add(&bar[XB_XGEN(b.x)], 1u);
            asm volatile("s_waitcnt vmcnt(0)" ::: "memory");
        } else {
            XB_SPIN(xb_ld(&bar[XB_XGEN(b.x)]) == gen, bar);
            __builtin_amdgcn_fence(__ATOMIC_ACQUIRE, "agent");
            asm volatile("s_waitcnt vmcnt(0)" ::: "memory");
        }
    }
    __syncthreads();
}

constexpr int LDS_BYTES = 160 * 1024;
__global__ void __launch_bounds__(NTHREADS) k_mega(P p) {
    extern __shared__ __attribute__((aligned(16))) char smem[];
    cg::grid_group grid = cg::this_grid();
    volatile LAS unsigned* xbst = (volatile LAS unsigned*)(smem + 160 * 1024 - 64);
    if (tidx() == 0) { xbst[0] = 0u; xbst[1] = 0u; }
    __syncthreads();
    const XcdBarrier xb = xcd_barrier_post((unsigned*)(p.ws + WS_BAR), xbst);
#define RUN(bit, call) do { call; xcd_barrier(xb); if (DUP_MASK & (1 << (bit))) { call; xcd_barrier(xb); } } while (0)
    phase0(p, smem);
    if (p.ws == nullptr) grid.sync();
    if (DUP_MASK & 1) phase0(p, smem);
    RUN(1, phase1(p, smem));
    RUN(2, phase2(p, smem));
    RUN(3, phase3(p, smem));
    RUN(4, phase4(p, smem));
    RUN(5, phase5(p, smem));
    RUN(6, phase6(p, smem));
    phase7(p, smem); xcd_barrier(xb);
    if (DUP_MASK & 128) { if (blockIdx.x == 0 && tidx() < 128) ((int*)(p.ws + WS_CURSOR))[tidx()] = 0; xcd_barrier(xb); phase7(p, smem); xcd_barrier(xb); }
    RUN(8, phase9a(p, smem));
    RUN(9, phase9b(p, smem));
    phase10(p, smem);
#undef RUN
}

extern "C" void kernel_launch(void* const* d_in, const int* in_sizes, int n_in, void* d_out, int out_size, void* d_ws, size_t ws_size, hipStream_t stream) {
    if (n_in != 28 || ws_size < WS_END) { fprintf(stderr, "kernel_launch: unexpected inputs (%d) or workspace (%zu < %zu)\n", n_in, ws_size, (size_t)WS_END); return; }
    static int grid_blocks = 0;
    if (!grid_blocks) {
        int dev = 0, cus = 0, per_cu = 0;
        (void)hipGetDevice(&dev);
        (void)hipDeviceGetAttribute(&cus, hipDeviceAttributeMultiprocessorCount, dev);
        (void)hipFuncSetAttribute((const void*)k_mega, hipFuncAttributeMaxDynamicSharedMemorySize, LDS_BYTES);
        (void)hipOccupancyMaxActiveBlocksPerMultiprocessor(&per_cu, (const void*)k_mega, NTHREADS, LDS_BYTES);
        if (per_cu < 1) { fprintf(stderr, "kernel_launch: occupancy query returned %d\n", per_cu); per_cu = 1; }
        if (per_cu > 1) per_cu = 1;
        grid_blocks = cus * per_cu;
    }
    P p{};
    const float** f = (const float**)&p;
    for (int i = 0; i < 28; ++i) f[i] = (const float*)d_in[i];
    p.out = (float*)d_out; p.ws = (unsigned char*)d_ws;
    (void)hipMemsetAsync((char*)d_ws + WS_BAR, 0, (XB_ADAFLAG + 16) * 4, stream);
    void* args[] = {&p};
    hipError_t e = hipLaunchCooperativeKernel((const void*)k_mega, dim3(grid_blocks), dim3(NTHREADS), args, LDS_BYTES, stream);
    if (e != hipSuccess) fprintf(stderr, "cooperative launch failed: %s (grid %d)\n", hipGetErrorString(e), grid_blocks);
}
```
